# Optimizing an MI355X kernel written in HIP

```python
import math
import jax, jax.numpy as jnp
from jax import lax
import numpy as np

D_MODEL = 1024
BATCH = 8
SEQ = 2048
DEPTH = 4
DEC_BATCH = 128
DEC_SEQ = 4
PAST_LEN = 8192
PAGE_SIZE = 128

MIX_WIDTH = D_MODEL
GDN_HEADS = 4
GDN_HEAD_DIM = (MIX_WIDTH // 2) // GDN_HEADS
GDN_KEY = GDN_HEADS * GDN_HEAD_DIM
GDN_VAL = GDN_HEADS * GDN_HEAD_DIM
CONV_WIDTH = 4
CONV_CH = 2 * GDN_KEY + GDN_VAL
GDN_CHUNK = 64
SWA_HEADS = 8
SWA_KV_HEADS = 2
SWA_WIDTH = MIX_WIDTH - GDN_VAL
SWA_HEAD_DIM = SWA_WIDTH // SWA_HEADS
SWA_GROUP = SWA_HEADS // SWA_KV_HEADS
SWA_KV_WIDTH = SWA_KV_HEADS * SWA_HEAD_DIM
WINDOW = 128
D_FF = 2816
EPS = 1e-6
L2_EPS = 1e-6
OFF_Z = CONV_CH
OFF_B = OFF_Z + GDN_VAL
OFF_A = OFF_B + GDN_HEADS
OFF_SQ = OFF_A + GDN_HEADS
OFF_SK = OFF_SQ + SWA_WIDTH
OFF_SV = OFF_SK + SWA_KV_WIDTH
IN_COLS = OFF_SV + SWA_KV_WIDTH

kernel_name = "hymba_gdn_swa_sink_macaron_step"


def _rmsnorm(x, w):
    xf = x.astype(jnp.float32)
    y = xf * lax.rsqrt(jnp.mean(xf * xf, axis=-1, keepdims=True) + EPS)
    return (y * w.astype(jnp.float32)).astype(x.dtype)


def _swiglu(x, w_gate, w_up, w_down):
    return (jax.nn.silu(x @ w_gate) * (x @ w_up)) @ w_down


def _l2norm(x):
    return x * lax.rsqrt(jnp.sum(x * x, axis=-1, keepdims=True) + L2_EPS)


def _short_conv(u, buf, w):
    L = u.shape[1]
    full = jnp.concatenate([buf.astype(u.dtype), u], axis=1)
    out = sum(full[:, i:i + L] * w[i] for i in range(CONV_WIDTH))
    return jax.nn.silu(out), full[:, -(CONV_WIDTH - 1):]


def _gated_delta_chunked(q, k, v, g, beta, s0):
    B, L, H, DK = q.shape
    DV = v.shape[-1]
    C = min(GDN_CHUNK, L)
    pad = (-L) % C
    if pad:
        pw = ((0, 0), (0, pad), (0, 0), (0, 0))
        q, k, v = jnp.pad(q, pw), jnp.pad(k, pw), jnp.pad(v, pw)
        g, beta = jnp.pad(g, pw[:3]), jnp.pad(beta, pw[:3])
    N = (L + pad) // C

    def blk(t):
        return jnp.moveaxis(t.reshape((B, N, C, H) + t.shape[3:]), 3, 1)

    q, k, v, g, beta = blk(q), blk(k), blk(v), blk(g), blk(beta)
    gc = jnp.cumsum(g, axis=-1)
    idx = jnp.arange(C)
    causal = idx[:, None] >= idx[None, :]
    strict = idx[:, None] > idx[None, :]
    decay = jnp.exp(jnp.where(causal, gc[..., :, None] - gc[..., None, :], -jnp.inf))
    kb = k * beta[..., None]
    a_mat = jnp.where(strict, jnp.einsum('bhnid,bhnjd->bhnij', kb, k) * decay, 0.0)
    lhs = a_mat + jnp.eye(C, dtype=jnp.float32)
    rhs = jnp.concatenate([v * beta[..., None], kb * jnp.exp(gc)[..., None]], axis=-1)
    sol = lax.linalg.triangular_solve(lhs, rhs, left_side=True, lower=True, unit_diagonal=True)
    w_val, k_cum = sol[..., :DV], sol[..., DV:]
    qk = jnp.einsum('bhnid,bhnjd->bhnij', q, k) * decay
    q_dec = q * jnp.exp(gc)[..., None]
    k_dec = k * jnp.exp(gc[..., -1:] - gc)[..., None]
    c_dec = jnp.exp(gc[..., -1])
    xs = tuple(jnp.moveaxis(t, 2, 0) for t in (w_val, k_cum, qk, q_dec, k_dec, c_dec))

    def step(S, inp):
        w_i, kc_i, qk_i, qd_i, kd_i, cd_i = inp
        u = w_i - jnp.einsum('bhck,bhkv->bhcv', kc_i, S)
        o = jnp.einsum('bhck,bhkv->bhcv', qd_i, S) + jnp.einsum('bhij,bhjv->bhiv', qk_i, u)
        S = S * cd_i[..., None, None] + jnp.einsum('bhck,bhcv->bhkv', kd_i, u)
        return S, o

    s_final, o = lax.scan(step, s0, xs)
    o = jnp.moveaxis(jnp.moveaxis(o, 0, 2), 1, 3).reshape(B, N * C, H, DV)[:, :L]
    return o, s_final


def _gdn_branch(h_qkv, z, b, a, conv_buf, s0, conv_w, a_log, dt_bias, norm_w):
    B, L, _ = h_qkv.shape
    u, new_buf = _short_conv(h_qkv, conv_buf, conv_w)
    u = u.astype(jnp.float32)
    q = _l2norm(u[..., :GDN_KEY].reshape(B, L, GDN_HEADS, GDN_HEAD_DIM)) * (GDN_HEAD_DIM ** -0.5)
    k = _l2norm(u[..., GDN_KEY:2 * GDN_KEY].reshape(B, L, GDN_HEADS, GDN_HEAD_DIM))
    v = u[..., 2 * GDN_KEY:].reshape(B, L, GDN_HEADS, GDN_HEAD_DIM)
    beta = jax.nn.sigmoid(b.astype(jnp.float32))
    g = -jnp.exp(a_log.astype(jnp.float32)) * jax.nn.softplus(a.astype(jnp.float32) + dt_bias.astype(jnp.float32))
    o, s_new = _gated_delta_chunked(q, k, v, g, beta, s0.astype(jnp.float32))
    o = o * lax.rsqrt(jnp.mean(o * o, axis=-1, keepdims=True) + EPS) * norm_w.astype(jnp.float32)
    o = o * jax.nn.silu(z.astype(jnp.float32).reshape(B, L, GDN_HEADS, GDN_HEAD_DIM))
    return o.reshape(B, L, GDN_VAL).astype(h_qkv.dtype), new_buf, s_new


def _sink_attention(q, k, v, allowed, sinks):
    s = jnp.einsum('bnqhgd,bnkhd->bnhgqk', q, k).astype(jnp.float32) * (SWA_HEAD_DIM ** -0.5)
    s = jnp.where(allowed[None, :, None, None], s, -jnp.inf)
    sink = jnp.broadcast_to(sinks.astype(jnp.float32)[None, None, :, :, None, None], s.shape[:-1] + (1,))
    p = jax.nn.softmax(jnp.concatenate([s, sink], axis=-1), axis=-1)[..., :-1]
    return jnp.einsum('bnhgqk,bnkhd->bnqhgd', p.astype(v.dtype), v)


def _swa_branch(q, k, v, k_buf, v_buf, sinks, norm_w):
    B, L = q.shape[:2]
    q = q.reshape(B, L, SWA_KV_HEADS, SWA_GROUP, SWA_HEAD_DIM)
    k = k.reshape(B, L, SWA_KV_HEADS, SWA_HEAD_DIM)
    v = v.reshape(B, L, SWA_KV_HEADS, SWA_HEAD_DIM)
    sk = sinks.reshape(SWA_KV_HEADS, SWA_GROUP)
    if k_buf is None:
        N = L // WINDOW
        qb = q.reshape(B, N, WINDOW, SWA_KV_HEADS, SWA_GROUP, SWA_HEAD_DIM)

        def band(t):
            prev = jnp.concatenate([jnp.zeros_like(t[:, :WINDOW]), t[:, :L - WINDOW]], axis=1)
            shp = (B, N, WINDOW, SWA_KV_HEADS, SWA_HEAD_DIM)
            return jnp.concatenate([prev.reshape(shp), t.reshape(shp)], axis=2)

        i = jnp.arange(WINDOW)[:, None]
        j = jnp.arange(2 * WINDOW)[None, :]
        diff = i + WINDOW - j
        local = (diff >= 0) & (diff < WINDOW)
        allowed = local[None] & ((jnp.arange(N) > 0)[:, None, None] | (j >= WINDOW)[None])
        o = _sink_attention(qb, band(k), band(v), allowed, sk).reshape(B, L, SWA_WIDTH)
        buf_len = min(WINDOW, L)
        k_new, v_new = k[:, -buf_len:], v[:, -buf_len:]
    else:
        buf_len = k_buf.shape[1]
        kk = jnp.concatenate([k_buf.astype(k.dtype), k], axis=1)
        vv = jnp.concatenate([v_buf.astype(v.dtype), v], axis=1)
        i = jnp.arange(L)[:, None]
        j = jnp.arange(buf_len + L)[None, :]
        diff = buf_len + i - j
        allowed = ((diff >= 0) & (diff < WINDOW))[None]
        o = _sink_attention(q[:, None], kk[:, None], vv[:, None], allowed, sk).reshape(B, L, SWA_WIDTH)
        k_new, v_new = kk[:, -buf_len:], vv[:, -buf_len:]
    return _rmsnorm(o, norm_w), k_new, v_new


def _layer(x, conv_buf, gdn_s, k_buf, v_buf, p):
    (n1, g1, u1, d1, nm, w_in, conv_w, a_log, dt_bias, gdn_norm, sinks, swa_norm, w_out, n2, g2, u2, d2) = p
    x = x + 0.5 * _swiglu(_rmsnorm(x, n1), g1, u1, d1)
    h = _rmsnorm(x, nm) @ w_in
    gdn_o, conv_new, s_new = _gdn_branch(h[..., :OFF_Z], h[..., OFF_Z:OFF_B], h[..., OFF_B:OFF_A],
                                         h[..., OFF_A:OFF_SQ], conv_buf, gdn_s, conv_w, a_log, dt_bias, gdn_norm)
    swa_o, k_new, v_new = _swa_branch(h[..., OFF_SQ:OFF_SK], h[..., OFF_SK:OFF_SV], h[..., OFF_SV:],
                                      k_buf, v_buf, sinks, swa_norm)
    x = x + jnp.concatenate([gdn_o, swa_o], axis=-1) @ w_out
    x = x + 0.5 * _swiglu(_rmsnorm(x, n2), g2, u2, d2)
    return x, conv_new, s_new, k_new, v_new


def setup_inputs(seed: int = 0) -> dict:
    key = jax.random.key(seed)
    ks = jax.random.split(key, 32)
    f32 = jnp.float32
    nrm = lambda k, shp, s: jax.random.normal(k, shp, f32) * s
    gain = lambda k, shp: 1.0 + 0.02 * jax.random.normal(k, shp, f32)
    buf_len = min(WINDOW, PAST_LEN)
    a_init = jax.random.uniform(ks[10], (DEPTH, GDN_HEADS), f32, 1.0, 16.0)
    dt = jnp.exp(jax.random.uniform(ks[11], (DEPTH, GDN_HEADS), f32) * (math.log(0.1) - math.log(0.001)) + math.log(0.001))
    return {
        "x_prompt": nrm(ks[0], (BATCH, SEQ, D_MODEL), 1.0),
        "x_sample": nrm(ks[1], (DEC_BATCH, DEC_SEQ, D_MODEL), 1.0),
        "state_gdn_conv": nrm(ks[2], (DEPTH, DEC_BATCH, CONV_WIDTH - 1, CONV_CH), 1.0),
        "state_gdn": nrm(ks[3], (DEPTH, DEC_BATCH, GDN_HEADS, GDN_HEAD_DIM, GDN_HEAD_DIM), GDN_HEAD_DIM ** -0.5),
        "cache_swa_k": nrm(ks[4], (DEPTH, DEC_BATCH, buf_len, SWA_KV_HEADS, SWA_HEAD_DIM), 1.0),
        "cache_swa_v": nrm(ks[5], (DEPTH, DEC_BATCH, buf_len, SWA_KV_HEADS, SWA_HEAD_DIM), 1.0),
        "ffn1_norm": gain(ks[6], (DEPTH, D_MODEL)),
        "ffn1_w_gate": nrm(ks[7], (DEPTH, D_MODEL, D_FF), D_MODEL ** -0.5),
        "ffn1_w_up": nrm(ks[8], (DEPTH, D_MODEL, D_FF), D_MODEL ** -0.5),
        "ffn1_w_down": nrm(ks[9], (DEPTH, D_FF, D_MODEL), D_FF ** -0.5),
        "mix_norm": gain(ks[12], (DEPTH, D_MODEL)),
        "w_in": nrm(ks[13], (DEPTH, D_MODEL, IN_COLS), D_MODEL ** -0.5),
        "gdn_conv_w": nrm(ks[14], (DEPTH, CONV_WIDTH, CONV_CH), CONV_WIDTH ** -0.5),
        "gdn_a_log": jnp.log(a_init),
        "gdn_dt_bias": dt + jnp.log(-jnp.expm1(-dt)),
        "gdn_out_norm": gain(ks[15], (DEPTH, GDN_HEAD_DIM)),
        "swa_sinks": nrm(ks[16], (DEPTH, SWA_HEADS), 0.5),
        "swa_out_norm": gain(ks[17], (DEPTH, SWA_WIDTH)),
        "w_out": nrm(ks[18], (DEPTH, MIX_WIDTH, D_MODEL), MIX_WIDTH ** -0.5),
        "ffn2_norm": gain(ks[19], (DEPTH, D_MODEL)),
        "ffn2_w_gate": nrm(ks[20], (DEPTH, D_MODEL, D_FF), D_MODEL ** -0.5),
        "ffn2_w_up": nrm(ks[21], (DEPTH, D_MODEL, D_FF), D_MODEL ** -0.5),
        "ffn2_w_down": nrm(ks[22], (DEPTH, D_FF, D_MODEL), D_FF ** -0.5),
        "final_norm": gain(ks[23], (D_MODEL,)),
    }


def reference(x_prompt, x_sample, state_gdn_conv, state_gdn, cache_swa_k, cache_swa_v,
              ffn1_norm, ffn1_w_gate, ffn1_w_up, ffn1_w_down, mix_norm, w_in, gdn_conv_w,
              gdn_a_log, gdn_dt_bias, gdn_out_norm, swa_sinks, swa_out_norm, w_out,
              ffn2_norm, ffn2_w_gate, ffn2_w_up, ffn2_w_down, final_norm):
    xp, xs = x_prompt, x_sample
    bp = xp.shape[0]
    pc, ps, pk, pv = [], [], [], []
    sc, ss, sk, sv = [], [], [], []
    for l in range(DEPTH):
        p = (ffn1_norm[l], ffn1_w_gate[l], ffn1_w_up[l], ffn1_w_down[l], mix_norm[l], w_in[l],
             gdn_conv_w[l], gdn_a_log[l], gdn_dt_bias[l], gdn_out_norm[l], swa_sinks[l],
             swa_out_norm[l], w_out[l], ffn2_norm[l], ffn2_w_gate[l], ffn2_w_up[l], ffn2_w_down[l])
        xp, c, s, kn, vn = _layer(xp, jnp.zeros((bp, CONV_WIDTH - 1, CONV_CH), xp.dtype),
                                  jnp.zeros((bp, GDN_HEADS, GDN_HEAD_DIM, GDN_HEAD_DIM), jnp.float32),
                                  None, None, p)
        pc.append(c); ps.append(s.astype(state_gdn.dtype)); pk.append(kn); pv.append(vn)
        xs, c, s, kn, vn = _layer(xs, state_gdn_conv[l], state_gdn[l], cache_swa_k[l], cache_swa_v[l], p)
        sc.append(c); ss.append(s.astype(state_gdn.dtype)); sk.append(kn); sv.append(vn)
    y_prompt = _rmsnorm(xp, final_norm)
    y_sample = _rmsnorm(xs, final_norm)
    return (y_prompt, y_sample,
            jnp.stack(pc), jnp.stack(ps), jnp.stack(pk), jnp.stack(pv),
            jnp.stack(sc), jnp.stack(ss), jnp.stack(sk), jnp.stack(sv))
```

```cpp
#include <hip/hip_runtime.h>
#include <hip/hip_cooperative_groups.h>
#include <cstdio>
namespace cg = cooperative_groups;

#define LAS __attribute__((address_space(3)))
typedef unsigned short bf16_t;
typedef short bf16x8 __attribute__((ext_vector_type(8)));
typedef float f32x4 __attribute__((ext_vector_type(4)));
typedef float f32x2 __attribute__((ext_vector_type(2)));
typedef unsigned u32x4 __attribute__((ext_vector_type(4)));
typedef unsigned u32x2 __attribute__((ext_vector_type(2)));

constexpr int TP = 16384, TSM = 512, TT = TP + TSM, DM = 1024, FF = 2816, HC = 2816, INC = 2824;
constexpr int C_Z = 1536, C_SQ = 2048, C_SK = 2560, C_SV = 2688;
constexpr int NTHR = 512, LDS_MAIN = 131072, LDS_BYTES = LDS_MAIN + 16;
constexpr size_t E_GU = (size_t)2 * FF * DM, E_DN = (size_t)DM * FF, E_IN = (size_t)HC * DM, E_OUT = (size_t)DM * DM;
constexpr size_t O_GU1 = 0, O_DN1 = O_GU1 + E_GU, O_IN = O_DN1 + E_DN, O_OUT = O_IN + E_IN, O_GU2 = O_OUT + E_OUT, O_DN2 = O_GU2 + E_GU, WL_ELEMS = O_DN2 + E_DN;
constexpr size_t WS_W = 0;
constexpr size_t WS_X = WS_W + 4 * WL_ELEMS * 2;
constexpr size_t WS_XN = WS_X + (size_t)TT * DM * 4;
constexpr size_t WS_H = WS_XN + (size_t)TT * DM * 2;
constexpr size_t WS_O = WS_H + (size_t)TT * HC * 2;
constexpr size_t WS_G = WS_O + (size_t)TT * DM * 4;
constexpr size_t G_ITEM = 8192 * 4 + 4096;
constexpr size_t WS_CD = WS_G + (size_t)1024 * G_ITEM * 2;
constexpr size_t WS_BA = WS_CD + 131072;
constexpr size_t WS_BAR = WS_BA + (size_t)TT * 8 * 4;
constexpr size_t WS_END = WS_BAR + 16384;
constexpr size_t OUT_Y = 0;
constexpr size_t OUT_CONV_P = (size_t)TT * DM;
constexpr size_t OUT_GDN_P = OUT_CONV_P + (size_t)4 * 8 * 3 * 1536;
constexpr size_t OUT_K_P = OUT_GDN_P + (size_t)4 * 8 * 4 * 128 * 128;
constexpr size_t OUT_V_P = OUT_K_P + (size_t)4 * 8 * 128 * 128;
constexpr size_t OUT_CONV_S = OUT_V_P + (size_t)4 * 8 * 128 * 128;
constexpr size_t OUT_GDN_S = OUT_CONV_S + (size_t)4 * 128 * 3 * 1536;
constexpr size_t OUT_K_S = OUT_GDN_S + (size_t)4 * 128 * 4 * 128 * 128;
constexpr size_t OUT_V_S = OUT_K_S + (size_t)4 * 128 * 128 * 128;
constexpr size_t OUT_END = OUT_V_S + (size_t)4 * 128 * 128 * 128;

struct Params {
    const float* in[24];
    float* out;
    unsigned char* ws;
    int ph_lo, ph_hi;
};

typedef const __attribute__((address_space(4))) Params* PP;
__device__ __forceinline__ PP get_params() { PP q = (PP)__builtin_amdgcn_kernarg_segment_ptr(); asm volatile("" : "+s"(q)); return q; }
__device__ __forceinline__ int get_tid() { int t = threadIdx.x; asm volatile("" : "+v"(t)); return t; }
typedef __bf16 bf16x2_t __attribute__((ext_vector_type(2)));
__device__ __forceinline__ unsigned pk2(float lo, float hi) { const f32x2 v = {lo, hi}; return __builtin_bit_cast(unsigned, __builtin_convertvector(v, bf16x2_t)); }
__device__ __forceinline__ float bflo(unsigned w) { return __uint_as_float(w << 16); }
__device__ __forceinline__ float bfhi(unsigned w) { return __uint_as_float(w & 0xffff0000u); }
__device__ __forceinline__ float bf2f(bf16_t b) { return __uint_as_float((unsigned)b << 16); }
__device__ __forceinline__ float wave_sum(float v) {
#pragma unroll
    for (int o = 1; o < 64; o <<= 1) v += __shfl_xor(v, o);
    return v;
}
__device__ __forceinline__ float silu_f(float v) { return v * __builtin_amdgcn_rcpf(1.f + __expf(-v)); }
__device__ __forceinline__ void unpack8(const u32x4 r, float (&f)[8]) {
    f[0] = bflo(r.x); f[1] = bfhi(r.x); f[2] = bflo(r.y); f[3] = bfhi(r.y); f[4] = bflo(r.z); f[5] = bfhi(r.z); f[6] = bflo(r.w); f[7] = bfhi(r.w);
}
#define LDS_WAIT() asm volatile("s_waitcnt lgkmcnt(0)" ::: "memory")

namespace pg8 {
constexpr int BM = 256, BK = 64, HALF = 128, HTB = HALF * BK * 2, STAGE_BYTES = 8 * HTB, NXCD = 8, WGM = 8;
__device__ __forceinline__ int lds_byte(int r, int c) { const int st = (r >> 4) * 2 + (c >> 5), rr = r & 15, cc = c & 31, ob = rr * 64 + cc * 2; return st * 1024 + (ob ^ (((ob >> 9) & 1) << 5)); }
__device__ __forceinline__ void stage_rc(int b, int& R, int& C) { const int st = b / 1024, sb = b % 1024, swz = sb ^ (((sb >> 9) & 1) << 5); R = (st >> 1) * 16 + swz / 64; C = (st & 1) * 32 + (swz % 64) / 2; }
__device__ __forceinline__ int perm32(int rho) { const int n = rho >> 4, i = rho & 15; return 8 * (i >> 2) + 4 * n + (i & 3); }
struct Unit { int pm, pn, koff; };
struct Gemm { const bf16_t* A; const bf16_t* Bt; int ldk, nt; };

struct StaticOrder {
    int nM, nN, nwg, G, c;
    __device__ void init(int M, int N, int G_, int c_) { nM = M / BM; nN = N / BM; nwg = nM * nN; G = G_; c = c_; }
    __device__ bool next(int i, Unit& u) const {
        const long L = (long)i * G + c; if (L >= nwg) return false;
        int wgid = (int)L; { const int q = nwg / NXCD, r = nwg % NXCD, xcd = wgid % NXCD, off = wgid / NXCD; wgid = (xcd < r ? xcd * (q + 1) : r * (q + 1) + (xcd - r) * q) + off; }
        const int nig = WGM * nN, gid = wgid / nig, fm = gid * WGM, gsz = (nM - fm) < WGM ? (nM - fm) : WGM;
        u.pm = fm + ((wgid % nig) % gsz); u.pn = (wgid % nig) / gsz; u.koff = 0; return true;
    }
};
struct SplitOrder {
    int pm0, nM, nN, nsplit, ksb, G, c;
    __device__ bool next(int i, Unit& u) const {
        const int L = i * G + c; if (L >= nM * nN * nsplit) return false;
        const int ks = L / (nM * nN), t = L % (nM * nN);
        u.pm = pm0 + t / nN; u.pn = t % nN; u.koff = ks * ksb; return true;
    }
};

template <class Epi, class Sched>
__device__ __forceinline__ void gemm_phase(LAS unsigned char* lds, const Gemm g, const Sched& S, const Epi& E) {
    const int tid = get_tid(), wid = __builtin_amdgcn_readfirstlane(tid >> 6), lane = tid & 63, wr = wid >> 2, wc = wid & 3, fr = lane & 15, fq = lane >> 4;
    const int K = g.ldk, nt = g.nt;
    unsigned voffA[2], voffB[2];
#pragma unroll
    for (int i = 0; i < 2; ++i) { int R, C; stage_rc(tid * 16 + i * 8192, R, C); const int Rb = Epi::PERM ? ((R & ~31) + perm32(R & 31)) : R;
        voffA[i] = (unsigned)(R * K + C) * 2u; voffB[i] = (unsigned)(Rb * K + C) * 2u; }
    const size_t kstep = (size_t)(BK * 2);
    const size_t hstep = (size_t)HALF * K * 2;
    const size_t tstep = 2 * hstep;
    const unsigned ldsw = (unsigned)wid * 1024u;
    const int aoff = lds_byte(wr * 64 + fr, fq * 8), boff = lds_byte(wc * 32 + fr, fq * 8);
#define PG8_SA(b, h) (((b) * 2 + (h)) * HTB)
#define PG8_SB(b, h) ((4 + (b) * 2 + (h)) * HTB)
#define PG8_STAGE(bufoff, gbase, voff) do { _Pragma("unroll") for (int _i = 0; _i < 2; ++_i) \
        __builtin_amdgcn_global_load_lds((const unsigned*)((const char*)(gbase) + (voff)[_i]), (LAS unsigned*)(lds + (bufoff) + ldsw + _i * 8192), 16, 0, 0); } while (0)
#define PG8_LDA(dst, b, h) do { _Pragma("unroll") for (int m = 0; m < 4; ++m) _Pragma("unroll") for (int k = 0; k < 2; ++k) dst[m][k] = *(const LAS bf16x8*)(lds + PG8_SA(b, h) + aoff + m * 2048 + k * 1024); } while (0)
#define PG8_LDB(dst, b, h) do { _Pragma("unroll") for (int n = 0; n < 2; ++n) _Pragma("unroll") for (int k = 0; k < 2; ++k) dst[n][k] = *(const LAS bf16x8*)(lds + PG8_SB(b, h) + boff + n * 2048 + k * 1024); } while (0)
#define PG8_MMA(ai, bj, At, Bt) do { __builtin_amdgcn_s_setprio(1); _Pragma("unroll") for (int m = 0; m < 4; ++m) _Pragma("unroll") for (int n = 0; n < 2; ++n) _Pragma("unroll") for (int k = 0; k < 2; ++k) \
        acc[ai][bj][m][n] = __builtin_amdgcn_mfma_f32_16x16x32_bf16(Bt[n][k], At[m][k], acc[ai][bj][m][n], 0, 0, 0); __builtin_amdgcn_s_setprio(0); } while (0)
#define PG8_WAIT_V(n) asm volatile("s_waitcnt vmcnt(" #n ")" ::: "memory")
#define PG8_WAIT_L(n) asm volatile("s_waitcnt lgkmcnt(" #n ")" ::: "memory")
#define PG8_BAR __builtin_amdgcn_s_barrier()
#define PG8_SCHED __builtin_amdgcn_sched_barrier(0)
    Unit cur, nxt; int ui = 0;
    if (!S.next(0, cur)) return;
    f32x4 acc[2][2][4][2];
#pragma unroll
    for (int a = 0; a < 2; ++a)
#pragma unroll
        for (int b = 0; b < 2; ++b)
#pragma unroll
            for (int m = 0; m < 4; ++m)
#pragma unroll
                for (int n = 0; n < 2; ++n) acc[a][b][m][n] = (f32x4){0.f, 0.f, 0.f, 0.f};
    bf16x8 At[4][2], B0[2][2], B1[2][2];
    const char* cA = (const char*)g.A + (size_t)cur.pm * tstep + cur.koff; const char* cB = (const char*)g.Bt + (size_t)cur.pn * tstep + cur.koff;
    PG8_STAGE(PG8_SB(0, 0), cB, voffB); PG8_STAGE(PG8_SA(0, 0), cA, voffA); PG8_STAGE(PG8_SB(0, 1), cB + hstep, voffB); PG8_STAGE(PG8_SA(0, 1), cA + hstep, voffA);
    if (wr == 1) PG8_BAR;
    PG8_WAIT_V(4); PG8_BAR;
    PG8_STAGE(PG8_SB(1, 0), cB + kstep, voffB); PG8_STAGE(PG8_SA(1, 0), cA + kstep, voffA); PG8_STAGE(PG8_SB(1, 1), cB + hstep + kstep, voffB);
    PG8_WAIT_V(6); PG8_BAR;
    for (;;) {
        const bool has_next = S.next(ui + 1, nxt);
        const char* nA = has_next ? (const char*)g.A + (size_t)nxt.pm * tstep + nxt.koff : cA; const char* nB = has_next ? (const char*)g.Bt + (size_t)nxt.pn * tstep + nxt.koff : cB;
        for (int t = 0; t < nt; t += 2) {
            const bool last = (t == nt - 2);
            const char* a1 = cA + (size_t)(t + 1) * kstep;
            const char* a2 = last ? nA : cA + (size_t)(t + 2) * kstep; const char* b2 = last ? nB : cB + (size_t)(t + 2) * kstep;
            const char* a3 = a2 + kstep; const char* b3 = b2 + kstep;
            PG8_LDB(B0, 0, 0); PG8_SCHED; PG8_LDA(At, 0, 0); PG8_STAGE(PG8_SA(1, 1), a1 + hstep, voffA);
            PG8_WAIT_L(8); PG8_BAR; PG8_WAIT_L(0); PG8_MMA(0, 0, At, B0); PG8_BAR; PG8_SCHED;
            PG8_LDB(B1, 0, 1); PG8_STAGE(PG8_SB(0, 0), b2, voffB);
            PG8_BAR; PG8_WAIT_L(0); PG8_MMA(0, 1, At, B1); PG8_BAR;
            PG8_LDA(At, 0, 1); PG8_STAGE(PG8_SA(0, 0), a2, voffA);
            PG8_BAR; PG8_WAIT_L(0); PG8_MMA(1, 0, At, B0); PG8_BAR; PG8_SCHED;
            PG8_STAGE(PG8_SB(0, 1), b2 + hstep, voffB);
            PG8_WAIT_V(6); PG8_BAR; PG8_MMA(1, 1, At, B1); PG8_BAR;
            PG8_LDB(B0, 1, 0); PG8_SCHED; PG8_LDA(At, 1, 0); PG8_STAGE(PG8_SA(0, 1), a2 + hstep, voffA);
            PG8_WAIT_L(8); PG8_BAR; PG8_WAIT_L(0); PG8_MMA(0, 0, At, B0); PG8_BAR; PG8_SCHED;
            PG8_LDB(B1, 1, 1); PG8_STAGE(PG8_SB(1, 0), b3, voffB);
            PG8_BAR; PG8_WAIT_L(0); PG8_MMA(0, 1, At, B1); PG8_BAR;
            PG8_LDA(At, 1, 1); PG8_STAGE(PG8_SA(1, 0), a3, voffA);
            PG8_BAR; PG8_WAIT_L(0); PG8_MMA(1, 0, At, B0); PG8_BAR; PG8_SCHED;
            PG8_STAGE(PG8_SB(1, 1), b3 + hstep, voffB);
            PG8_WAIT_V(6); PG8_BAR; PG8_MMA(1, 1, At, B1); PG8_BAR;
        }
        E(acc, cur, wr, wc, fr, fq);
        if (!has_next) break;
#pragma unroll
        for (int a = 0; a < 2; ++a)
#pragma unroll
            for (int b = 0; b < 2; ++b)
#pragma unroll
                for (int m = 0; m < 4; ++m)
#pragma unroll
                    for (int n = 0; n < 2; ++n) acc[a][b][m][n] = (f32x4){0.f, 0.f, 0.f, 0.f};
        cur = nxt; cA = nA; cB = nB; ++ui;
    }
    PG8_WAIT_V(0);
    if (wr == 0) PG8_BAR;
    PG8_BAR;
#undef PG8_SA
#undef PG8_SB
#undef PG8_STAGE
#undef PG8_LDA
#undef PG8_LDB
#undef PG8_MMA
#undef PG8_WAIT_V
#undef PG8_WAIT_L
#undef PG8_BAR
#undef PG8_SCHED
}

struct EpiGU {
    static constexpr bool PERM = true;
    bf16_t* O;
    __device__ __forceinline__ void operator()(const f32x4 (&acc)[2][2][4][2], const Unit& u, int wr, int wc, int fr, int fq) const {
        const int row0 = u.pm * BM + wr * 64 + fr, col0 = u.pn * 128 + wc * 32 + 8 * fq;
#pragma unroll
        for (int ai = 0; ai < 2; ++ai)
#pragma unroll
            for (int m = 0; m < 4; ++m) { bf16_t* rowp = O + (size_t)(row0 + ai * HALF + m * 16) * FF + col0;
                const f32x4 g0 = acc[ai][0][m][0], g1 = acc[ai][0][m][1], u0 = acc[ai][1][m][0], u1 = acc[ai][1][m][1];
                u32x4 w; w.x = pk2(silu_f(g0[0]) * u0[0], silu_f(g0[1]) * u0[1]); w.y = pk2(silu_f(g0[2]) * u0[2], silu_f(g0[3]) * u0[3]);
                w.z = pk2(silu_f(g1[0]) * u1[0], silu_f(g1[1]) * u1[1]); w.w = pk2(silu_f(g1[2]) * u1[2], silu_f(g1[3]) * u1[3]);
                *(u32x4*)rowp = w; }
    }
};
struct EpiH {
    static constexpr bool PERM = true;
    bf16_t* O; int ldc;
    __device__ __forceinline__ void operator()(const f32x4 (&acc)[2][2][4][2], const Unit& u, int wr, int wc, int fr, int fq) const {
        const int row0 = u.pm * BM + wr * 64 + fr, col0 = u.pn * BM + wc * 32 + 8 * fq;
#pragma unroll
        for (int ai = 0; ai < 2; ++ai)
#pragma unroll
            for (int m = 0; m < 4; ++m) { bf16_t* rowp = O + (size_t)(row0 + ai * HALF + m * 16) * ldc + col0;
#pragma unroll
                for (int bj = 0; bj < 2; ++bj) { const f32x4 v0 = acc[ai][bj][m][0], v1 = acc[ai][bj][m][1];
                    u32x4 w; w.x = pk2(v0[0], v0[1]); w.y = pk2(v0[2], v0[3]); w.z = pk2(v1[0], v1[1]); w.w = pk2(v1[2], v1[3]);
                    *(u32x4*)(rowp + bj * HALF) = w; } }
    }
};
struct EpiRes {
    static constexpr bool PERM = false;
    float* X; float scale;
    __device__ __forceinline__ void operator()(const f32x4 (&acc)[2][2][4][2], const Unit& u, int wr, int wc, int fr, int fq) const {
        const int row0 = u.pm * BM + wr * 64 + fr, col0 = u.pn * BM + wc * 32 + 4 * fq;
#pragma unroll
        for (int ai = 0; ai < 2; ++ai) {
            f32x4 t[4][2][2];
#pragma unroll
            for (int m = 0; m < 4; ++m)
#pragma unroll
                for (int bj = 0; bj < 2; ++bj)
#pragma unroll
                    for (int n = 0; n < 2; ++n) t[m][bj][n] = *(const f32x4*)(X + (size_t)(row0 + ai * HALF + m * 16) * DM + col0 + bj * HALF + n * 16);
#pragma unroll
            for (int m = 0; m < 4; ++m)
#pragma unroll
                for (int bj = 0; bj < 2; ++bj)
#pragma unroll
                    for (int n = 0; n < 2; ++n) *(f32x4*)(X + (size_t)(row0 + ai * HALF + m * 16) * DM + col0 + bj * HALF + n * 16) = t[m][bj][n] + acc[ai][bj][m][n] * scale;
        }
    }
};
struct EpiPart {
    static constexpr bool PERM = false;
    float* P;
    __device__ __forceinline__ void operator()(const f32x4 (&acc)[2][2][4][2], const Unit& u, int wr, int wc, int fr, int fq) const {
        const int row0 = u.pm * BM - TP + wr * 64 + fr, col0 = u.pn * BM + wc * 32 + 4 * fq;
        float* base = P + (size_t)(u.koff >> 9) * TSM * DM;
#pragma unroll
        for (int ai = 0; ai < 2; ++ai)
#pragma unroll
            for (int m = 0; m < 4; ++m) { float* rowp = base + (size_t)(row0 + ai * HALF + m * 16) * DM + col0;
#pragma unroll
                for (int bj = 0; bj < 2; ++bj)
#pragma unroll
                    for (int n = 0; n < 2; ++n) *(f32x4*)(rowp + bj * HALF + n * 16) = acc[ai][bj][m][n]; }
    }
};
}

__device__ __forceinline__ void transpose_item(const float* colp, int ld, int k0, bf16_t* dst, int K, LAS float* scr, int lane) {
    float tv[32];
#pragma unroll
    for (int i = 0; i < 32; ++i) tv[i] = colp[(size_t)(k0 + 2 * i + (lane >> 5)) * ld];
#pragma unroll
    for (int i = 0; i < 32; ++i) scr[(2 * i + (lane >> 5)) * 33 + (lane & 31)] = tv[i];
    LDS_WAIT();
    const int c = lane & 7;
#pragma unroll
    for (int j = 0; j < 4; ++j) { const int n = (lane >> 3) + 8 * j; const LAS float* s = scr + (8 * c) * 33 + n;
        u32x4 o; o.x = pk2(s[0 * 33], s[1 * 33]); o.y = pk2(s[2 * 33], s[3 * 33]); o.z = pk2(s[4 * 33], s[5 * 33]); o.w = pk2(s[6 * 33], s[7 * 33]);
        *(u32x4*)(dst + (size_t)n * K + 8 * c) = o; }
    LDS_WAIT();
}
__device__ __forceinline__ void prep_phase(PP p, LAS unsigned char* lds, int bid, int nb) {
    const int tid = get_tid(), lane = tid & 63, wave = tid >> 6;
    LAS float* scr = (LAS float*)(lds + wave * 8448);
    const int gw = bid * 8 + wave, NGW = nb * 8;
    constexpr int I_GU = 16 * 176, I_DN = 44 * 32, I_IN = 16 * 88, I_OUT = 16 * 32, I_L = 2 * I_GU + 2 * I_DN + I_IN + I_OUT;
    for (int it = gw; it < 4 * I_L; it += NGW) {
        const int l = it / I_L; int r = it % I_L;
        bf16_t* wl = (bf16_t*)(p->ws + WS_W) + (size_t)l * WL_ELEMS;
        const float* colp; int ld, K, k0; bf16_t* dst;
        if (r < 2 * I_GU) {
            const int f = r >= I_GU; r -= f * I_GU; const int kb = r / 176, nb32 = r % 176;
            const float* gsrc = p->in[f ? 20 : 7] + (size_t)l * DM * FF; const float* usrc = p->in[f ? 21 : 8] + (size_t)l * DM * FF;
            colp = (((nb32 >> 2) & 1) ? usrc : gsrc) + 128 * (nb32 >> 3) + 32 * (nb32 & 3) + (lane & 31); ld = FF; K = DM; k0 = 64 * kb;
            dst = wl + (f ? O_GU2 : O_GU1) + (size_t)(32 * nb32) * DM + k0;
        } else if (r < 2 * I_GU + 2 * I_DN) {
            r -= 2 * I_GU; const int f = r >= I_DN; r -= f * I_DN; const int kb = r / 32, nb32 = r % 32;
            colp = p->in[f ? 22 : 9] + (size_t)l * FF * DM + 32 * nb32 + (lane & 31); ld = DM; K = FF; k0 = 64 * kb;
            dst = wl + (f ? O_DN2 : O_DN1) + (size_t)(32 * nb32) * FF + k0;
        } else if (r < 2 * I_GU + 2 * I_DN + I_IN) {
            r -= 2 * I_GU + 2 * I_DN; const int kb = r / 88, nb32 = r % 88; const int n = 32 * nb32 + (lane & 31);
            colp = p->in[11] + (size_t)l * DM * INC + (n < 2048 ? n : n + 8); ld = INC; K = DM; k0 = 64 * kb;
            dst = wl + O_IN + (size_t)(32 * nb32) * DM + k0;
        } else {
            r -= 2 * I_GU + 2 * I_DN + I_IN; const int kb = r / 32, nb32 = r % 32;
            colp = p->in[18] + (size_t)l * DM * DM + 32 * nb32 + (lane & 31); ld = DM; K = DM; k0 = 64 * kb;
            dst = wl + O_OUT + (size_t)(32 * nb32) * DM + k0;
        }
        transpose_item(colp, ld, k0, dst, K, scr, lane);
    }
    {
        f32x4 wv[4];
#pragma unroll
        for (int j = 0; j < 4; ++j) wv[j] = ((const f32x4*)p->in[6])[lane + 64 * j];
        for (int row = gw; row < TT; row += NGW) {
            const f32x4* xr = (const f32x4*)(row < TP ? p->in[0] + (size_t)row * DM : p->in[1] + (size_t)(row - TP) * DM) + lane;
            f32x4* xo = (f32x4*)((float*)(p->ws + WS_X) + (size_t)row * DM) + lane;
            f32x4 v[4]; float s = 0.f;
#pragma unroll
            for (int j = 0; j < 4; ++j) { v[j] = xr[64 * j]; xo[64 * j] = v[j]; s += (v[j].x * v[j].x + v[j].y * v[j].y) + (v[j].z * v[j].z + v[j].w * v[j].w); }
            const float rs = rsqrtf(wave_sum(s) * (1.f / DM) + 1e-6f);
            u32x2* o = (u32x2*)((bf16_t*)(p->ws + WS_XN) + (size_t)row * DM) + lane;
#pragma unroll
            for (int j = 0; j < 4; ++j) { const f32x4 t = v[j] * rs * wv[j]; u32x2 q; q.x = pk2(t.x, t.y); q.y = pk2(t.z, t.w); o[64 * j] = q; }
        }
    }
}

__device__ __forceinline__ int row_of(int k, int bid, int wave, int nb) {
    if (nb == 256) {
        if (k < 8) return (bid & 7) * 2048 + ((bid >> 3) * 8 + wave) + 256 * k;
        const int gw = bid * 8 + wave;
        return (k == 8 && gw < TSM) ? TP + gw : -1;
    }
    const int r = bid * 8 + wave + k * nb * 8;
    return r < TT ? r : -1;
}
template <int MODE>
__device__ __forceinline__ void rms_phase(float* x, const float* w, bf16_t* ob, float* of, float* ba, const float* win, const float* part, int nsplit, float pscale, int bid, int nb) {
    const int tid = get_tid(), lane = tid & 63, wave = tid >> 6;
    f32x4 wv[4];
#pragma unroll
    for (int j = 0; j < 4; ++j) wv[j] = ((const f32x4*)w)[lane + 64 * j];
    f32x4 wc0[4][4], wc1[4][4];
    if (MODE == 1) {
#pragma unroll
        for (int j = 0; j < 4; ++j)
#pragma unroll
            for (int e = 0; e < 4; ++e) { const float* wp = win + (size_t)(4 * lane + 256 * j + e) * INC + 2048; wc0[j][e] = *(const f32x4*)wp; wc1[j][e] = *(const f32x4*)(wp + 4); }
    }
    f32x4 nv[4];
    {
        const int r0 = row_of(0, bid, wave, nb);
        if (r0 >= 0) { const f32x4* q = (const f32x4*)(x + (size_t)r0 * DM) + lane;
#pragma unroll
            for (int j = 0; j < 4; ++j) nv[j] = q[64 * j]; }
    }
    for (int kk = 0;; ++kk) {
        const int row = row_of(kk, bid, wave, nb); if (row < 0) break;
        f32x4* xr = (f32x4*)(x + (size_t)row * DM) + lane;
        f32x4 v[4]; float s = 0.f;
#pragma unroll
        for (int j = 0; j < 4; ++j) v[j] = nv[j];
        const int rnext = row_of(kk + 1, bid, wave, nb);
        if (rnext >= 0) { const f32x4* q = (const f32x4*)(x + (size_t)rnext * DM) + lane;
#pragma unroll
            for (int j = 0; j < 4; ++j) nv[j] = q[64 * j]; }
        if (row >= TP && nsplit > 0) {
            f32x4 a[4] = {(f32x4){0.f, 0.f, 0.f, 0.f}, (f32x4){0.f, 0.f, 0.f, 0.f}, (f32x4){0.f, 0.f, 0.f, 0.f}, (f32x4){0.f, 0.f, 0.f, 0.f}};
            for (int ks = 0; ks < nsplit; ++ks) { const f32x4* pr = (const f32x4*)(part + ((size_t)ks * TSM + (row - TP)) * DM) + lane;
#pragma unroll
                for (int j = 0; j < 4; ++j) a[j] += pr[64 * j]; }
#pragma unroll
            for (int j = 0; j < 4; ++j) { v[j] += a[j] * pscale; xr[64 * j] = v[j]; }
        }
#pragma unroll
        for (int j = 0; j < 4; ++j) s += (v[j].x * v[j].x + v[j].y * v[j].y) + (v[j].z * v[j].z + v[j].w * v[j].w);
        const float rs = rsqrtf(wave_sum(s) * (1.f / DM) + 1e-6f);
#pragma unroll
        for (int j = 0; j < 4; ++j) v[j] = v[j] * rs * wv[j];
        if (MODE == 2) {
            f32x4* o = (f32x4*)(of + (size_t)row * DM) + lane;
#pragma unroll
            for (int j = 0; j < 4; ++j) o[64 * j] = v[j];
        } else {
            u32x2* o = (u32x2*)(ob + (size_t)row * DM) + lane;
#pragma unroll
            for (int j = 0; j < 4; ++j) { u32x2 q; q.x = pk2(v[j].x, v[j].y); q.y = pk2(v[j].z, v[j].w); o[64 * j] = q; }
        }
        if (MODE == 1) {
            float a8[8];
#pragma unroll
            for (int c = 0; c < 8; ++c) a8[c] = 0.f;
#pragma unroll
            for (int j = 0; j < 4; ++j)
#pragma unroll
                for (int e = 0; e < 4; ++e) {
                    const f32x4 w0 = wc0[j][e], w1 = wc1[j][e]; const float xv = v[j][e];
                    a8[0] += xv * w0.x; a8[1] += xv * w0.y; a8[2] += xv * w0.z; a8[3] += xv * w0.w; a8[4] += xv * w1.x; a8[5] += xv * w1.y; a8[6] += xv * w1.z; a8[7] += xv * w1.w;
                }
#pragma unroll
            for (int c = 0; c < 8; ++c) a8[c] = wave_sum(a8[c]);
            if (lane == 0) { *(f32x4*)(ba + (size_t)row * 8) = (f32x4){a8[0], a8[1], a8[2], a8[3]}; *(f32x4*)(ba + (size_t)row * 8 + 4) = (f32x4){a8[4], a8[5], a8[6], a8[7]}; }
        }
    }
}

__device__ __forceinline__ void gdn_stage_a(PP p, int l, int it, LAS unsigned char* lds) {
    const int tid = get_tid(), lane = tid & 63, wave = tid >> 6;
    const int hh = it & 3, n = (it >> 2) & 31, b = it >> 7;
    const int t0 = b * 2048 + n * 64;
    const bf16_t* hb = (const bf16_t*)(p->ws + WS_H);
    const float* ba = (const float*)(p->ws + WS_BA);
    bf16_t* gi_base = (bf16_t*)(p->ws + WS_G) + (size_t)it * G_ITEM;
    bf16_t* wg = gi_base; bf16_t* kcg = gi_base + 8192; bf16_t* qdg = gi_base + 16384; bf16_t* kdtg = gi_base + 24576; bf16_t* qkg = gi_base + 32768;
    LAS float* gcs = (LAS float*)lds;
    LAS float* bet = gcs + 64;
    LAS float* AT = (LAS float*)(lds + 1024);
    LAS float* vr = AT + 64 * 68;
    LAS float* kr = vr + 64 * 128;
    LAS bf16_t* qb = (LAS bf16_t*)(kr + 64 * 128);
    LAS bf16_t* kb = qb + 64 * 136;
    if (wave == 7) {
        const float av = ba[(size_t)(t0 + lane) * 8 + 4 + hh] + p->in[14][l * 4 + hh];
        const float bv = ba[(size_t)(t0 + lane) * 8 + hh];
        const float sp = av > 20.f ? av : log1pf(expf(av));
        float g = -expf(p->in[13][l * 4 + hh]) * sp;
#pragma unroll
        for (int o = 1; o < 64; o <<= 1) { const float t = __shfl_up(g, o); if (lane >= o) g += t; }
        gcs[lane] = g; bet[lane] = 1.f / (1.f + expf(-bv));
    }
    const int tb = tid / 48, r48 = tid % 48, part = r48 >> 4, gi = r48 & 15;
    const int cb = part * 512 + hh * 128 + gi * 8;
    const int tok0 = tb * 8;
    float o[8][8], ss[8];
    if (tid < 384) {
        float cw[4][8];
        const float* cwp = p->in[12] + (size_t)l * 4 * 1536 + cb;
#pragma unroll
        for (int i = 0; i < 4; ++i) { const f32x4 a = *(const f32x4*)(cwp + i * 1536), c = *(const f32x4*)(cwp + i * 1536 + 4);
            cw[i][0] = a.x; cw[i][1] = a.y; cw[i][2] = a.z; cw[i][3] = a.w; cw[i][4] = c.x; cw[i][5] = c.y; cw[i][6] = c.z; cw[i][7] = c.w; }
        float win[3][8];
#pragma unroll
        for (int i = 0; i < 3; ++i) {
            const int tl = tok0 - 3 + i;
            if (n > 0 || tl >= 0) { const u32x4 raw = *(const u32x4*)(hb + (size_t)(t0 + tl) * HC + cb); unpack8(raw, win[i]); }
            else {
#pragma unroll
                for (int c = 0; c < 8; ++c) win[i][c] = 0.f; }
        }
#pragma unroll
        for (int tt = 0; tt < 8; ++tt) {
            float cur[8];
            const u32x4 raw = *(const u32x4*)(hb + (size_t)(t0 + tok0 + tt) * HC + cb); unpack8(raw, cur);
            float s2 = 0.f;
#pragma unroll
            for (int c = 0; c < 8; ++c) { float v = cw[0][c] * win[0][c] + cw[1][c] * win[1][c] + cw[2][c] * win[2][c] + cw[3][c] * cur[c]; v = silu_f(v); o[tt][c] = v; s2 += v * v; }
            ss[tt] = s2;
            if (n == 31 && tb == 7 && tt >= 5) {
                float* cp = p->out + OUT_CONV_P + ((size_t)(l * 8 + b) * 3 + (tt - 5)) * 1536 + cb;
                *(f32x4*)cp = (f32x4){cur[0], cur[1], cur[2], cur[3]}; *(f32x4*)(cp + 4) = (f32x4){cur[4], cur[5], cur[6], cur[7]};
            }
#pragma unroll
            for (int c = 0; c < 8; ++c) { win[0][c] = win[1][c]; win[1][c] = win[2][c]; win[2][c] = cur[c]; }
        }
#pragma unroll
        for (int tt = 0; tt < 8; ++tt) {
            float s2 = ss[tt];
            s2 += __shfl_xor(s2, 1); s2 += __shfl_xor(s2, 2); s2 += __shfl_xor(s2, 4); s2 += __shfl_xor(s2, 8);
            ss[tt] = rsqrtf(s2 + 1e-6f);
        }
    }
    __syncthreads();
    const float gc_last = gcs[63];
    if (tid < 384) {
        if (part == 0) {
#pragma unroll
            for (int tt = 0; tt < 8; ++tt) {
                const int tok = tok0 + tt; const float sc = ss[tt] * 0.08838834764831845f; const float eg = __expf(gcs[tok]);
                float q[8];
#pragma unroll
                for (int c = 0; c < 8; ++c) q[c] = o[tt][c] * sc;
                u32x4 w; w.x = pk2(q[0], q[1]); w.y = pk2(q[2], q[3]); w.z = pk2(q[4], q[5]); w.w = pk2(q[6], q[7]);
                *(LAS u32x4*)(qb + tok * 136 + gi * 8) = w;
                u32x4 d; d.x = pk2(q[0] * eg, q[1] * eg); d.y = pk2(q[2] * eg, q[3] * eg); d.z = pk2(q[4] * eg, q[5] * eg); d.w = pk2(q[6] * eg, q[7] * eg);
                *(u32x4*)(qdg + tok * 128 + gi * 8) = d;
            }
        } else if (part == 1) {
            float ed[8];
#pragma unroll
            for (int tt = 0; tt < 8; ++tt) {
                const int tok = tok0 + tt; const float sc = ss[tt]; const float gct = gcs[tok]; const float be = bet[tok] * __expf(gct);
                ed[tt] = __expf(gc_last - gct);
#pragma unroll
                for (int c = 0; c < 8; ++c) o[tt][c] *= sc;
                u32x4 w; w.x = pk2(o[tt][0], o[tt][1]); w.y = pk2(o[tt][2], o[tt][3]); w.z = pk2(o[tt][4], o[tt][5]); w.w = pk2(o[tt][6], o[tt][7]);
                *(LAS u32x4*)(kb + tok * 136 + gi * 8) = w;
                *(LAS f32x4*)(kr + tok * 128 + gi * 8) = (f32x4){o[tt][0] * be, o[tt][1] * be, o[tt][2] * be, o[tt][3] * be};
                *(LAS f32x4*)(kr + tok * 128 + gi * 8 + 4) = (f32x4){o[tt][4] * be, o[tt][5] * be, o[tt][6] * be, o[tt][7] * be};
            }
#pragma unroll
            for (int c = 0; c < 8; ++c) {
                u32x4 w; w.x = pk2(o[0][c] * ed[0], o[1][c] * ed[1]); w.y = pk2(o[2][c] * ed[2], o[3][c] * ed[3]); w.z = pk2(o[4][c] * ed[4], o[5][c] * ed[5]); w.w = pk2(o[6][c] * ed[6], o[7][c] * ed[7]);
                *(u32x4*)(kdtg + (gi * 8 + c) * 64 + tok0) = w;
            }
        } else {
#pragma unroll
            for (int tt = 0; tt < 8; ++tt) {
                const int tok = tok0 + tt; const float be = bet[tok];
                *(LAS f32x4*)(vr + tok * 128 + gi * 8) = (f32x4){o[tt][0] * be, o[tt][1] * be, o[tt][2] * be, o[tt][3] * be};
                *(LAS f32x4*)(vr + tok * 128 + gi * 8 + 4) = (f32x4){o[tt][4] * be, o[tt][5] * be, o[tt][6] * be, o[tt][7] * be};
            }
        }
    }
    if (tid == 0) ((float*)(p->ws + WS_CD))[it * 32] = __expf(gc_last);
    __syncthreads();
    {
        const int prod = wave >> 2, I = wave & 3, fr = lane & 15, fq = lane >> 4;
        const LAS bf16_t* X = prod ? qb : kb;
        bf16x8 af[4];
#pragma unroll
        for (int ks = 0; ks < 4; ++ks) af[ks] = *(const LAS bf16x8*)(X + (16 * I + fr) * 136 + ks * 32 + fq * 8);
        const int i0 = 16 * I + 4 * fq;
        float gci[4];
#pragma unroll
        for (int r = 0; r < 4; ++r) gci[r] = gcs[i0 + r];
#pragma unroll
        for (int J = 0; J < 4; ++J) {
            f32x4 acc = (f32x4){0.f, 0.f, 0.f, 0.f};
            if (J <= I) {
#pragma unroll
                for (int ks = 0; ks < 4; ++ks) { const bf16x8 bfr = *(const LAS bf16x8*)(kb + (16 * J + fr) * 136 + ks * 32 + fq * 8); acc = __builtin_amdgcn_mfma_f32_16x16x32_bf16(af[ks], bfr, acc, 0, 0, 0); }
            }
            const int j = 16 * J + fr; const float gcj = gcs[j];
            if (prod == 0) {
                if (J <= I) {
                    f32x4 o4;
#pragma unroll
                    for (int r = 0; r < 4; ++r) { const int i = i0 + r; o4[r] = (i > j) ? bet[i] * acc[r] * __expf(gci[r] - gcj) : 0.f; }
                    *(LAS f32x4*)(AT + j * 68 + i0) = o4;
                }
            } else {
#pragma unroll
                for (int r = 0; r < 4; ++r) { const int i = i0 + r; const float v = (i >= j) ? acc[r] * __expf(gci[r] - gcj) : 0.f; qkg[i * 64 + j] = (bf16_t)(pk2(v, 0.f) & 0xffffu); }
            }
        }
    }
    __syncthreads();
    if (tid < 256) {
        const LAS float* src = tid < 128 ? vr + tid : kr + (tid - 128);
        f32x2 ap[32];
#pragma unroll
        for (int k = 0; k < 32; ++k) ap[k] = (f32x2){src[(2 * k) * 128], src[(2 * k + 1) * 128]};
        f32x4 cur[16], nxt[16];
#pragma unroll
        for (int c = 0; c < 16; ++c) cur[c] = *(const LAS f32x4*)(AT + 4 * c);
#pragma unroll
        for (int j = 0; j < 63; ++j) {
#pragma unroll
            for (int c = 0; c < 16; ++c) if (j < 62 && 4 * c + 3 > j + 1) nxt[c] = *(const LAS f32x4*)(AT + (j + 1) * 68 + 4 * c);
            __builtin_amdgcn_sched_barrier(0);
            const float xj = (j & 1) ? ap[j >> 1].y : ap[j >> 1].x;
            if (!(j & 1)) ap[j >> 1].y -= cur[j >> 2][(j & 3) + 1] * xj;
#pragma unroll
            for (int k = (j >> 1) + 1; k < 32; ++k) { const int c = k >> 1, lo = (k & 1) * 2; ap[k] -= (f32x2){cur[c][lo], cur[c][lo + 1]} * xj; }
            __builtin_amdgcn_sched_barrier(0);
#pragma unroll
            for (int c = 0; c < 16; ++c) cur[c] = nxt[c];
        }
        bf16_t* dst = tid < 128 ? wg + tid : kcg + (tid - 128);
#pragma unroll
        for (int k = 0; k < 32; ++k) { const unsigned w2 = pk2(ap[k].x, ap[k].y); dst[(2 * k) * 128] = (bf16_t)(w2 & 0xffffu); dst[(2 * k + 1) * 128] = (bf16_t)(w2 >> 16); }
    }
    __syncthreads();
}

__device__ __forceinline__ void gdn_sample(PP p, int l, int it, LAS unsigned char* lds) {
    const int tid = get_tid(), lane = tid & 63, wave = tid >> 6;
    const int hh = it & 3, b = it >> 2;
    const bf16_t* hb = (const bf16_t*)(p->ws + WS_H);
    const float* ba = (const float*)(p->ws + WS_BA);
    float* oraw = (float*)(p->ws + WS_O);
    LAS float* val = (LAS float*)lds;
    LAS float* valn = val + 4 * 384;
    LAS float* red = valn + 4 * 256;
    LAS float* kqs = red + 4 * 2 * 512;
    const int trow = TP + b * 4;
    const int dv = tid & 127, kq = tid >> 7;
    const size_t sbase = ((size_t)(l * 128 + b) * 4 + hh) * 16384 + (size_t)(32 * kq) * 128 + dv;
    if (tid < 384) {
        const int part = tid >> 7, d = tid & 127, col = part * 512 + hh * 128 + d;
        float full[7];
#pragma unroll
        for (int r = 0; r < 3; ++r) full[r] = p->in[2][((size_t)(l * 128 + b) * 3 + r) * 1536 + col];
#pragma unroll
        for (int i = 0; i < 4; ++i) full[3 + i] = bf2f(hb[(size_t)(trow + i) * HC + col]);
        float cw[4];
#pragma unroll
        for (int i = 0; i < 4; ++i) cw[i] = p->in[12][((size_t)l * 4 + i) * 1536 + col];
#pragma unroll
        for (int t = 0; t < 4; ++t) val[t * 384 + tid] = silu_f(cw[0] * full[t] + cw[1] * full[t + 1] + cw[2] * full[t + 2] + cw[3] * full[t + 3]);
#pragma unroll
        for (int r = 0; r < 3; ++r) p->out[OUT_CONV_S + ((size_t)(l * 128 + b) * 3 + r) * 1536 + col] = full[4 + r];
    }
    __syncthreads();
    {
        const int t = wave & 3, part = wave >> 2;
        const float q0 = val[t * 384 + lane], q1 = val[t * 384 + 64 + lane], k0 = val[t * 384 + 128 + lane], k1 = val[t * 384 + 192 + lane];
        const float scq = rsqrtf(wave_sum(q0 * q0 + q1 * q1) + 1e-6f) * 0.08838834764831845f, sck = rsqrtf(wave_sum(k0 * k0 + k1 * k1) + 1e-6f);
        const float dqk = wave_sum(q0 * k0 + q1 * k1);
        if (part == 0) { valn[t * 256 + lane] = q0 * scq; valn[t * 256 + 64 + lane] = q1 * scq; if (lane == 0) kqs[t] = dqk * scq * sck; }
        else { valn[t * 256 + 128 + lane] = k0 * sck; valn[t * 256 + 192 + lane] = k1 * sck; }
    }
    float dec[4], beta[4];
    {
        const float alog = -expf(p->in[13][l * 4 + hh]), dtb = p->in[14][l * 4 + hh];
#pragma unroll
        for (int t = 0; t < 4; ++t) {
            const float av = ba[(size_t)(trow + t) * 8 + 4 + hh] + dtb, bv = ba[(size_t)(trow + t) * 8 + hh];
            const float sp = av > 20.f ? av : log1pf(expf(av));
            dec[t] = expf(alog * sp); beta[t] = 1.f / (1.f + expf(-bv));
        }
    }
    __syncthreads();
    float S[32];
#pragma unroll
    for (int i = 0; i < 32; ++i) S[i] = p->in[3][sbase + (size_t)i * 128];
#pragma unroll
    for (int t = 0; t < 4; ++t) {
        const LAS float* qv = valn + t * 256 + 32 * kq; const LAS float* kv = qv + 128;
        float pk = 0.f, pq = 0.f;
#pragma unroll
        for (int i = 0; i < 32; ++i) { S[i] *= dec[t]; pk += S[i] * kv[i]; pq += S[i] * qv[i]; }
        LAS float* r0 = red + (t * 2 + 0) * 512; LAS float* r1 = red + (t * 2 + 1) * 512;
        r0[kq * 128 + dv] = pk; r1[kq * 128 + dv] = pq;
        __syncthreads();
        const float sk = (r0[dv] + r0[128 + dv]) + (r0[256 + dv] + r0[384 + dv]);
        const float u = beta[t] * (val[t * 384 + 256 + dv] - sk);
#pragma unroll
        for (int i = 0; i < 32; ++i) S[i] += kv[i] * u;
        if (kq == 0) oraw[(size_t)(trow + t) * DM + hh * 128 + dv] = ((r1[dv] + r1[128 + dv]) + (r1[256 + dv] + r1[384 + dv])) + u * kqs[t];
    }
    float* so = p->out + OUT_GDN_S + sbase;
#pragma unroll
    for (int i = 0; i < 32; ++i) so[(size_t)i * 128] = S[i];
    __syncthreads();
}

__device__ __forceinline__ void gdn_sample2(PP p, int l, int itA, int itB, LAS unsigned char* lds) {
    const int tid = get_tid(), lane = tid & 63, wave = tid >> 6;
    const bf16_t* hb = (const bf16_t*)(p->ws + WS_H);
    const float* ba = (const float*)(p->ws + WS_BA);
    float* oraw = (float*)(p->ws + WS_O);
    constexpr int ISTR = 4 * 384 + 4 * 256 + 4 * 2 * 512 + 16;
    const int dv = tid & 127, kq = tid >> 7;
    int hh[2], b[2], trow[2]; size_t sbase[2];
#pragma unroll
    for (int i = 0; i < 2; ++i) { const int it = i ? itB : itA; hh[i] = it & 3; b[i] = it >> 2; trow[i] = TP + b[i] * 4;
        sbase[i] = ((size_t)(l * 128 + b[i]) * 4 + hh[i]) * 16384 + (size_t)(32 * kq) * 128 + dv; }
    if (tid < 384) {
        const int part = tid >> 7, d = tid & 127;
        float full[2][7], cw[2][4];
#pragma unroll
        for (int i = 0; i < 2; ++i) { const int col = part * 512 + hh[i] * 128 + d;
#pragma unroll
            for (int r = 0; r < 3; ++r) full[i][r] = p->in[2][((size_t)(l * 128 + b[i]) * 3 + r) * 1536 + col];
#pragma unroll
            for (int q = 0; q < 4; ++q) full[i][3 + q] = bf2f(hb[(size_t)(trow[i] + q) * HC + col]);
#pragma unroll
            for (int q = 0; q < 4; ++q) cw[i][q] = p->in[12][((size_t)l * 4 + q) * 1536 + col]; }
#pragma unroll
        for (int i = 0; i < 2; ++i) { const int col = part * 512 + hh[i] * 128 + d; LAS float* val = (LAS float*)lds + i * ISTR;
#pragma unroll
            for (int t = 0; t < 4; ++t) val[t * 384 + tid] = silu_f(cw[i][0] * full[i][t] + cw[i][1] * full[i][t + 1] + cw[i][2] * full[i][t + 2] + cw[i][3] * full[i][t + 3]);
#pragma unroll
            for (int r = 0; r < 3; ++r) p->out[OUT_CONV_S + ((size_t)(l * 128 + b[i]) * 3 + r) * 1536 + col] = full[i][4 + r]; }
    }
    __syncthreads();
#pragma unroll
    for (int i = 0; i < 2; ++i) {
        LAS float* val = (LAS float*)lds + i * ISTR; LAS float* valn = val + 4 * 384; LAS float* kqs = valn + 4 * 256 + 4 * 2 * 512;
        const int t = wave & 3, part = wave >> 2;
        const float q0 = val[t * 384 + lane], q1 = val[t * 384 + 64 + lane], k0 = val[t * 384 + 128 + lane], k1 = val[t * 384 + 192 + lane];
        const float scq = rsqrtf(wave_sum(q0 * q0 + q1 * q1) + 1e-6f) * 0.08838834764831845f, sck = rsqrtf(wave_sum(k0 * k0 + k1 * k1) + 1e-6f);
        const float dqk = wave_sum(q0 * k0 + q1 * k1);
        if (part == 0) { valn[t * 256 + lane] = q0 * scq; valn[t * 256 + 64 + lane] = q1 * scq; if (lane == 0) kqs[t] = dqk * scq * sck; }
        else { valn[t * 256 + 128 + lane] = k0 * sck; valn[t * 256 + 192 + lane] = k1 * sck; }
    }
    float dec[2][4], beta[2][4];
#pragma unroll
    for (int i = 0; i < 2; ++i) {
        const float alog = -expf(p->in[13][l * 4 + hh[i]]), dtb = p->in[14][l * 4 + hh[i]];
#pragma unroll
        for (int t = 0; t < 4; ++t) {
            const float av = ba[(size_t)(trow[i] + t) * 8 + 4 + hh[i]] + dtb, bv = ba[(size_t)(trow[i] + t) * 8 + hh[i]];
            const float sp = av > 20.f ? av : log1pf(expf(av));
            dec[i][t] = expf(alog * sp); beta[i][t] = 1.f / (1.f + expf(-bv));
        }
    }
    __syncthreads();
    float S[2][32];
#pragma unroll
    for (int i = 0; i < 2; ++i)
#pragma unroll
        for (int q = 0; q < 32; ++q) S[i][q] = p->in[3][sbase[i] + (size_t)q * 128];
#pragma unroll
    for (int t = 0; t < 4; ++t) {
#pragma unroll
        for (int i = 0; i < 2; ++i) {
            LAS float* val = (LAS float*)lds + i * ISTR; LAS float* valn = val + 4 * 384; LAS float* red = valn + 4 * 256;
            const LAS float* qv = valn + t * 256 + 32 * kq; const LAS float* kv = qv + 128;
            float pk = 0.f, pq = 0.f;
#pragma unroll
            for (int q = 0; q < 32; ++q) { S[i][q] *= dec[i][t]; pk += S[i][q] * kv[q]; pq += S[i][q] * qv[q]; }
            red[(t * 2 + 0) * 512 + kq * 128 + dv] = pk; red[(t * 2 + 1) * 512 + kq * 128 + dv] = pq;
        }
        __syncthreads();
#pragma unroll
        for (int i = 0; i < 2; ++i) {
            LAS float* val = (LAS float*)lds + i * ISTR; LAS float* valn = val + 4 * 384; LAS float* red = valn + 4 * 256; LAS float* kqs = red + 4 * 2 * 512;
            const LAS float* kv = valn + t * 256 + 128 + 32 * kq;
            const LAS float* r0 = red + (t * 2 + 0) * 512; const LAS float* r1 = red + (t * 2 + 1) * 512;
            const float sk = (r0[dv] + r0[128 + dv]) + (r0[256 + dv] + r0[384 + dv]);
            const float u = beta[i][t] * (val[t * 384 + 256 + dv] - sk);
#pragma unroll
            for (int q = 0; q < 32; ++q) S[i][q] += kv[q] * u;
            if (kq == 0) oraw[(size_t)(trow[i] + t) * DM + hh[i] * 128 + dv] = ((r1[dv] + r1[128 + dv]) + (r1[256 + dv] + r1[384 + dv])) + u * kqs[t];
        }
    }
#pragma unroll
    for (int i = 0; i < 2; ++i) { float* so = p->out + OUT_GDN_S + sbase[i];
#pragma unroll
        for (int q = 0; q < 32; ++q) so[(size_t)q * 128] = S[i][q]; }
    __syncthreads();
}

__device__ __forceinline__ void swa_prompt(PP p, int l, int it, LAS unsigned char* lds) {
    const int tid = get_tid(), lane = tid & 63, wave = tid >> 6, fr = lane & 15, fq = lane >> 4;
    const int rr = it >> 3, pr = (rr >> 5) * 8 + (it & 7), qt = rr & 31, b = pr >> 1, kvh = pr & 1;
    const int q0 = qt * 64, kbase = q0 - 128;
    const bf16_t* hb = (const bf16_t*)(p->ws + WS_H) + (size_t)(b * 2048) * HC;
    float* oraw = (float*)(p->ws + WS_O) + (size_t)(b * 2048) * DM;
    LAS bf16_t* Ks = (LAS bf16_t*)lds;
    LAS bf16_t* VT = Ks + 192 * 72;
#pragma unroll
    for (int i = 0; i < 3; ++i) {
        const int id = tid + 512 * i, row = id >> 3, c8 = id & 7, kp = kbase + row;
        u32x4 kr4 = (u32x4){0u, 0u, 0u, 0u}, vr4 = kr4;
        if (kp >= 0) { kr4 = *(const u32x4*)(hb + (size_t)kp * HC + C_SK + kvh * 64 + c8 * 8); vr4 = *(const u32x4*)(hb + (size_t)kp * HC + C_SV + kvh * 64 + c8 * 8); }
        *(LAS u32x4*)(Ks + row * 72 + c8 * 8) = kr4;
        LAS bf16_t* vt = VT + (c8 * 8) * 200 + row;
        vt[0 * 200] = (bf16_t)(vr4.x & 0xffffu); vt[1 * 200] = (bf16_t)(vr4.x >> 16); vt[2 * 200] = (bf16_t)(vr4.y & 0xffffu); vt[3 * 200] = (bf16_t)(vr4.y >> 16);
        vt[4 * 200] = (bf16_t)(vr4.z & 0xffffu); vt[5 * 200] = (bf16_t)(vr4.z >> 16); vt[6 * 200] = (bf16_t)(vr4.w & 0xffffu); vt[7 * 200] = (bf16_t)(vr4.w >> 16);
        if (qt >= 30 && row >= 128) {
            float kf[8], vf[8]; unpack8(kr4, kf); unpack8(vr4, vf);
            const size_t o = ((size_t)(l * 8 + b) * 128 + (kp - 1920)) * 128 + kvh * 64 + c8 * 8;
            *(f32x4*)(p->out + OUT_K_P + o) = (f32x4){kf[0], kf[1], kf[2], kf[3]}; *(f32x4*)(p->out + OUT_K_P + o + 4) = (f32x4){kf[4], kf[5], kf[6], kf[7]};
            *(f32x4*)(p->out + OUT_V_P + o) = (f32x4){vf[0], vf[1], vf[2], vf[3]}; *(f32x4*)(p->out + OUT_V_P + o + 4) = (f32x4){vf[4], vf[5], vf[6], vf[7]};
        }
    }
    const int g = wave >> 1, half = wave & 1, hq = kvh * 4 + g;
    const int qrow0 = q0 + 32 * half, kl0 = 32 * half;
    bf16x8 qf[2][2];
#pragma unroll
    for (int qt2 = 0; qt2 < 2; ++qt2)
#pragma unroll
        for (int ks = 0; ks < 2; ++ks) qf[qt2][ks] = *(const bf16x8*)(hb + (size_t)(qrow0 + 16 * qt2 + fr) * HC + C_SQ + hq * 64 + ks * 32 + fq * 8);
    __syncthreads();
    f32x4 sacc[2][10];
#pragma unroll
    for (int kt = 0; kt < 10; ++kt) {
        bf16x8 kf[2];
#pragma unroll
        for (int ks = 0; ks < 2; ++ks) kf[ks] = *(const LAS bf16x8*)(Ks + (kl0 + 16 * kt + fr) * 72 + ks * 32 + fq * 8);
#pragma unroll
        for (int qt2 = 0; qt2 < 2; ++qt2) {
            f32x4 a = (f32x4){0.f, 0.f, 0.f, 0.f};
            a = __builtin_amdgcn_mfma_f32_16x16x32_bf16(kf[0], qf[qt2][0], a, 0, 0, 0);
            a = __builtin_amdgcn_mfma_f32_16x16x32_bf16(kf[1], qf[qt2][1], a, 0, 0, 0);
            sacc[qt2][kt] = a;
        }
    }
    const float sink = p->in[16][l * 8 + hq];
    float inv[2];
    bf16x8 pf[2][5];
#pragma unroll
    for (int qt2 = 0; qt2 < 2; ++qt2) {
        float m = sink;
#pragma unroll
        for (int kt = 0; kt < 10; ++kt)
#pragma unroll
            for (int r = 0; r < 4; ++r) {
                const int diff = 128 + 16 * qt2 + fr - 16 * kt - 4 * fq - r;
                const int kp = kbase + kl0 + 16 * kt + 4 * fq + r;
                const bool ok = (diff >= 0) && (diff < 128) && (kp >= 0);
                const float s = ok ? sacc[qt2][kt][r] * 0.125f : -__builtin_inff();
                sacc[qt2][kt][r] = s; m = fmaxf(m, s);
            }
        m = fmaxf(m, __shfl_xor(m, 16)); m = fmaxf(m, __shfl_xor(m, 32));
        float sum = 0.f;
#pragma unroll
        for (int kt = 0; kt < 10; ++kt)
#pragma unroll
            for (int r = 0; r < 4; ++r) { const float e = __expf(sacc[qt2][kt][r] - m); sacc[qt2][kt][r] = e; sum += e; }
        sum += __shfl_xor(sum, 16); sum += __shfl_xor(sum, 32);
        sum += __expf(sink - m);
        inv[qt2] = 1.f / sum;
#pragma unroll
        for (int s5 = 0; s5 < 5; ++s5) {
            const f32x4 a = sacc[qt2][2 * s5], c = sacc[qt2][2 * s5 + 1];
            u32x4 w; w.x = pk2(a[0], a[1]); w.y = pk2(a[2], a[3]); w.z = pk2(c[0], c[1]); w.w = pk2(c[2], c[3]);
            pf[qt2][s5] = __builtin_bit_cast(bf16x8, w);
        }
    }
#pragma unroll
    for (int dt = 0; dt < 4; ++dt) {
        f32x4 oa[2] = {(f32x4){0.f, 0.f, 0.f, 0.f}, (f32x4){0.f, 0.f, 0.f, 0.f}};
#pragma unroll
        for (int s5 = 0; s5 < 5; ++s5) {
            const LAS bf16_t* vp = VT + (16 * dt + fr) * 200 + kl0 + 32 * s5 + 4 * fq;
            const u32x2 lo = *(const LAS u32x2*)vp, hi = *(const LAS u32x2*)(vp + 16);
            const bf16x8 vf = __builtin_bit_cast(bf16x8, (u32x4){lo.x, lo.y, hi.x, hi.y});
            oa[0] = __builtin_amdgcn_mfma_f32_16x16x32_bf16(vf, pf[0][s5], oa[0], 0, 0, 0);
            oa[1] = __builtin_amdgcn_mfma_f32_16x16x32_bf16(vf, pf[1][s5], oa[1], 0, 0, 0);
        }
#pragma unroll
        for (int qt2 = 0; qt2 < 2; ++qt2)
            *(f32x4*)(oraw + (size_t)(qrow0 + 16 * qt2 + fr) * DM + 512 + hq * 64 + 16 * dt + 4 * fq) = oa[qt2] * inv[qt2];
    }
    __syncthreads();
}

__device__ __forceinline__ void swa_sample(PP p, int l, int it, LAS unsigned char* lds) {
    const int tid = get_tid(), lane = tid & 63, wave = tid >> 6;
    const int kvh = it & 1, b = it >> 1;
    const bf16_t* hb = (const bf16_t*)(p->ws + WS_H) + (size_t)(TP + b * 4) * HC;
    float* oraw = (float*)(p->ws + WS_O) + (size_t)(TP + b * 4) * DM;
    LAS float* Kc = (LAS float*)lds;
    LAS float* Vc = Kc + 132 * 68;
    LAS float* Qs = Vc + 132 * 68;
    LAS float* sc = Qs + 16 * 64;
    for (int id = tid; id < 132 * 16; id += NTHR) {
        const int row = id >> 4, c4 = (id & 15) * 4;
        f32x4 kv, vv;
        if (row < 128) {
            const size_t o = ((size_t)(l * 128 + b) * 128 + row) * 128 + kvh * 64 + c4;
            kv = *(const f32x4*)(p->in[4] + o); vv = *(const f32x4*)(p->in[5] + o);
        } else {
            const bf16_t* hp = hb + (size_t)(row - 128) * HC + kvh * 64 + c4;
            const u32x2 kr = *(const u32x2*)(hp + C_SK), vr = *(const u32x2*)(hp + C_SV);
            kv = (f32x4){bflo(kr.x), bfhi(kr.x), bflo(kr.y), bfhi(kr.y)}; vv = (f32x4){bflo(vr.x), bfhi(vr.x), bflo(vr.y), bfhi(vr.y)};
        }
        *(LAS f32x4*)(Kc + row * 68 + c4) = kv; *(LAS f32x4*)(Vc + row * 68 + c4) = vv;
        if (row >= 4) {
            const size_t o = ((size_t)(l * 128 + b) * 128 + (row - 4)) * 128 + kvh * 64 + c4;
            *(f32x4*)(p->out + OUT_K_S + o) = kv; *(f32x4*)(p->out + OUT_V_S + o) = vv;
        }
    }
    for (int id = tid; id < 16 * 64; id += NTHR) {
        const int row = id >> 6, d = id & 63, g = row >> 2, i = row & 3;
        Qs[id] = bf2f(hb[(size_t)i * HC + C_SQ + (kvh * 4 + g) * 64 + d]);
    }
    __syncthreads();
    for (int id = tid; id < 16 * 132; id += NTHR) {
        const int row = id / 132, key = id % 132, i = row & 3;
        const LAS float* kp = Kc + key * 68; const LAS float* qp = Qs + row * 64;
        float s = 0.f;
#pragma unroll
        for (int d = 0; d < 64; d += 4) { const f32x4 a = *(const LAS f32x4*)(kp + d), c = *(const LAS f32x4*)(qp + d); s += (a.x * c.x + a.y * c.y) + (a.z * c.z + a.w * c.w); }
        const bool ok = (key >= i + 1) && (key <= i + 128);
        sc[row * 136 + key] = ok ? s * 0.125f : -__builtin_inff();
    }
    __syncthreads();
#pragma unroll
    for (int rr = 0; rr < 2; ++rr) {
        const int row = wave * 2 + rr, g = row >> 2;
        const float sink = p->in[16][l * 8 + kvh * 4 + g];
        const float s0 = sc[row * 136 + lane], s1 = sc[row * 136 + 64 + lane], s2 = lane < 4 ? sc[row * 136 + 128 + lane] : -__builtin_inff();
        float m = fmaxf(fmaxf(s0, s1), fmaxf(s2, sink));
#pragma unroll
        for (int o = 1; o < 64; o <<= 1) m = fmaxf(m, __shfl_xor(m, o));
        const float e0 = __expf(s0 - m), e1 = __expf(s1 - m), e2 = __expf(s2 - m);
        const float inv = 1.f / (wave_sum(e0 + e1 + e2) + __expf(sink - m));
        sc[row * 136 + lane] = e0 * inv; sc[row * 136 + 64 + lane] = e1 * inv; if (lane < 4) sc[row * 136 + 128 + lane] = e2 * inv;
    }
    __syncthreads();
    {
        const int row = tid >> 5, d2 = (tid & 31) * 2, g = row >> 2, i = row & 3;
        float o0 = 0.f, o1 = 0.f;
#pragma unroll 6
        for (int key = 0; key < 132; ++key) { const float pr = sc[row * 136 + key]; const f32x2 v = *(const LAS f32x2*)(Vc + key * 68 + d2); o0 += pr * v.x; o1 += pr * v.y; }
        *(f32x2*)(oraw + (size_t)i * DM + 512 + (kvh * 4 + g) * 64 + d2) = (f32x2){o0, o1};
    }
    __syncthreads();
}

__device__ __forceinline__ void gdn_chain(PP p, int l, int c, LAS unsigned char* lds) {
    const int tid = get_tid(), lane = tid & 63, wave = tid >> 6, fr = lane & 15, fq = lane >> 4;
    const int xg = c & 7, jg = c >> 3, vs = jg & 3, grp = (jg >> 2) * 8 + xg, hh = grp & 3, b = grp >> 2;
    float* oraw = (float*)(p->ws + WS_O);
    const float* cdg = (const float*)(p->ws + WS_CD);
    LAS bf16_t* STb = (LAS bf16_t*)lds;
    LAS bf16_t* kcs = STb + 32 * 136;
    LAS bf16_t* qds = kcs + 64 * 136;
    LAS bf16_t* kdts = qds + 64 * 136;
    LAS bf16_t* qks = kdts + 128 * 72;
    LAS bf16_t* wsl = qks + 64 * 72;
    LAS bf16_t* uT = wsl + 64 * 40;
    u32x4 rk[2], rq[2], rd[2], rqk, rw;
    auto prefetch = [&](int n) {
        const bf16_t* gb = (const bf16_t*)(p->ws + WS_G) + (size_t)(((b * 32 + n) << 2) + hh) * G_ITEM;
#pragma unroll
        for (int i = 0; i < 2; ++i) { const int id = tid + 512 * i;
            rk[i] = *(const u32x4*)(gb + 8192 + (id >> 4) * 128 + (id & 15) * 8);
            rq[i] = *(const u32x4*)(gb + 16384 + (id >> 4) * 128 + (id & 15) * 8);
            rd[i] = *(const u32x4*)(gb + 24576 + (id >> 3) * 64 + (id & 7) * 8); }
        rqk = *(const u32x4*)(gb + 32768 + (tid >> 3) * 64 + (tid & 7) * 8);
        if (tid < 256) rw = *(const u32x4*)(gb + (tid >> 2) * 128 + 32 * vs + (tid & 3) * 8);
    };
    auto commit = [&]() {
#pragma unroll
        for (int i = 0; i < 2; ++i) { const int id = tid + 512 * i;
            *(LAS u32x4*)(kcs + (id >> 4) * 136 + (id & 15) * 8) = rk[i];
            *(LAS u32x4*)(qds + (id >> 4) * 136 + (id & 15) * 8) = rq[i];
            *(LAS u32x4*)(kdts + (id >> 3) * 72 + (id & 7) * 8) = rd[i]; }
        *(LAS u32x4*)(qks + (tid >> 3) * 72 + (tid & 7) * 8) = rqk;
        if (tid < 256) *(LAS u32x4*)(wsl + (tid >> 2) * 40 + (tid & 3) * 8) = rw;
    };
    LAS float* cds = (LAS float*)(uT + 32 * 72);
    if (tid < 32) cds[tid] = cdg[(((b * 32 + tid) << 2) + hh) * 32];
    prefetch(0);
    for (int i = tid; i < 32 * 136 / 2; i += NTHR) ((LAS unsigned*)STb)[i] = 0u;
    commit();
    f32x4 sa[2] = {(f32x4){0.f, 0.f, 0.f, 0.f}, (f32x4){0.f, 0.f, 0.f, 0.f}};
    const int I = wave >> 1, Jt = wave & 1;
    __syncthreads();
    for (int n = 0; n < 32; ++n) {
        const float cd = cds[n];
        if (n + 1 < 32) prefetch(n + 1);
        bf16x8 sfr[4];
        {
            f32x4 a = (f32x4){0.f, 0.f, 0.f, 0.f};
            bf16x8 af[4];
#pragma unroll
            for (int ks = 0; ks < 4; ++ks) { af[ks] = *(const LAS bf16x8*)(kcs + (16 * I + fr) * 136 + ks * 32 + fq * 8); sfr[ks] = *(const LAS bf16x8*)(STb + (16 * Jt + fr) * 136 + ks * 32 + fq * 8); }
            float w4[4];
#pragma unroll
            for (int r = 0; r < 4; ++r) w4[r] = bf2f(wsl[(16 * I + 4 * fq + r) * 40 + 16 * Jt + fr]);
            __builtin_amdgcn_sched_barrier(0);
#pragma unroll
            for (int ks = 0; ks < 4; ++ks) a = __builtin_amdgcn_mfma_f32_16x16x32_bf16(af[ks], sfr[ks], a, 0, 0, 0);
            float u4[4];
#pragma unroll
            for (int r = 0; r < 4; ++r) u4[r] = w4[r] - a[r];
            u32x2 w; w.x = pk2(u4[0], u4[1]); w.y = pk2(u4[2], u4[3]);
            *(LAS u32x2*)(uT + (16 * Jt + fr) * 72 + 16 * I + 4 * fq) = w;
        }
        __syncthreads();
        {
            f32x4 a = (f32x4){0.f, 0.f, 0.f, 0.f};
            bf16x8 af[6], ufo[2], kf[2], ufx[2];
#pragma unroll
            for (int ks = 0; ks < 4; ++ks) af[ks] = *(const LAS bf16x8*)(qds + (16 * I + fr) * 136 + ks * 32 + fq * 8);
#pragma unroll
            for (int ks = 0; ks < 2; ++ks) { af[4 + ks] = *(const LAS bf16x8*)(qks + (16 * I + fr) * 72 + ks * 32 + fq * 8); ufo[ks] = *(const LAS bf16x8*)(uT + (16 * Jt + fr) * 72 + ks * 32 + fq * 8); }
#pragma unroll
            for (int ks = 0; ks < 2; ++ks) { kf[ks] = *(const LAS bf16x8*)(kdts + (16 * wave + fr) * 72 + ks * 32 + fq * 8); ufx[ks] = *(const LAS bf16x8*)(uT + (16 * (Jt ^ 1) + fr) * 72 + ks * 32 + fq * 8); }
            __builtin_amdgcn_sched_barrier(0);
#pragma unroll
            for (int ks = 0; ks < 4; ++ks) a = __builtin_amdgcn_mfma_f32_16x16x32_bf16(sfr[ks], af[ks], a, 0, 0, 0);
#pragma unroll
            for (int ks = 0; ks < 2; ++ks) a = __builtin_amdgcn_mfma_f32_16x16x32_bf16(ufo[ks], af[4 + ks], a, 0, 0, 0);
            {
                f32x4 s0 = sa[0] * cd, s1 = sa[1] * cd;
#pragma unroll
                for (int ks = 0; ks < 2; ++ks) { s0 = __builtin_amdgcn_mfma_f32_16x16x32_bf16(kf[ks], ufo[ks], s0, 0, 0, 0); s1 = __builtin_amdgcn_mfma_f32_16x16x32_bf16(kf[ks], ufx[ks], s1, 0, 0, 0); }
                sa[0] = s0; sa[1] = s1;
            }
            *(f32x4*)(oraw + (size_t)(b * 2048 + n * 64 + 16 * I + fr) * DM + hh * 128 + 32 * vs + 16 * Jt + 4 * fq) = a;
        }
        __syncthreads();
#pragma unroll
        for (int j2 = 0; j2 < 2; ++j2) { u32x2 w; w.x = pk2(sa[j2][0], sa[j2][1]); w.y = pk2(sa[j2][2], sa[j2][3]);
            *(LAS u32x2*)(STb + (16 * (Jt ^ j2) + fr) * 136 + 16 * wave + 4 * fq) = w; }
        if (n + 1 < 32) commit();
        __syncthreads();
    }
    float* so = p->out + OUT_GDN_P + ((size_t)(l * 8 + b) * 4 + hh) * 16384;
#pragma unroll
    for (int j2 = 0; j2 < 2; ++j2)
#pragma unroll
        for (int r = 0; r < 4; ++r) so[(size_t)(16 * wave + 4 * fq + r) * 128 + 32 * vs + 16 * (Jt ^ j2) + fr] = sa[j2][r];
}

__device__ __forceinline__ void finalize_phase(PP p, int l, int bid, int nb) {
    const int tid = get_tid(), lane = tid & 63, wave = tid >> 6;
    const float* oraw = (const float*)(p->ws + WS_O);
    const bf16_t* hb = (const bf16_t*)(p->ws + WS_H);
    bf16_t* mix = (bf16_t*)(p->ws + WS_XN);
    float wv[16];
    {
        const float* wp = lane < 32 ? p->in[15] + l * 128 + (lane & 7) * 16 : p->in[17] + l * 512 + (lane - 32) * 16;
#pragma unroll
        for (int e = 0; e < 16; ++e) wv[e] = wp[e];
    }
    for (int kk = 0;; ++kk) {
        const int row = row_of(kk, bid, wave, nb); if (row < 0) break;
        const f32x4* op = (const f32x4*)(oraw + (size_t)row * DM + 16 * lane);
        float v[16]; float s = 0.f;
#pragma unroll
        for (int j = 0; j < 4; ++j) { const f32x4 a = op[j]; v[4 * j] = a.x; v[4 * j + 1] = a.y; v[4 * j + 2] = a.z; v[4 * j + 3] = a.w; s += (a.x * a.x + a.y * a.y) + (a.z * a.z + a.w * a.w); }
        s += __shfl_xor(s, 1); s += __shfl_xor(s, 2); s += __shfl_xor(s, 4);
        float s5 = s; s5 += __shfl_xor(s5, 8); s5 += __shfl_xor(s5, 16);
        const float rs = lane < 32 ? rsqrtf(s * (1.f / 128.f) + 1e-6f) : rsqrtf(s5 * (1.f / 512.f) + 1e-6f);
        if (lane < 32) {
            const u32x4* zp = (const u32x4*)(hb + (size_t)row * HC + C_Z + 16 * lane);
            float z[16]; { float t8[8]; unpack8(zp[0], t8);
#pragma unroll
                for (int e = 0; e < 8; ++e) z[e] = t8[e];
                unpack8(zp[1], t8);
#pragma unroll
                for (int e = 0; e < 8; ++e) z[8 + e] = t8[e]; }
#pragma unroll
            for (int e = 0; e < 16; ++e) v[e] = v[e] * rs * wv[e] * silu_f(z[e]);
        } else {
#pragma unroll
            for (int e = 0; e < 16; ++e) v[e] = v[e] * rs * wv[e];
        }
        u32x4 o0, o1;
        o0.x = pk2(v[0], v[1]); o0.y = pk2(v[2], v[3]); o0.z = pk2(v[4], v[5]); o0.w = pk2(v[6], v[7]);
        o1.x = pk2(v[8], v[9]); o1.y = pk2(v[10], v[11]); o1.z = pk2(v[12], v[13]); o1.w = pk2(v[14], v[15]);
        u32x4* mp = (u32x4*)(mix + (size_t)row * DM + 16 * lane); mp[0] = o0; mp[1] = o1;
    }
}

#define XB_TMO      128
#define XB_XCNT(j)  (256  + 64 * (j))
#define XB_XSUB(j)  (1280 + 64 * (j))
#define XB_XGEN(j)  (2304 + 64 * (j))
#define XB_TOP      3328
#define XB_TOPGEN   3392
#define XCD_BAR_WORDS 3456
#define XB_SPIN_CAP (1u << 20)
__device__ __forceinline__ unsigned xb_ld(unsigned* p)              { return __hip_atomic_load(p, __ATOMIC_RELAXED, __HIP_MEMORY_SCOPE_AGENT); }
__device__ __forceinline__ unsigned xb_add(unsigned* p, unsigned v) { return __hip_atomic_fetch_add(p, v, __ATOMIC_RELAXED, __HIP_MEMORY_SCOPE_AGENT); }
__device__ __forceinline__ unsigned xb_xcc_id() { return (unsigned)__builtin_amdgcn_s_getreg((3 << 11) | 20) & 0xFu; }
#define XB_SPIN(cond, bar) do { unsigned _sp = 0; while (cond) { __builtin_amdgcn_s_sleep(1); \
    if ((++_sp & 255u) == 0u) { if (xb_ld(&(bar)[XB_TMO])) break; if (_sp > XB_SPIN_CAP) { atomicAdd(&(bar)[XB_TMO], 1u); break; } } } } while (0)
__device__ __forceinline__ void xcd_barrier_complete(unsigned* bar, unsigned x, unsigned& nloc, unsigned& nx) {
    const unsigned G = gridDim.x * gridDim.y * gridDim.z;
    unsigned sum, cnt, mine, sp = 0u;
    for (;;) {
        sum = 0u; cnt = 0u; mine = 0u;
#pragma unroll
        for (unsigned j = 0; j < 16; ++j) { const unsigned c = xb_ld(&bar[XB_XCNT(j)]); sum += c; cnt += (c > 0u) ? 1u : 0u; mine = (j == x) ? c : mine; }
        if (sum == G) break;
        __builtin_amdgcn_s_sleep(1);
        if ((++sp & 255u) == 0u) { if (xb_ld(&bar[XB_TMO])) break; if (sp > XB_SPIN_CAP) { atomicAdd(&bar[XB_TMO], 1u); break; } }
    }
    nloc = mine > 0u ? mine : 1u; nx = cnt > 0u ? cnt : 1u;
}
__device__ __forceinline__ void xcd_barrier(unsigned* bar, volatile LAS unsigned* st) {
    asm volatile("s_waitcnt vmcnt(0)" ::: "memory");
    __syncthreads();
    if (threadIdx.x == 0) {
        const unsigned x = xb_xcc_id();
        __builtin_amdgcn_s_waitcnt(0);
        unsigned nloc = st[0], nx = st[1];
        if (nloc == 0u) { xcd_barrier_complete(bar, x, nloc, nx); st[0] = nloc; st[1] = nx; }
        const unsigned old = xb_add(&bar[XB_XSUB(x)], 1u);
        const unsigned gen = old / nloc;
        if (old + 1u == (gen + 1u) * nloc) {
            __builtin_amdgcn_fence(__ATOMIC_RELEASE, "agent");
            asm volatile("s_waitcnt vmcnt(0)" ::: "memory");
            const unsigned og = xb_add(&bar[XB_TOP], 1u);
            const unsigned tg = og / nx;
            if (og + 1u == (tg + 1u) * nx) xb_add(&bar[XB_TOPGEN], 1u);
            else XB_SPIN(xb_ld(&bar[XB_TOPGEN]) == tg, bar);
            __builtin_amdgcn_fence(__ATOMIC_ACQUIRE, "agent");
            xb_add(&bar[XB_XGEN(x)], 1u);
            asm volatile("s_waitcnt vmcnt(0)" ::: "memory");
        } else {
            XB_SPIN(xb_ld(&bar[XB_XGEN(x)]) == gen, bar);
            __builtin_amdgcn_fence(__ATOMIC_ACQUIRE, "agent");
            asm volatile("s_waitcnt vmcnt(0)" ::: "memory");
        }
    }
    __syncthreads();
}

#ifndef PROBE_A
#define PROBE_A 1
#endif
#ifndef PROBE_C
#define PROBE_C 1
#endif
__global__ void __launch_bounds__(NTHR, 2) hymba_fwd(Params pv) {
    extern __shared__ __attribute__((aligned(16))) unsigned char smem[];
    LAS unsigned char* lds = (LAS unsigned char*)smem;
    cg::grid_group grid = cg::this_grid();
    const int bid = blockIdx.x, nb = gridDim.x;
    volatile LAS unsigned* xst = (volatile LAS unsigned*)(lds + LDS_MAIN);
    if (threadIdx.x == 0) { xst[0] = 0u; xst[1] = 0u; (void)xb_add((unsigned*)(pv.ws + WS_BAR) + XB_XCNT(xb_xcc_id()), 1u); }
    __syncthreads();
    const int ph_lo = pv.ph_lo, ph_hi = pv.ph_hi;
    int ph = 0;
#define RUN (ph >= ph_lo && ph < ph_hi)
#if defined(USE_CG_SYNC)
#define SEAM() do { ++ph; if (ph > ph_lo && ph < ph_hi) grid.sync(); } while (0)
#else
#define SEAM() do { ++ph; if (ph > ph_lo && ph < ph_hi) xcd_barrier((unsigned*)(get_params()->ws + WS_BAR), xst); } while (0)
#endif
    if (RUN) { PP p = get_params(); prep_phase(p, lds, bid, nb); }
    if (ph_hi == -12345) grid.sync();
    SEAM();
#pragma unroll 1
    for (int step = 0; step < 12; ++step) {
        const int l = step / 3, ty = step % 3;
        if (step > 0) {
            if (RUN) {
                PP p = get_params();
                float* xres = (float*)(p->ws + WS_X); bf16_t* xn = (bf16_t*)(p->ws + WS_XN);
                const float* part = (const float*)(p->ws + WS_O);
                const int nsp = ty == 2 ? DM / 256 : FF / 256; const float psc = ty == 2 ? 1.f : 0.5f;
                if (ty == 1) rms_phase<1>(xres, p->in[10] + l * DM, xn, nullptr, (float*)(p->ws + WS_BA), p->in[11] + (size_t)l * DM * INC, part, nsp, psc, bid, nb);
                else rms_phase<0>(xres, p->in[ty == 0 ? 6 : 19] + l * DM, xn, nullptr, nullptr, nullptr, part, nsp, psc, bid, nb);
            }
            SEAM();
        }
        if (RUN) {
            PP p = get_params();
            const bf16_t* wl = (const bf16_t*)(p->ws + WS_W) + (size_t)l * WL_ELEMS;
            const bf16_t* xn = (const bf16_t*)(p->ws + WS_XN); bf16_t* hbuf = (bf16_t*)(p->ws + WS_H);
            if (ty == 1) {
                pg8::Gemm g{xn, wl + O_IN, DM, DM / 64}; pg8::StaticOrder S; S.init(TT, HC, nb, bid); pg8::EpiH E{hbuf, HC};
                pg8::gemm_phase(lds, g, S, E);
            } else {
                pg8::Gemm g{xn, wl + (ty == 0 ? O_GU1 : O_GU2), DM, DM / 64}; pg8::StaticOrder S; S.init(TT, 2 * FF, nb, bid); pg8::EpiGU E{hbuf};
                pg8::gemm_phase(lds, g, S, E);
            }
        }
        SEAM();
        if (ty == 1) {
            if (RUN) {
                for (int rep = 0; rep < PROBE_A; ++rep)
                for (int it = bid; it < 1024 + 512; it += nb) {
                    PP p = get_params();
                    if (it < 1024) gdn_stage_a(p, l, it, lds);
                    else if (it + nb < 1024 + 512) { gdn_sample2(p, l, it - 1024, it + nb - 1024, lds); it += nb; }
                    else gdn_sample(p, l, it - 1024, lds);
                }
            }
            SEAM();
            if (RUN) {
                if (bid < 128 || nb < 256) { for (int rep = 0; rep < PROBE_C; ++rep) for (int c = bid; c < 128; c += nb) { PP p = get_params(); gdn_chain(p, l, c, lds); __syncthreads(); } }
                const int sb = nb >= 256 ? bid - 128 : bid, sn = nb >= 256 ? nb - 128 : nb;
                if (sb >= 0) for (int it = sb; it < 512 + 256; it += sn) {
                    PP p = get_params();
                    if (it < 512) swa_prompt(p, l, it, lds);
                    else swa_sample(p, l, it - 512, lds);
                }
            }
            SEAM();
            if (RUN) { PP p = get_params(); finalize_phase(p, l, bid, nb); }
            SEAM();
        }
        if (RUN) {
            PP p = get_params();
            const bf16_t* wl = (const bf16_t*)(p->ws + WS_W) + (size_t)l * WL_ELEMS;
            float* xres = (float*)(p->ws + WS_X);
            const bf16_t* A = ty == 1 ? (const bf16_t*)(p->ws + WS_XN) : (const bf16_t*)(p->ws + WS_H); const bf16_t* Bt = wl + (ty == 0 ? O_DN1 : ty == 1 ? O_OUT : O_DN2);
            const int K = ty == 1 ? DM : FF; const float scale = ty == 1 ? 1.f : 0.5f;
            {
                pg8::Gemm g{A, Bt, K, K / 64}; pg8::StaticOrder S; S.init(TP, DM, nb, bid); pg8::EpiRes E{xres, scale};
                pg8::gemm_phase(lds, g, S, E);
            }
            {
                pg8::Gemm g{A, Bt, K, 4}; pg8::SplitOrder S{TP / 256, TSM / 256, DM / 256, K / 256, 512, nb, bid}; pg8::EpiPart E{(float*)(p->ws + WS_O)};
                pg8::gemm_phase(lds, g, S, E);
            }
        }
        SEAM();
    }
    if (RUN) { PP p = get_params(); rms_phase<2>((float*)(p->ws + WS_X), p->in[23], nullptr, p->out + OUT_Y, nullptr, nullptr, (const float*)(p->ws + WS_O), FF / 256, 0.5f, bid, nb); }
#undef RUN
#undef SEAM
}

extern "C" void kernel_launch(void* const* d_in, const int* in_sizes, int n_in, void* d_out, int out_size, void* d_ws, size_t ws_size, hipStream_t stream) {
    static int grid = 0;
    if (grid == 0) {
        if (n_in != 24 || (size_t)out_size != OUT_END || ws_size < WS_END) { fprintf(stderr, "kernel_launch: unexpected shapes (n_in %d out %d ws %zu need %zu)\n", n_in, out_size, ws_size, (size_t)WS_END); grid = -1; return; }
        int dev = 0, cus = 0, per_cu = 0;
        (void)hipGetDevice(&dev); (void)hipDeviceGetAttribute(&cus, hipDeviceAttributeMultiprocessorCount, dev);
        (void)hipFuncSetAttribute((const void*)hymba_fwd, hipFuncAttributeMaxDynamicSharedMemorySize, LDS_BYTES);
        (void)hipOccupancyMaxActiveBlocksPerMultiprocessor(&per_cu, (const void*)hymba_fwd, NTHR, LDS_BYTES);
        (void)hipGetLastError();
        if (per_cu < 1) fprintf(stderr, "kernel_launch: occupancy query says %d blocks per CU\n", per_cu);
        grid = cus;
    }
    if (grid < 0) return;
    Params p{};
    for (int i = 0; i < 24; ++i) p.in[i] = (const float*)d_in[i];
    p.out = (float*)d_out; p.ws = (unsigned char*)d_ws; p.ph_lo = 0; p.ph_hi = 1 << 20;
    void* args[] = {&p};
    (void)hipMemsetAsync((char*)d_ws + WS_BAR, 0, 16384, stream);
    hipError_t e = hipLaunchCooperativeKernel((const void*)hymba_fwd, dim3(grid), dim3(NTHR), args, LDS_BYTES, stream);
    if (e != hipSuccess) fprintf(stderr, "cooperative launch failed: %s (grid %d)\n", hipGetErrorString(e), grid);
}
```

```cpp
#include <hip/hip_runtime.h>
#include <hip/hip_cooperative_groups.h>
#include <cstdio>
namespace cg = cooperative_groups;

#define LAS __attribute__((address_space(3)))
typedef unsigned short bf16_t;
typedef short bf16x8 __attribute__((ext_vector_type(8)));
typedef float f32x4 __attribute__((ext_vector_type(4)));
typedef float f32x2 __attribute__((ext_vector_type(2)));
typedef unsigned u32x4 __attribute__((ext_vector_type(4)));
typedef unsigned u32x2 __attribute__((ext_vector_type(2)));

constexpr int TP = 16384, TSM = 512, TT = TP + TSM, DM = 1024, FF = 2816, HC = 2816, INC = 2824;
constexpr int C_Z = 1536, C_SQ = 2048, C_SK = 2560, C_SV = 2688;
constexpr int NTHR = 512, LDS_MAIN = 131072, LDS_BYTES = LDS_MAIN + 16;
constexpr size_t E_GU = (size_t)2 * FF * DM, E_DN = (size_t)DM * FF, E_IN = (size_t)HC * DM, E_OUT = (size_t)DM * DM;
constexpr size_t O_GU1 = 0, O_DN1 = O_GU1 + E_GU, O_IN = O_DN1 + E_DN, O_OUT = O_IN + E_IN, O_GU2 = O_OUT + E_OUT, O_DN2 = O_GU2 + E_GU, WL_ELEMS = O_DN2 + E_DN;
constexpr size_t WS_W = 0;
constexpr size_t WS_X = WS_W + 4 * WL_ELEMS * 2;
constexpr size_t WS_XN = WS_X + (size_t)TT * DM * 4;
constexpr size_t WS_H = WS_XN + (size_t)TT * DM * 2;
constexpr size_t WS_O = WS_H + (size_t)TT * HC * 2;
constexpr size_t WS_G = WS_O + (size_t)TT * DM * 4;
constexpr size_t G_ITEM = 8192 * 4 + 4096;
constexpr size_t WS_CD = WS_G + (size_t)1024 * G_ITEM * 2;
constexpr size_t WS_BA = WS_CD + 131072;
constexpr size_t WS_BAR = WS_BA + (size_t)TT * 8 * 4;
constexpr size_t WS_END = WS_BAR + 16384;
constexpr size_t OUT_Y = 0;
constexpr size_t OUT_CONV_P = (size_t)TT * DM;
constexpr size_t OUT_GDN_P = OUT_CONV_P + (size_t)4 * 8 * 3 * 1536;
constexpr size_t OUT_K_P = OUT_GDN_P + (size_t)4 * 8 * 4 * 128 * 128;
constexpr size_t OUT_V_P = OUT_K_P + (size_t)4 * 8 * 128 * 128;
constexpr size_t OUT_CONV_S = OUT_V_P + (size_t)4 * 8 * 128 * 128;
constexpr size_t OUT_GDN_S = OUT_CONV_S + (size_t)4 * 128 * 3 * 1536;
constexpr size_t OUT_K_S = OUT_GDN_S + (size_t)4 * 128 * 4 * 128 * 128;
constexpr size_t OUT_V_S = OUT_K_S + (size_t)4 * 128 * 128 * 128;
constexpr size_t OUT_END = OUT_V_S + (size_t)4 * 128 * 128 * 128;

struct Params {
    const float* in[24];
    float* out;
    unsigned char* ws;
    int ph_lo, ph_hi;
};

typedef const __attribute__((address_space(4))) Params* PP;
__device__ __forceinline__ PP get_params() { PP q = (PP)__builtin_amdgcn_kernarg_segment_ptr(); asm volatile("" : "+s"(q)); return q; }
__device__ __forceinline__ int get_tid() { int t = threadIdx.x; asm volatile("" : "+v"(t)); return t; }
typedef __bf16 bf16x2_t __attribute__((ext_vector_type(2)));
__device__ __forceinline__ unsigned pk2(float lo, float hi) { const f32x2 v = {lo, hi}; return __builtin_bit_cast(unsigned, __builtin_convertvector(v, bf16x2_t)); }
__device__ __forceinline__ float bflo(unsigned w) { return __uint_as_float(w << 16); }
__device__ __forceinline__ float bfhi(unsigned w) { return __uint_as_float(w & 0xffff0000u); }
__device__ __forceinline__ float bf2f(bf16_t b) { return __uint_as_float((unsigned)b << 16); }
__device__ __forceinline__ float wave_sum(float v) {
#pragma unroll
    for (int o = 1; o < 64; o <<= 1) v += __shfl_xor(v, o);
    return v;
}
__device__ __forceinline__ float silu_f(float v) { return v * __builtin_amdgcn_rcpf(1.f + __expf(-v)); }
__device__ __forceinline__ void unpack8(const u32x4 r, float (&f)[8]) {
    f[0] = bflo(r.x); f[1] = bfhi(r.x); f[2] = bflo(r.y); f[3] = bfhi(r.y); f[4] = bflo(r.z); f[5] = bfhi(r.z); f[6] = bflo(r.w); f[7] = bfhi(r.w);
}
#define LDS_WAIT() asm volatile("s_waitcnt lgkmcnt(0)" ::: "memory")

namespace pg8 {
constexpr int BM = 256, BK = 64, HALF = 128, HTB = HALF * BK * 2, STAGE_BYTES = 8 * HTB, NXCD = 8, WGM = 8;
__device__ __forceinline__ int lds_byte(int r, int c) { const int st = (r >> 4) * 2 + (c >> 5), rr = r & 15, cc = c & 31, ob = rr * 64 + cc * 2; return st * 1024 + (ob ^ (((ob >> 9) & 1) << 5)); }
__device__ __forceinline__ void stage_rc(int b, int& R, int& C) { const int st = b / 1024, sb = b % 1024, swz = sb ^ (((sb >> 9) & 1) << 5); R = (st >> 1) * 16 + swz / 64; C = (st & 1) * 32 + (swz % 64) / 2; }
__device__ __forceinline__ int perm32(int rho) { const int n = rho >> 4, i = rho & 15; return 8 * (i >> 2) + 4 * n + (i & 3); }
struct Unit { int pm, pn, koff; };
struct Gemm { const bf16_t* A; const bf16_t* Bt; int ldk, nt; };

struct StaticOrder {
    int nM, nN, nwg, G, c;
    __device__ void init(int M, int N, int G_, int c_) { nM = M / BM; nN = N / BM; nwg = nM * nN; G = G_; c = c_; }
    __device__ bool next(int i, Unit& u) const {
        const long L = (long)i * G + c; if (L >= nwg) return false;
        int wgid = (int)L; { const int q = nwg / NXCD, r = nwg % NXCD, xcd = wgid % NXCD, off = wgid / NXCD; wgid = (xcd < r ? xcd * (q + 1) : r * (q + 1) + (xcd - r) * q) + off; }
        const int nig = WGM * nN, gid = wgid / nig, fm = gid * WGM, gsz = (nM - fm) < WGM ? (nM - fm) : WGM;
        u.pm = fm + ((wgid % nig) % gsz); u.pn = (wgid % nig) / gsz; u.koff = 0; return true;
    }
};
struct SplitOrder {
    int pm0, nM, nN, nsplit, ksb, G, c;
    __device__ bool next(int i, Unit& u) const {
        const int L = i * G + c; if (L >= nM * nN * nsplit) return false;
        const int ks = L / (nM * nN), t = L % (nM * nN);
        u.pm = pm0 + t / nN; u.pn = t % nN; u.koff = ks * ksb; return true;
    }
};

template <class Epi, class Sched>
__device__ __forceinline__ void gemm_phase(LAS unsigned char* lds, const Gemm g, const Sched& S, const Epi& E) {
    const int tid = get_tid(), wid = __builtin_amdgcn_readfirstlane(tid >> 6), lane = tid & 63, wr = wid >> 2, wc = wid & 3, fr = lane & 15, fq = lane >> 4;
    const int K = g.ldk, nt = g.nt;
    unsigned voffA[2], voffB[2];
#pragma unroll
    for (int i = 0; i < 2; ++i) { int R, C; stage_rc(tid * 16 + i * 8192, R, C); const int Rb = Epi::PERM ? ((R & ~31) + perm32(R & 31)) : R;
        voffA[i] = (unsigned)(R * K + C) * 2u; voffB[i] = (unsigned)(Rb * K + C) * 2u; }
    const size_t kstep = (size_t)(BK * 2);
    const size_t hstep = (size_t)HALF * K * 2;
    const size_t tstep = 2 * hstep;
    const unsigned ldsw = (unsigned)wid * 1024u;
    const int aoff = lds_byte(wr * 64 + fr, fq * 8), boff = lds_byte(wc * 32 + fr, fq * 8);
#define PG8_SA(b, h) (((b) * 2 + (h)) * HTB)
#define PG8_SB(b, h) ((4 + (b) * 2 + (h)) * HTB)
#define PG8_STAGE(bufoff, gbase, voff) do { _Pragma("unroll") for (int _i = 0; _i < 2; ++_i) \
        __builtin_amdgcn_global_load_lds((const unsigned*)((const char*)(gbase) + (voff)[_i]), (LAS unsigned*)(lds + (bufoff) + ldsw + _i * 8192), 16, 0, 0); } while (0)
#define PG8_LDA(dst, b, h) do { _Pragma("unroll") for (int m = 0; m < 4; ++m) _Pragma("unroll") for (int k = 0; k < 2; ++k) dst[m][k] = *(const LAS bf16x8*)(lds + PG8_SA(b, h) + aoff + m * 2048 + k * 1024); } while (0)
#define PG8_LDB(dst, b, h) do { _Pragma("unroll") for (int n = 0; n < 2; ++n) _Pragma("unroll") for (int k = 0; k < 2; ++k) dst[n][k] = *(const LAS bf16x8*)(lds + PG8_SB(b, h) + boff + n * 2048 + k * 1024); } while (0)
#define PG8_MMA(ai, bj, At, Bt) do { __builtin_amdgcn_s_setprio(1); _Pragma("unroll") for (int m = 0; m < 4; ++m) _Pragma("unroll") for (int n = 0; n < 2; ++n) _Pragma("unroll") for (int k = 0; k < 2; ++k) \
        acc[ai][bj][m][n] = __builtin_amdgcn_mfma_f32_16x16x32_bf16(Bt[n][k], At[m][k], acc[ai][bj][m][n], 0, 0, 0); __builtin_amdgcn_s_setprio(0); } while (0)
#define PG8_WAIT_V(n) asm volatile("s_waitcnt vmcnt(" #n ")" ::: "memory")
#define PG8_WAIT_L(n) asm volatile("s_waitcnt lgkmcnt(" #n ")" ::: "memory")
#define PG8_BAR __builtin_amdgcn_s_barrier()
#define PG8_SCHED __builtin_amdgcn_sched_barrier(0)
    Unit cur, nxt; int ui = 0;
    if (!S.next(0, cur)) return;
    f32x4 acc[2][2][4][2];
#pragma unroll
    for (int a = 0; a < 2; ++a)
#pragma unroll
        for (int b = 0; b < 2; ++b)
#pragma unroll
            for (int m = 0; m < 4; ++m)
#pragma unroll
                for (int n = 0; n < 2; ++n) acc[a][b][m][n] = (f32x4){0.f, 0.f, 0.f, 0.f};
    bf16x8 At[4][2], B0[2][2], B1[2][2];
    const char* cA = (const char*)g.A + (size_t)cur.pm * tstep + cur.koff; const char* cB = (const char*)g.Bt + (size_t)cur.pn * tstep + cur.koff;
    PG8_STAGE(PG8_SB(0, 0), cB, voffB); PG8_STAGE(PG8_SA(0, 0), cA, voffA); PG8_STAGE(PG8_SB(0, 1), cB + hstep, voffB); PG8_STAGE(PG8_SA(0, 1), cA + hstep, voffA);
    if (wr == 1) PG8_BAR;
    PG8_WAIT_V(4); PG8_BAR;
    PG8_STAGE(PG8_SB(1, 0), cB + kstep, voffB); PG8_STAGE(PG8_SA(1, 0), cA + kstep, voffA); PG8_STAGE(PG8_SB(1, 1), cB + hstep + kstep, voffB);
    PG8_WAIT_V(6); PG8_BAR;
    for (;;) {
        const bool has_next = S.next(ui + 1, nxt);
        const char* nA = has_next ? (const char*)g.A + (size_t)nxt.pm * tstep + nxt.koff : cA; const char* nB = has_next ? (const char*)g.Bt + (size_t)nxt.pn * tstep + nxt.koff : cB;
        for (int t = 0; t < nt; t += 2) {
            const bool last = (t == nt - 2);
            const char* a1 = cA + (size_t)(t + 1) * kstep;
            const char* a2 = last ? nA : cA + (size_t)(t + 2) * kstep; const char* b2 = last ? nB : cB + (size_t)(t + 2) * kstep;
            const char* a3 = a2 + kstep; const char* b3 = b2 + kstep;
            PG8_LDB(B0, 0, 0); PG8_SCHED; PG8_LDA(At, 0, 0); PG8_STAGE(PG8_SA(1, 1), a1 + hstep, voffA);
            PG8_WAIT_L(8); PG8_BAR; PG8_WAIT_L(0); PG8_MMA(0, 0, At, B0); PG8_BAR; PG8_SCHED;
            PG8_LDB(B1, 0, 1); PG8_STAGE(PG8_SB(0, 0), b2, voffB);
            PG8_BAR; PG8_WAIT_L(0); PG8_MMA(0, 1, At, B1); PG8_BAR;
            PG8_LDA(At, 0, 1); PG8_STAGE(PG8_SA(0, 0), a2, voffA);
            PG8_BAR; PG8_WAIT_L(0); PG8_MMA(1, 0, At, B0); PG8_BAR; PG8_SCHED;
            PG8_STAGE(PG8_SB(0, 1), b2 + hstep, voffB);
            PG8_WAIT_V(6); PG8_BAR; PG8_MMA(1, 1, At, B1); PG8_BAR;
            PG8_LDB(B0, 1, 0); PG8_SCHED; PG8_LDA(At, 1, 0); PG8_STAGE(PG8_SA(0, 1), a2 + hstep, voffA);
            PG8_WAIT_L(8); PG8_BAR; PG8_WAIT_L(0); PG8_MMA(0, 0, At, B0); PG8_BAR; PG8_SCHED;
            PG8_LDB(B1, 1, 1); PG8_STAGE(PG8_SB(1, 0), b3, voffB);
            PG8_BAR; PG8_WAIT_L(0); PG8_MMA(0, 1, At, B1); PG8_BAR;
            PG8_LDA(At, 1, 1); PG8_STAGE(PG8_SA(1, 0), a3, voffA);
            PG8_BAR; PG8_WAIT_L(0); PG8_MMA(1, 0, At, B0); PG8_BAR; PG8_SCHED;
            PG8_STAGE(PG8_SB(1, 1), b3 + hstep, voffB);
            PG8_WAIT_V(6); PG8_BAR; PG8_MMA(1, 1, At, B1); PG8_BAR;
        }
        E(acc, cur, wr, wc, fr, fq);
        if (!has_next) break;
#pragma unroll
        for (int a = 0; a < 2; ++a)
#pragma unroll
            for (int b = 0; b < 2; ++b)
#pragma unroll
                for (int m = 0; m < 4; ++m)
#pragma unroll
                    for (int n = 0; n < 2; ++n) acc[a][b][m][n] = (f32x4){0.f, 0.f, 0.f, 0.f};
        cur = nxt; cA = nA; cB = nB; ++ui;
    }
    PG8_WAIT_V(0);
    if (wr == 0) PG8_BAR;
    PG8_BAR;
#undef PG8_SA
#undef PG8_SB
#undef PG8_STAGE
#undef PG8_LDA
#undef PG8_LDB
#undef PG8_MMA
#undef PG8_WAIT_V
#undef PG8_WAIT_L
#undef PG8_BAR
#undef PG8_SCHED
}

struct EpiGU {
    static constexpr bool PERM = true;
    bf16_t* O;
    __device__ __forceinline__ void operator()(const f32x4 (&acc)[2][2][4][2], const Unit& u, int wr, int wc, int fr, int fq) const {
        const int row0 = u.pm * BM + wr * 64 + fr, col0 = u.pn * 128 + wc * 32 + 8 * fq;
#pragma unroll
        for (int ai = 0; ai < 2; ++ai)
#pragma unroll
            for (int m = 0; m < 4; ++m) { bf16_t* rowp = O + (size_t)(row0 + ai * HALF + m * 16) * FF + col0;
                const f32x4 g0 = acc[ai][0][m][0], g1 = acc[ai][0][m][1], u0 = acc[ai][1][m][0], u1 = acc[ai][1][m][1];
                u32x4 w; w.x = pk2(silu_f(g0[0]) * u0[0], silu_f(g0[1]) * u0[1]); w.y = pk2(silu_f(g0[2]) * u0[2], silu_f(g0[3]) * u0[3]);
                w.z = pk2(silu_f(g1[0]) * u1[0], silu_f(g1[1]) * u1[1]); w.w = pk2(silu_f(g1[2]) * u1[2], silu_f(g1[3]) * u1[3]);
                *(u32x4*)rowp = w; }
    }
};
struct EpiH {
    static constexpr bool PERM = true;
    bf16_t* O; int ldc;
    __device__ __forceinline__ void operator()(const f32x4 (&acc)[2][2][4][2], const Unit& u, int wr, int wc, int fr, int fq) const {
        const int row0 = u.pm * BM + wr * 64 + fr, col0 = u.pn * BM + wc * 32 + 8 * fq;
#pragma unroll
        for (int ai = 0; ai < 2; ++ai)
#pragma unroll
            for (int m = 0; m < 4; ++m) { bf16_t* rowp = O + (size_t)(row0 + ai * HALF + m * 16) * ldc + col0;
#pragma unroll
                for (int bj = 0; bj < 2; ++bj) { const f32x4 v0 = acc[ai][bj][m][0], v1 = acc[ai][bj][m][1];
                    u32x4 w; w.x = pk2(v0[0], v0[1]); w.y = pk2(v0[2], v0[3]); w.z = pk2(v1[0], v1[1]); w.w = pk2(v1[2], v1[3]);
                    *(u32x4*)(rowp + bj * HALF) = w; } }
    }
};
struct EpiRes {
    static constexpr bool PERM = false;
    float* X; float scale;
    __device__ __forceinline__ void operator()(const f32x4 (&acc)[2][2][4][2], const Unit& u, int wr, int wc, int fr, int fq) const {
        const int row0 = u.pm * BM + wr * 64 + fr, col0 = u.pn * BM + wc * 32 + 4 * fq;
#pragma unroll
        for (int ai = 0; ai < 2; ++ai) {
            f32x4 t[4][2][2];
#pragma unroll
            for (int m = 0; m < 4; ++m)
#pragma unroll
                for (int bj = 0; bj < 2; ++bj)
#pragma unroll
                    for (int n = 0; n < 2; ++n) t[m][bj][n] = *(const f32x4*)(X + (size_t)(row0 + ai * HALF + m * 16) * DM + col0 + bj * HALF + n * 16);
#pragma unroll
            for (int m = 0; m < 4; ++m)
#pragma unroll
                for (int bj = 0; bj < 2; ++bj)
#pragma unroll
                    for (int n = 0; n < 2; ++n) *(f32x4*)(X + (size_t)(row0 + ai * HALF + m * 16) * DM + col0 + bj * HALF + n * 16) = t[m][bj][n] + acc[ai][bj][m][n] * scale;
        }
    }
};
struct EpiPart {
    static constexpr bool PERM = false;
    float* P;
    __device__ __forceinline__ void operator()(const f32x4 (&acc)[2][2][4][2], const Unit& u, int wr, int wc, int fr, int fq) const {
        const int row0 = u.pm * BM - TP + wr * 64 + fr, col0 = u.pn * BM + wc * 32 + 4 * fq;
        float* base = P + (size_t)(u.koff >> 9) * TSM * DM;
#pragma unroll
        for (int ai = 0; ai < 2; ++ai)
#pragma unroll
            for (int m = 0; m < 4; ++m) { float* rowp = base + (size_t)(row0 + ai * HALF + m * 16) * DM + col0;
#pragma unroll
                for (int bj = 0; bj < 2; ++bj)
#pragma unroll
                    for (int n = 0; n < 2; ++n) *(f32x4*)(rowp + bj * HALF + n * 16) = acc[ai][bj][m][n]; }
    }
};
}

__device__ __forceinline__ void transpose_item(const float* colp, int ld, int k0, bf16_t* dst, int K, LAS float* scr, int lane) {
    float tv[32];
#pragma unroll
    for (int i = 0; i < 32; ++i) tv[i] = colp[(size_t)(k0 + 2 * i + (lane >> 5)) * ld];
#pragma unroll
    for (int i = 0; i < 32; ++i) scr[(2 * i + (lane >> 5)) * 33 + (lane & 31)] = tv[i];
    LDS_WAIT();
    const int c = lane & 7;
#pragma unroll
    for (int j = 0; j < 4; ++j) { const int n = (lane >> 3) + 8 * j; const LAS float* s = scr + (8 * c) * 33 + n;
        u32x4 o; o.x = pk2(s[0 * 33], s[1 * 33]); o.y = pk2(s[2 * 33], s[3 * 33]); o.z = pk2(s[4 * 33], s[5 * 33]); o.w = pk2(s[6 * 33], s[7 * 33]);
        *(u32x4*)(dst + (size_t)n * K + 8 * c) = o; }
    LDS_WAIT();
}
__device__ __forceinline__ void prep_phase(PP p, LAS unsigned char* lds, int bid, int nb) {
    const int tid = get_tid(), lane = tid & 63, wave = tid >> 6;
    LAS float* scr = (LAS float*)(lds + wave * 8448);
    const int gw = bid * 8 + wave, NGW = nb * 8;
    constexpr int I_GU = 16 * 176, I_DN = 44 * 32, I_IN = 16 * 88, I_OUT = 16 * 32, I_L = 2 * I_GU + 2 * I_DN + I_IN + I_OUT;
    for (int it = gw; it < 4 * I_L; it += NGW) {
        const int l = it / I_L; int r = it % I_L;
        bf16_t* wl = (bf16_t*)(p->ws + WS_W) + (size_t)l * WL_ELEMS;
        const float* colp; int ld, K, k0; bf16_t* dst;
        if (r < 2 * I_GU) {
            const int f = r >= I_GU; r -= f * I_GU; const int kb = r / 176, nb32 = r % 176;
            const float* gsrc = p->in[f ? 20 : 7] + (size_t)l * DM * FF; const float* usrc = p->in[f ? 21 : 8] + (size_t)l * DM * FF;
            colp = (((nb32 >> 2) & 1) ? usrc : gsrc) + 128 * (nb32 >> 3) + 32 * (nb32 & 3) + (lane & 31); ld = FF; K = DM; k0 = 64 * kb;
            dst = wl + (f ? O_GU2 : O_GU1) + (size_t)(32 * nb32) * DM + k0;
        } else if (r < 2 * I_GU + 2 * I_DN) {
            r -= 2 * I_GU; const int f = r >= I_DN; r -= f * I_DN; const int kb = r / 32, nb32 = r % 32;
            colp = p->in[f ? 22 : 9] + (size_t)l * FF * DM + 32 * nb32 + (lane & 31); ld = DM; K = FF; k0 = 64 * kb;
            dst = wl + (f ? O_DN2 : O_DN1) + (size_t)(32 * nb32) * FF + k0;
        } else if (r < 2 * I_GU + 2 * I_DN + I_IN) {
            r -= 2 * I_GU + 2 * I_DN; const int kb = r / 88, nb32 = r % 88; const int n = 32 * nb32 + (lane & 31);
            colp = p->in[11] + (size_t)l * DM * INC + (n < 2048 ? n : n + 8); ld = INC; K = DM; k0 = 64 * kb;
            dst = wl + O_IN + (size_t)(32 * nb32) * DM + k0;
        } else {
            r -= 2 * I_GU + 2 * I_DN + I_IN; const int kb = r / 32, nb32 = r % 32;
            colp = p->in[18] + (size_t)l * DM * DM + 32 * nb32 + (lane & 31); ld = DM; K = DM; k0 = 64 * kb;
            dst = wl + O_OUT + (size_t)(32 * nb32) * DM + k0;
        }
        transpose_item(colp, ld, k0, dst, K, scr, lane);
    }
    {
        f32x4 wv[4];
#pragma unroll
        for (int j = 0; j < 4; ++j) wv[j] = ((const f32x4*)p->in[6])[lane + 64 * j];
        for (int row = gw; row < TT; row += NGW) {
            const f32x4* xr = (const f32x4*)(row < TP ? p->in[0] + (size_t)row * DM : p->in[1] + (size_t)(row - TP) * DM) + lane;
            f32x4* xo = (f32x4*)((float*)(p->ws + WS_X) + (size_t)row * DM) + lane;
            f32x4 v[4]; float s = 0.f;
#pragma unroll
            for (int j = 0; j < 4; ++j) { v[j] = xr[64 * j]; xo[64 * j] = v[j]; s += (v[j].x * v[j].x + v[j].y * v[j].y) + (v[j].z * v[j].z + v[j].w * v[j].w); }
            const float rs = rsqrtf(wave_sum(s) * (1.f / DM) + 1e-6f);
            u32x2* o = (u32x2*)((bf16_t*)(p->ws + WS_XN) + (size_t)row * DM) + lane;
#pragma unroll
            for (int j = 0; j < 4; ++j) { const f32x4 t = v[j] * rs * wv[j]; u32x2 q; q.x = pk2(t.x, t.y); q.y = pk2(t.z, t.w); o[64 * j] = q; }
        }
    }
}

__device__ __forceinline__ int row_of(int k, int bid, int wave, int nb) {
    if (nb == 256) {
        if (k < 8) return (bid & 7) * 2048 + ((bid >> 3) * 8 + wave) + 256 * k;
        const int gw = bid * 8 + wave;
        return (k == 8 && gw < TSM) ? TP + gw : -1;
    }
    const int r = bid * 8 + wave + k * nb * 8;
    return r < TT ? r : -1;
}
template <int MODE>
__device__ __forceinline__ void rms_phase(float* x, const float* w, bf16_t* ob, float* of, float* ba, const float* win, const float* part, int nsplit, float pscale, int bid, int nb) {
    const int tid = get_tid(), lane = tid & 63, wave = tid >> 6;
    f32x4 wv[4];
#pragma unroll
    for (int j = 0; j < 4; ++j) wv[j] = ((const f32x4*)w)[lane + 64 * j];
    f32x4 wc0[4][4], wc1[4][4];
    if (MODE == 1) {
#pragma unroll
        for (int j = 0; j < 4; ++j)
#pragma unroll
            for (int e = 0; e < 4; ++e) { const float* wp = win + (size_t)(4 * lane + 256 * j + e) * INC + 2048; wc0[j][e] = *(const f32x4*)wp; wc1[j][e] = *(const f32x4*)(wp + 4); }
    }
    f32x4 nv[4];
    {
        const int r0 = row_of(0, bid, wave, nb);
        if (r0 >= 0) { const f32x4* q = (const f32x4*)(x + (size_t)r0 * DM) + lane;
#pragma unroll
            for (int j = 0; j < 4; ++j) nv[j] = q[64 * j]; }
    }
    for (int kk = 0;; ++kk) {
        const int row = row_of(kk, bid, wave, nb); if (row < 0) break;
        f32x4* xr = (f32x4*)(x + (size_t)row * DM) + lane;
        f32x4 v[4]; float s = 0.f;
#pragma unroll
        for (int j = 0; j < 4; ++j) v[j] = nv[j];
        const int rnext = row_of(kk + 1, bid, wave, nb);
        if (rnext >= 0) { const f32x4* q = (const f32x4*)(x + (size_t)rnext * DM) + lane;
#pragma unroll
            for (int j = 0; j < 4; ++j) nv[j] = q[64 * j]; }
        if (row >= TP && nsplit > 0) {
            f32x4 a[4] = {(f32x4){0.f, 0.f, 0.f, 0.f}, (f32x4){0.f, 0.f, 0.f, 0.f}, (f32x4){0.f, 0.f, 0.f, 0.f}, (f32x4){0.f, 0.f, 0.f, 0.f}};
            for (int ks = 0; ks < nsplit; ++ks) { const f32x4* pr = (const f32x4*)(part + ((size_t)ks * TSM + (row - TP)) * DM) + lane;
#pragma unroll
                for (int j = 0; j < 4; ++j) a[j] += pr[64 * j]; }
#pragma unroll
            for (int j = 0; j < 4; ++j) { v[j] += a[j] * pscale; xr[64 * j] = v[j]; }
        }
#pragma unroll
        for (int j = 0; j < 4; ++j) s += (v[j].x * v[j].x + v[j].y * v[j].y) + (v[j].z * v[j].z + v[j].w * v[j].w);
        const float rs = rsqrtf(wave_sum(s) * (1.f / DM) + 1e-6f);
#pragma unroll
        for (int j = 0; j < 4; ++j) v[j] = v[j] * rs * wv[j];
        if (MODE == 2) {
            f32x4* o = (f32x4*)(of + (size_t)row * DM) + lane;
#pragma unroll
            for (int j = 0; j < 4; ++j) o[64 * j] = v[j];
        } else {
            u32x2* o = (u32x2*)(ob + (size_t)row * DM) + lane;
#pragma unroll
            for (int j = 0; j < 4; ++j) { u32x2 q; q.x = pk2(v[j].x, v[j].y); q.y = pk2(v[j].z, v[j].w); o[64 * j] = q; }
        }
        if (MODE == 1) {
            float a8[8];
#pragma unroll
            for (int c = 0; c < 8; ++c) a8[c] = 0.f;
#pragma unroll
            for (int j = 0; j < 4; ++j)
#pragma unroll
                for (int e = 0; e < 4; ++e) {
                    const f32x4 w0 = wc0[j][e], w1 = wc1[j][e]; const float xv = v[j][e];
                    a8[0] += xv * w0.x; a8[1] += xv * w0.y; a8[2] += xv * w0.z; a8[3] += xv * w0.w; a8[4] += xv * w1.x; a8[5] += xv * w1.y; a8[6] += xv * w1.z; a8[7] += xv * w1.w;
                }
#pragma unroll
            for (int c = 0; c < 8; ++c) a8[c] = wave_sum(a8[c]);
            if (lane == 0) { *(f32x4*)(ba + (size_t)row * 8) = (f32x4){a8[0], a8[1], a8[2], a8[3]}; *(f32x4*)(ba + (size_t)row * 8 + 4) = (f32x4){a8[4], a8[5], a8[6], a8[7]}; }
        }
    }
}

__device__ __forceinline__ void gdn_stage_a(PP p, int l, int it, LAS unsigned char* lds) {
    const int tid = get_tid(), lane = tid & 63, wave = tid >> 6;
    const int hh = it & 3, n = (it >> 2) & 31, b = it >> 7;
    const int t0 = b * 2048 + n * 64;
    const bf16_t* hb = (const bf16_t*)(p->ws + WS_H);
    const float* ba = (const float*)(p->ws + WS_BA);
    bf16_t* gi_base = (bf16_t*)(p->ws + WS_G) + (size_t)it * G_ITEM;
    bf16_t* wg = gi_base; bf16_t* kcg = gi_base + 8192; bf16_t* qdg = gi_base + 16384; bf16_t* kdtg = gi_base + 24576; bf16_t* qkg = gi_base + 32768;
    LAS float* gcs = (LAS float*)lds;
    LAS float* bet = gcs + 64;
    LAS float* AT = (LAS float*)(lds + 1024);
    LAS float* vr = AT + 64 * 68;
    LAS float* kr = vr + 64 * 128;
    LAS bf16_t* qb = (LAS bf16_t*)(kr + 64 * 128);
    LAS bf16_t* kb = qb + 64 * 136;
    if (wave == 7) {
        const float av = ba[(size_t)(t0 + lane) * 8 + 4 + hh] + p->in[14][l * 4 + hh];
        const float bv = ba[(size_t)(t0 + lane) * 8 + hh];
        const float sp = av > 20.f ? av : log1pf(expf(av));
        float g = -expf(p->in[13][l * 4 + hh]) * sp;
#pragma unroll
        for (int o = 1; o < 64; o <<= 1) { const float t = __shfl_up(g, o); if (lane >= o) g += t; }
        gcs[lane] = g; bet[lane] = 1.f / (1.f + expf(-bv));
    }
    const int tb = tid / 48, r48 = tid % 48, part = r48 >> 4, gi = r48 & 15;
    const int cb = part * 512 + hh * 128 + gi * 8;
    const int tok0 = tb * 8;
    float o[8][8], ss[8];
    if (tid < 384) {
        float cw[4][8];
        const float* cwp = p->in[12] + (size_t)l * 4 * 1536 + cb;
#pragma unroll
        for (int i = 0; i < 4; ++i) { const f32x4 a = *(const f32x4*)(cwp + i * 1536), c = *(const f32x4*)(cwp + i * 1536 + 4);
            cw[i][0] = a.x; cw[i][1] = a.y; cw[i][2] = a.z; cw[i][3] = a.w; cw[i][4] = c.x; cw[i][5] = c.y; cw[i][6] = c.z; cw[i][7] = c.w; }
        float win[3][8];
#pragma unroll
        for (int i = 0; i < 3; ++i) {
            const int tl = tok0 - 3 + i;
            if (n > 0 || tl >= 0) { const u32x4 raw = *(const u32x4*)(hb + (size_t)(t0 + tl) * HC + cb); unpack8(raw, win[i]); }
            else {
#pragma unroll
                for (int c = 0; c < 8; ++c) win[i][c] = 0.f; }
        }
#pragma unroll
        for (int tt = 0; tt < 8; ++tt) {
            float cur[8];
            const u32x4 raw = *(const u32x4*)(hb + (size_t)(t0 + tok0 + tt) * HC + cb); unpack8(raw, cur);
            float s2 = 0.f;
#pragma unroll
            for (int c = 0; c < 8; ++c) { float v = cw[0][c] * win[0][c] + cw[1][c] * win[1][c] + cw[2][c] * win[2][c] + cw[3][c] * cur[c]; v = silu_f(v); o[tt][c] = v; s2 += v * v; }
            ss[tt] = s2;
            if (n == 31 && tb == 7 && tt >= 5) {
                float* cp = p->out + OUT_CONV_P + ((size_t)(l * 8 + b) * 3 + (tt - 5)) * 1536 + cb;
                *(f32x4*)cp = (f32x4){cur[0], cur[1], cur[2], cur[3]}; *(f32x4*)(cp + 4) = (f32x4){cur[4], cur[5], cur[6], cur[7]};
            }
#pragma unroll
            for (int c = 0; c < 8; ++c) { win[0][c] = win[1][c]; win[1][c] = win[2][c]; win[2][c] = cur[c]; }
        }
#pragma unroll
        for (int tt = 0; tt < 8; ++tt) {
            float s2 = ss[tt];
            s2 += __shfl_xor(s2, 1); s2 += __shfl_xor(s2, 2); s2 += __shfl_xor(s2, 4); s2 += __shfl_xor(s2, 8);
            ss[tt] = rsqrtf(s2 + 1e-6f);
        }
    }
    __syncthreads();
    const float gc_last = gcs[63];
    if (tid < 384) {
        if (part == 0) {
#pragma unroll
            for (int tt = 0; tt < 8; ++tt) {
                const int tok = tok0 + tt; const float sc = ss[tt] * 0.08838834764831845f; const float eg = __expf(gcs[tok]);
                float q[8];
#pragma unroll
                for (int c = 0; c < 8; ++c) q[c] = o[tt][c] * sc;
                u32x4 w; w.x = pk2(q[0], q[1]); w.y = pk2(q[2], q[3]); w.z = pk2(q[4], q[5]); w.w = pk2(q[6], q[7]);
                *(LAS u32x4*)(qb + tok * 136 + gi * 8) = w;
                u32x4 d; d.x = pk2(q[0] * eg, q[1] * eg); d.y = pk2(q[2] * eg, q[3] * eg); d.z = pk2(q[4] * eg, q[5] * eg); d.w = pk2(q[6] * eg, q[7] * eg);
                *(u32x4*)(qdg + tok * 128 + gi * 8) = d;
            }
        } else if (part == 1) {
            float ed[8];
#pragma unroll
            for (int tt = 0; tt < 8; ++tt) {
                const int tok = tok0 + tt; const float sc = ss[tt]; const float gct = gcs[tok]; const float be = bet[tok] * __expf(gct);
                ed[tt] = __expf(gc_last - gct);
#pragma unroll
                for (int c = 0; c < 8; ++c) o[tt][c] *= sc;
                u32x4 w; w.x = pk2(o[tt][0], o[tt][1]); w.y = pk2(o[tt][2], o[tt][3]); w.z = pk2(o[tt][4], o[tt][5]); w.w = pk2(o[tt][6], o[tt][7]);
                *(LAS u32x4*)(kb + tok * 136 + gi * 8) = w;
                *(LAS f32x4*)(kr + tok * 128 + gi * 8) = (f32x4){o[tt][0] * be, o[tt][1] * be, o[tt][2] * be, o[tt][3] * be};
                *(LAS f32x4*)(kr + tok * 128 + gi * 8 + 4) = (f32x4){o[tt][4] * be, o[tt][5] * be, o[tt][6] * be, o[tt][7] * be};
            }
#pragma unroll
            for (int c = 0; c < 8; ++c) {
                u32x4 w; w.x = pk2(o[0][c] * ed[0], o[1][c] * ed[1]); w.y = pk2(o[2][c] * ed[2], o[3][c] * ed[3]); w.z = pk2(o[4][c] * ed[4], o[5][c] * ed[5]); w.w = pk2(o[6][c] * ed[6], o[7][c] * ed[7]);
                *(u32x4*)(kdtg + (gi * 8 + c) * 64 + tok0) = w;
            }
        } else {
#pragma unroll
            for (int tt = 0; tt < 8; ++tt) {
                const int tok = tok0 + tt; const float be = bet[tok];
                *(LAS f32x4*)(vr + tok * 128 + gi * 8) = (f32x4){o[tt][0] * be, o[tt][1] * be, o[tt][2] * be, o[tt][3] * be};
                *(LAS f32x4*)(vr + tok * 128 + gi * 8 + 4) = (f32x4){o[tt][4] * be, o[tt][5] * be, o[tt][6] * be, o[tt][7] * be};
            }
        }
    }
    if (tid == 0) ((float*)(p->ws + WS_CD))[it * 32] = __expf(gc_last);
    __syncthreads();
    {
        const int prod = wave >> 2, I = wave & 3, fr = lane & 15, fq = lane >> 4;
        const LAS bf16_t* X = prod ? qb : kb;
        bf16x8 af[4];
#pragma unroll
        for (int ks = 0; ks < 4; ++ks) af[ks] = *(const LAS bf16x8*)(X + (16 * I + fr) * 136 + ks * 32 + fq * 8);
        const int i0 = 16 * I + 4 * fq;
        float gci[4];
#pragma unroll
        for (int r = 0; r < 4; ++r) gci[r] = gcs[i0 + r];
#pragma unroll
        for (int J = 0; J < 4; ++J) {
            f32x4 acc = (f32x4){0.f, 0.f, 0.f, 0.f};
            if (J <= I) {
#pragma unroll
                for (int ks = 0; ks < 4; ++ks) { const bf16x8 bfr = *(const LAS bf16x8*)(kb + (16 * J + fr) * 136 + ks * 32 + fq * 8); acc = __builtin_amdgcn_mfma_f32_16x16x32_bf16(af[ks], bfr, acc, 0, 0, 0); }
            }
            const int j = 16 * J + fr; const float gcj = gcs[j];
            if (prod == 0) {
                if (J <= I) {
                    f32x4 o4;
#pragma unroll
                    for (int r = 0; r < 4; ++r) { const int i = i0 + r; o4[r] = (i > j) ? bet[i] * acc[r] * __expf(gci[r] - gcj) : 0.f; }
                    *(LAS f32x4*)(AT + j * 68 + i0) = o4;
                }
            } else {
#pragma unroll
                for (int r = 0; r < 4; ++r) { const int i = i0 + r; const float v = (i >= j) ? acc[r] * __expf(gci[r] - gcj) : 0.f; qkg[i * 64 + j] = (bf16_t)(pk2(v, 0.f) & 0xffffu); }
            }
        }
    }
    __syncthreads();
    if (tid < 256) {
        const LAS float* src = tid < 128 ? vr + tid : kr + (tid - 128);
        f32x2 ap[32];
#pragma unroll
        for (int k = 0; k < 32; ++k) ap[k] = (f32x2){src[(2 * k) * 128], src[(2 * k + 1) * 128]};
        f32x4 cur[16], nxt[16];
#pragma unroll
        for (int c = 0; c < 16; ++c) cur[c] = *(const LAS f32x4*)(AT + 4 * c);
#pragma unroll
        for (int j = 0; j < 63; ++j) {
#pragma unroll
            for (int c = 0; c < 16; ++c) if (j < 62 && 4 * c + 3 > j + 1) nxt[c] = *(const LAS f32x4*)(AT + (j + 1) * 68 + 4 * c);
            __builtin_amdgcn_sched_barrier(0);
            const float xj = (j & 1) ? ap[j >> 1].y : ap[j >> 1].x;
            if (!(j & 1)) ap[j >> 1].y -= cur[j >> 2][(j & 3) + 1] * xj;
#pragma unroll
            for (int k = (j >> 1) + 1; k < 32; ++k) { const int c = k >> 1, lo = (k & 1) * 2; ap[k] -= (f32x2){cur[c][lo], cur[c][lo + 1]} * xj; }
            __builtin_amdgcn_sched_barrier(0);
#pragma unroll
            for (int c = 0; c < 16; ++c) cur[c] = nxt[c];
        }
        bf16_t* dst = tid < 128 ? wg + tid : kcg + (tid - 128);
#pragma unroll
        for (int k = 0; k < 32; ++k) { const unsigned w2 = pk2(ap[k].x, ap[k].y); dst[(2 * k) * 128] = (bf16_t)(w2 & 0xffffu); dst[(2 * k + 1) * 128] = (bf16_t)(w2 >> 16); }
    }
    __syncthreads();
}

__device__ __forceinline__ void gdn_sample(PP p, int l, int it, LAS unsigned char* lds) {
    const int tid = get_tid(), lane = tid & 63, wave = tid >> 6;
    const int hh = it & 3, b = it >> 2;
    const bf16_t* hb = (const bf16_t*)(p->ws + WS_H);
    const float* ba = (const float*)(p->ws + WS_BA);
    float* oraw = (float*)(p->ws + WS_O);
    LAS float* val = (LAS float*)lds;
    LAS float* valn = val + 4 * 384;
    LAS float* red = valn + 4 * 256;
    LAS float* kqs = red + 4 * 2 * 512;
    const int trow = TP + b * 4;
    const int dv = tid & 127, kq = tid >> 7;
    const size_t sbase = ((size_t)(l * 128 + b) * 4 + hh) * 16384 + (size_t)(32 * kq) * 128 + dv;
    if (tid < 384) {
        const int part = tid >> 7, d = tid & 127, col = part * 512 + hh * 128 + d;
        float full[7];
#pragma unroll
        for (int r = 0; r < 3; ++r) full[r] = p->in[2][((size_t)(l * 128 + b) * 3 + r) * 1536 + col];
#pragma unroll
        for (int i = 0; i < 4; ++i) full[3 + i] = bf2f(hb[(size_t)(trow + i) * HC + col]);
        float cw[4];
#pragma unroll
        for (int i = 0; i < 4; ++i) cw[i] = p->in[12][((size_t)l * 4 + i) * 1536 + col];
#pragma unroll
        for (int t = 0; t < 4; ++t) val[t * 384 + tid] = silu_f(cw[0] * full[t] + cw[1] * full[t + 1] + cw[2] * full[t + 2] + cw[3] * full[t + 3]);
#pragma unroll
        for (int r = 0; r < 3; ++r) p->out[OUT_CONV_S + ((size_t)(l * 128 + b) * 3 + r) * 1536 + col] = full[4 + r];
    }
    __syncthreads();
    {
        const int t = wave & 3, part = wave >> 2;
        const float q0 = val[t * 384 + lane], q1 = val[t * 384 + 64 + lane], k0 = val[t * 384 + 128 + lane], k1 = val[t * 384 + 192 + lane];
        const float scq = rsqrtf(wave_sum(q0 * q0 + q1 * q1) + 1e-6f) * 0.08838834764831845f, sck = rsqrtf(wave_sum(k0 * k0 + k1 * k1) + 1e-6f);
        const float dqk = wave_sum(q0 * k0 + q1 * k1);
        if (part == 0) { valn[t * 256 + lane] = q0 * scq; valn[t * 256 + 64 + lane] = q1 * scq; if (lane == 0) kqs[t] = dqk * scq * sck; }
        else { valn[t * 256 + 128 + lane] = k0 * sck; valn[t * 256 + 192 + lane] = k1 * sck; }
    }
    float dec[4], beta[4];
    {
        const float alog = -expf(p->in[13][l * 4 + hh]), dtb = p->in[14][l * 4 + hh];
#pragma unroll
        for (int t = 0; t < 4; ++t) {
            const float av = ba[(size_t)(trow + t) * 8 + 4 + hh] + dtb, bv = ba[(size_t)(trow + t) * 8 + hh];
            const float sp = av > 20.f ? av : log1pf(expf(av));
            dec[t] = expf(alog * sp); beta[t] = 1.f / (1.f + expf(-bv));
        }
    }
    __syncthreads();
    float S[32];
#pragma unroll
    for (int i = 0; i < 32; ++i) S[i] = p->in[3][sbase + (size_t)i * 128];
#pragma unroll
    for (int t = 0; t < 4; ++t) {
        const LAS float* qv = valn + t * 256 + 32 * kq; const LAS float* kv = qv + 128;
        float pk = 0.f, pq = 0.f;
#pragma unroll
        for (int i = 0; i < 32; ++i) { S[i] *= dec[t]; pk += S[i] * kv[i]; pq += S[i] * qv[i]; }
        LAS float* r0 = red + (t * 2 + 0) * 512; LAS float* r1 = red + (t * 2 + 1) * 512;
        r0[kq * 128 + dv] = pk; r1[kq * 128 + dv] = pq;
        __syncthreads();
        const float sk = (r0[dv] + r0[128 + dv]) + (r0[256 + dv] + r0[384 + dv]);
        const float u = beta[t] * (val[t * 384 + 256 + dv] - sk);
#pragma unroll
        for (int i = 0; i < 32; ++i) S[i] += kv[i] * u;
        if (kq == 0) oraw[(size_t)(trow + t) * DM + hh * 128 + dv] = ((r1[dv] + r1[128 + dv]) + (r1[256 + dv] + r1[384 + dv])) + u * kqs[t];
    }
    float* so = p->out + OUT_GDN_S + sbase;
#pragma unroll
    for (int i = 0; i < 32; ++i) so[(size_t)i * 128] = S[i];
    __syncthreads();
}

__device__ __forceinline__ void swa_prompt(PP p, int l, int it, LAS unsigned char* lds) {
    const int tid = get_tid(), lane = tid & 63, wave = tid >> 6, fr = lane & 15, fq = lane >> 4;
    const int rr = it >> 3, pr = (rr >> 5) * 8 + (it & 7), qt = rr & 31, b = pr >> 1, kvh = pr & 1;
    const int q0 = qt * 64, kbase = q0 - 128;
    const bf16_t* hb = (const bf16_t*)(p->ws + WS_H) + (size_t)(b * 2048) * HC;
    float* oraw = (float*)(p->ws + WS_O) + (size_t)(b * 2048) * DM;
    LAS bf16_t* Ks = (LAS bf16_t*)lds;
    LAS bf16_t* VT = Ks + 192 * 72;
#pragma unroll
    for (int i = 0; i < 3; ++i) {
        const int id = tid + 512 * i, row = id >> 3, c8 = id & 7, kp = kbase + row;
        u32x4 kr4 = (u32x4){0u, 0u, 0u, 0u}, vr4 = kr4;
        if (kp >= 0) { kr4 = *(const u32x4*)(hb + (size_t)kp * HC + C_SK + kvh * 64 + c8 * 8); vr4 = *(const u32x4*)(hb + (size_t)kp * HC + C_SV + kvh * 64 + c8 * 8); }
        *(LAS u32x4*)(Ks + row * 72 + c8 * 8) = kr4;
        LAS bf16_t* vt = VT + (c8 * 8) * 200 + row;
        vt[0 * 200] = (bf16_t)(vr4.x & 0xffffu); vt[1 * 200] = (bf16_t)(vr4.x >> 16); vt[2 * 200] = (bf16_t)(vr4.y & 0xffffu); vt[3 * 200] = (bf16_t)(vr4.y >> 16);
        vt[4 * 200] = (bf16_t)(vr4.z & 0xffffu); vt[5 * 200] = (bf16_t)(vr4.z >> 16); vt[6 * 200] = (bf16_t)(vr4.w & 0xffffu); vt[7 * 200] = (bf16_t)(vr4.w >> 16);
        if (qt >= 30 && row >= 128) {
            float kf[8], vf[8]; unpack8(kr4, kf); unpack8(vr4, vf);
            const size_t o = ((size_t)(l * 8 + b) * 128 + (kp - 1920)) * 128 + kvh * 64 + c8 * 8;
            *(f32x4*)(p->out + OUT_K_P + o) = (f32x4){kf[0], kf[1], kf[2], kf[3]}; *(f32x4*)(p->out + OUT_K_P + o + 4) = (f32x4){kf[4], kf[5], kf[6], kf[7]};
            *(f32x4*)(p->out + OUT_V_P + o) = (f32x4){vf[0], vf[1], vf[2], vf[3]}; *(f32x4*)(p->out + OUT_V_P + o + 4) = (f32x4){vf[4], vf[5], vf[6], vf[7]};
        }
    }
    const int g = wave >> 1, half = wave & 1, hq = kvh * 4 + g;
    const int qrow0 = q0 + 32 * half, kl0 = 32 * half;
    bf16x8 qf[2][2];
#pragma unroll
    for (int qt2 = 0; qt2 < 2; ++qt2)
#pragma unroll
        for (int ks = 0; ks < 2; ++ks) qf[qt2][ks] = *(const bf16x8*)(hb + (size_t)(qrow0 + 16 * qt2 + fr) * HC + C_SQ + hq * 64 + ks * 32 + fq * 8);
    __syncthreads();
    f32x4 sacc[2][10];
#pragma unroll
    for (int kt = 0; kt < 10; ++kt) {
        bf16x8 kf[2];
#pragma unroll
        for (int ks = 0; ks < 2; ++ks) kf[ks] = *(const LAS bf16x8*)(Ks + (kl0 + 16 * kt + fr) * 72 + ks * 32 + fq * 8);
#pragma unroll
        for (int qt2 = 0; qt2 < 2; ++qt2) {
            f32x4 a = (f32x4){0.f, 0.f, 0.f, 0.f};
            a = __builtin_amdgcn_mfma_f32_16x16x32_bf16(kf[0], qf[qt2][0], a, 0, 0, 0);
            a = __builtin_amdgcn_mfma_f32_16x16x32_bf16(kf[1], qf[qt2][1], a, 0, 0, 0);
            sacc[qt2][kt] = a;
        }
    }
    const float sink = p->in[16][l * 8 + hq];
    float inv[2];
    bf16x8 pf[2][5];
#pragma unroll
    for (int qt2 = 0; qt2 < 2; ++qt2) {
        float m = sink;
#pragma unroll
        for (int kt = 0; kt < 10; ++kt)
#pragma unroll
            for (int r = 0; r < 4; ++r) {
                const int diff = 128 + 16 * qt2 + fr - 16 * kt - 4 * fq - r;
                const int kp = kbase + kl0 + 16 * kt + 4 * fq + r;
                const bool ok = (diff >= 0) && (diff < 128) && (kp >= 0);
                const float s = ok ? sacc[qt2][kt][r] * 0.125f : -__builtin_inff();
                sacc[qt2][kt][r] = s; m = fmaxf(m, s);
            }
        m = fmaxf(m, __shfl_xor(m, 16)); m = fmaxf(m, __shfl_xor(m, 32));
        float sum = 0.f;
#pragma unroll
        for (int kt = 0; kt < 10; ++kt)
#pragma unroll
            for (int r = 0; r < 4; ++r) { const float e = __expf(sacc[qt2][kt][r] - m); sacc[qt2][kt][r] = e; sum += e; }
        sum += __shfl_xor(sum, 16); sum += __shfl_xor(sum, 32);
        sum += __expf(sink - m);
        inv[qt2] = 1.f / sum;
#pragma unroll
        for (int s5 = 0; s5 < 5; ++s5) {
            const f32x4 a = sacc[qt2][2 * s5], c = sacc[qt2][2 * s5 + 1];
            u32x4 w; w.x = pk2(a[0], a[1]); w.y = pk2(a[2], a[3]); w.z = pk2(c[0], c[1]); w.w = pk2(c[2], c[3]);
            pf[qt2][s5] = __builtin_bit_cast(bf16x8, w);
        }
    }
#pragma unroll
    for (int dt = 0; dt < 4; ++dt) {
        f32x4 oa[2] = {(f32x4){0.f, 0.f, 0.f, 0.f}, (f32x4){0.f, 0.f, 0.f, 0.f}};
#pragma unroll
        for (int s5 = 0; s5 < 5; ++s5) {
            const LAS bf16_t* vp = VT + (16 * dt + fr) * 200 + kl0 + 32 * s5 + 4 * fq;
            const u32x2 lo = *(const LAS u32x2*)vp, hi = *(const LAS u32x2*)(vp + 16);
            const bf16x8 vf = __builtin_bit_cast(bf16x8, (u32x4){lo.x, lo.y, hi.x, hi.y});
            oa[0] = __builtin_amdgcn_mfma_f32_16x16x32_bf16(vf, pf[0][s5], oa[0], 0, 0, 0);
            oa[1] = __builtin_amdgcn_mfma_f32_16x16x32_bf16(vf, pf[1][s5], oa[1], 0, 0, 0);
        }
#pragma unroll
        for (int qt2 = 0; qt2 < 2; ++qt2)
            *(f32x4*)(oraw + (size_t)(qrow0 + 16 * qt2 + fr) * DM + 512 + hq * 64 + 16 * dt + 4 * fq) = oa[qt2] * inv[qt2];
    }
    __syncthreads();
}

__device__ __forceinline__ void swa_sample(PP p, int l, int it, LAS unsigned char* lds) {
    const int tid = get_tid(), lane = tid & 63, wave = tid >> 6;
    const int kvh = it & 1, b = it >> 1;
    const bf16_t* hb = (const bf16_t*)(p->ws + WS_H) + (size_t)(TP + b * 4) * HC;
    float* oraw = (float*)(p->ws + WS_O) + (size_t)(TP + b * 4) * DM;
    LAS float* Kc = (LAS float*)lds;
    LAS float* Vc = Kc + 132 * 68;
    LAS float* Qs = Vc + 132 * 68;
    LAS float* sc = Qs + 16 * 64;
    for (int id = tid; id < 132 * 16; id += NTHR) {
        const int row = id >> 4, c4 = (id & 15) * 4;
        f32x4 kv, vv;
        if (row < 128) {
            const size_t o = ((size_t)(l * 128 + b) * 128 + row) * 128 + kvh * 64 + c4;
            kv = *(const f32x4*)(p->in[4] + o); vv = *(const f32x4*)(p->in[5] + o);
        } else {
            const bf16_t* hp = hb + (size_t)(row - 128) * HC + kvh * 64 + c4;
            const u32x2 kr = *(const u32x2*)(hp + C_SK), vr = *(const u32x2*)(hp + C_SV);
            kv = (f32x4){bflo(kr.x), bfhi(kr.x), bflo(kr.y), bfhi(kr.y)}; vv = (f32x4){bflo(vr.x), bfhi(vr.x), bflo(vr.y), bfhi(vr.y)};
        }
        *(LAS f32x4*)(Kc + row * 68 + c4) = kv; *(LAS f32x4*)(Vc + row * 68 + c4) = vv;
        if (row >= 4) {
            const size_t o = ((size_t)(l * 128 + b) * 128 + (row - 4)) * 128 + kvh * 64 + c4;
            *(f32x4*)(p->out + OUT_K_S + o) = kv; *(f32x4*)(p->out + OUT_V_S + o) = vv;
        }
    }
    for (int id = tid; id < 16 * 64; id += NTHR) {
        const int row = id >> 6, d = id & 63, g = row >> 2, i = row & 3;
        Qs[id] = bf2f(hb[(size_t)i * HC + C_SQ + (kvh * 4 + g) * 64 + d]);
    }
    __syncthreads();
    for (int id = tid; id < 16 * 132; id += NTHR) {
        const int row = id / 132, key = id % 132, i = row & 3;
        const LAS float* kp = Kc + key * 68; const LAS float* qp = Qs + row * 64;
        float s = 0.f;
#pragma unroll
        for (int d = 0; d < 64; d += 4) { const f32x4 a = *(const LAS f32x4*)(kp + d), c = *(const LAS f32x4*)(qp + d); s += (a.x * c.x + a.y * c.y) + (a.z * c.z + a.w * c.w); }
        const bool ok = (key >= i + 1) && (key <= i + 128);
        sc[row * 136 + key] = ok ? s * 0.125f : -__builtin_inff();
    }
    __syncthreads();
#pragma unroll
    for (int rr = 0; rr < 2; ++rr) {
        const int row = wave * 2 + rr, g = row >> 2;
        const float sink = p->in[16][l * 8 + kvh * 4 + g];
        const float s0 = sc[row * 136 + lane], s1 = sc[row * 136 + 64 + lane], s2 = lane < 4 ? sc[row * 136 + 128 + lane] : -__builtin_inff();
        float m = fmaxf(fmaxf(s0, s1), fmaxf(s2, sink));
#pragma unroll
        for (int o = 1; o < 64; o <<= 1) m = fmaxf(m, __shfl_xor(m, o));
        const float e0 = __expf(s0 - m), e1 = __expf(s1 - m), e2 = __expf(s2 - m);
        const float inv = 1.f / (wave_sum(e0 + e1 + e2) + __expf(sink - m));
        sc[row * 136 + lane] = e0 * inv; sc[row * 136 + 64 + lane] = e1 * inv; if (lane < 4) sc[row * 136 + 128 + lane] = e2 * inv;
    }
    __syncthreads();
    {
        const int row = tid >> 5, d2 = (tid & 31) * 2, g = row >> 2, i = row & 3;
        float o0 = 0.f, o1 = 0.f;
#pragma unroll 6
        for (int key = 0; key < 132; ++key) { const float pr = sc[row * 136 + key]; const f32x2 v = *(const LAS f32x2*)(Vc + key * 68 + d2); o0 += pr * v.x; o1 += pr * v.y; }
        *(f32x2*)(oraw + (size_t)i * DM + 512 + (kvh * 4 + g) * 64 + d2) = (f32x2){o0, o1};
    }
    __syncthreads();
}

__device__ __forceinline__ void gdn_chain(PP p, int l, int c, LAS unsigned char* lds) {
    const int tid = get_tid(), lane = tid & 63, wave = tid >> 6, fr = lane & 15, fq = lane >> 4;
    const int xg = c & 7, jg = c >> 3, vs = jg & 3, grp = (jg >> 2) * 8 + xg, hh = grp & 3, b = grp >> 2;
    float* oraw = (float*)(p->ws + WS_O);
    const float* cdg = (const float*)(p->ws + WS_CD);
    LAS bf16_t* STb = (LAS bf16_t*)lds;
    LAS bf16_t* kcs = STb + 32 * 136;
    LAS bf16_t* qds = kcs + 64 * 136;
    LAS bf16_t* kdts = qds + 64 * 136;
    LAS bf16_t* qks = kdts + 128 * 72;
    LAS bf16_t* wsl = qks + 64 * 72;
    LAS bf16_t* uT = wsl + 64 * 40;
    u32x4 rk[2], rq[2], rd[2], rqk, rw;
    auto prefetch = [&](int n) {
        const bf16_t* gb = (const bf16_t*)(p->ws + WS_G) + (size_t)(((b * 32 + n) << 2) + hh) * G_ITEM;
#pragma unroll
        for (int i = 0; i < 2; ++i) { const int id = tid + 512 * i;
            rk[i] = *(const u32x4*)(gb + 8192 + (id >> 4) * 128 + (id & 15) * 8);
            rq[i] = *(const u32x4*)(gb + 16384 + (id >> 4) * 128 + (id & 15) * 8);
            rd[i] = *(const u32x4*)(gb + 24576 + (id >> 3) * 64 + (id & 7) * 8); }
        rqk = *(const u32x4*)(gb + 32768 + (tid >> 3) * 64 + (tid & 7) * 8);
        if (tid < 256) rw = *(const u32x4*)(gb + (tid >> 2) * 128 + 32 * vs + (tid & 3) * 8);
    };
    auto commit = [&]() {
#pragma unroll
        for (int i = 0; i < 2; ++i) { const int id = tid + 512 * i;
            *(LAS u32x4*)(kcs + (id >> 4) * 136 + (id & 15) * 8) = rk[i];
            *(LAS u32x4*)(qds + (id >> 4) * 136 + (id & 15) * 8) = rq[i];
            *(LAS u32x4*)(kdts + (id >> 3) * 72 + (id & 7) * 8) = rd[i]; }
        *(LAS u32x4*)(qks + (tid >> 3) * 72 + (tid & 7) * 8) = rqk;
        if (tid < 256) *(LAS u32x4*)(wsl + (tid >> 2) * 40 + (tid & 3) * 8) = rw;
    };
    LAS float* cds = (LAS float*)(uT + 32 * 72);
    if (tid < 32) cds[tid] = cdg[(((b * 32 + tid) << 2) + hh) * 32];
    prefetch(0);
    for (int i = tid; i < 32 * 136 / 2; i += NTHR) ((LAS unsigned*)STb)[i] = 0u;
    commit();
    f32x4 sa[2] = {(f32x4){0.f, 0.f, 0.f, 0.f}, (f32x4){0.f, 0.f, 0.f, 0.f}};
    const int I = wave >> 1, Jt = wave & 1;
    __syncthreads();
    for (int n = 0; n < 32; ++n) {
        const float cd = cds[n];
        if (n + 1 < 32) prefetch(n + 1);
        bf16x8 sfr[4];
        {
            f32x4 a = (f32x4){0.f, 0.f, 0.f, 0.f};
            bf16x8 af[4];
#pragma unroll
            for (int ks = 0; ks < 4; ++ks) { af[ks] = *(const LAS bf16x8*)(kcs + (16 * I + fr) * 136 + ks * 32 + fq * 8); sfr[ks] = *(const LAS bf16x8*)(STb + (16 * Jt + fr) * 136 + ks * 32 + fq * 8); }
            float w4[4];
#pragma unroll
            for (int r = 0; r < 4; ++r) w4[r] = bf2f(wsl[(16 * I + 4 * fq + r) * 40 + 16 * Jt + fr]);
            __builtin_amdgcn_sched_barrier(0);
#pragma unroll
            for (int ks = 0; ks < 4; ++ks) a = __builtin_amdgcn_mfma_f32_16x16x32_bf16(af[ks], sfr[ks], a, 0, 0, 0);
            float u4[4];
#pragma unroll
            for (int r = 0; r < 4; ++r) u4[r] = w4[r] - a[r];
            u32x2 w; w.x = pk2(u4[0], u4[1]); w.y = pk2(u4[2], u4[3]);
            *(LAS u32x2*)(uT + (16 * Jt + fr) * 72 + 16 * I + 4 * fq) = w;
        }
        __syncthreads();
        {
            f32x4 a = (f32x4){0.f, 0.f, 0.f, 0.f};
            bf16x8 af[6], ufo[2], kf[2], ufx[2];
#pragma unroll
            for (int ks = 0; ks < 4; ++ks) af[ks] = *(const LAS bf16x8*)(qds + (16 * I + fr) * 136 + ks * 32 + fq * 8);
#pragma unroll
            for (int ks = 0; ks < 2; ++ks) { af[4 + ks] = *(const LAS bf16x8*)(qks + (16 * I + fr) * 72 + ks * 32 + fq * 8); ufo[ks] = *(const LAS bf16x8*)(uT + (16 * Jt + fr) * 72 + ks * 32 + fq * 8); }
#pragma unroll
            for (int ks = 0; ks < 2; ++ks) { kf[ks] = *(const LAS bf16x8*)(kdts + (16 * wave + fr) * 72 + ks * 32 + fq * 8); ufx[ks] = *(const LAS bf16x8*)(uT + (16 * (Jt ^ 1) + fr) * 72 + ks * 32 + fq * 8); }
            __builtin_amdgcn_sched_barrier(0);
#pragma unroll
            for (int ks = 0; ks < 4; ++ks) a = __builtin_amdgcn_mfma_f32_16x16x32_bf16(sfr[ks], af[ks], a, 0, 0, 0);
#pragma unroll
            for (int ks = 0; ks < 2; ++ks) a = __builtin_amdgcn_mfma_f32_16x16x32_bf16(ufo[ks], af[4 + ks], a, 0, 0, 0);
            {
                f32x4 s0 = sa[0] * cd, s1 = sa[1] * cd;
#pragma unroll
                for (int ks = 0; ks < 2; ++ks) { s0 = __builtin_amdgcn_mfma_f32_16x16x32_bf16(kf[ks], ufo[ks], s0, 0, 0, 0); s1 = __builtin_amdgcn_mfma_f32_16x16x32_bf16(kf[ks], ufx[ks], s1, 0, 0, 0); }
                sa[0] = s0; sa[1] = s1;
            }
            *(f32x4*)(oraw + (size_t)(b * 2048 + n * 64 + 16 * I + fr) * DM + hh * 128 + 32 * vs + 16 * Jt + 4 * fq) = a;
        }
        __syncthreads();
#pragma unroll
        for (int j2 = 0; j2 < 2; ++j2) { u32x2 w; w.x = pk2(sa[j2][0], sa[j2][1]); w.y = pk2(sa[j2][2], sa[j2][3]);
            *(LAS u32x2*)(STb + (16 * (Jt ^ j2) + fr) * 136 + 16 * wave + 4 * fq) = w; }
        if (n + 1 < 32) commit();
        __syncthreads();
    }
    float* so = p->out + OUT_GDN_P + ((size_t)(l * 8 + b) * 4 + hh) * 16384;
#pragma unroll
    for (int j2 = 0; j2 < 2; ++j2)
#pragma unroll
        for (int r = 0; r < 4; ++r) so[(size_t)(16 * wave + 4 * fq + r) * 128 + 32 * vs + 16 * (Jt ^ j2) + fr] = sa[j2][r];
}

__device__ __forceinline__ void finalize_phase(PP p, int l, int bid, int nb) {
    const int tid = get_tid(), lane = tid & 63, wave = tid >> 6;
    const float* oraw = (const float*)(p->ws + WS_O);
    const bf16_t* hb = (const bf16_t*)(p->ws + WS_H);
    bf16_t* mix = (bf16_t*)(p->ws + WS_XN);
    const f32x4 wg = *(const f32x4*)(p->in[15] + l * 128 + 4 * (lane & 31));
    const f32x4 ws2 = *(const f32x4*)(p->in[17] + l * 512 + 4 * lane), ws3 = *(const f32x4*)(p->in[17] + l * 512 + 256 + 4 * lane);
    f32x4 nv[4];
    {
        const int r0 = row_of(0, bid, wave, nb);
        if (r0 >= 0) { const f32x4* q = (const f32x4*)(oraw + (size_t)r0 * DM) + lane;
#pragma unroll
            for (int jj = 0; jj < 4; ++jj) nv[jj] = q[64 * jj]; }
    }
    for (int kk = 0;; ++kk) {
        const int row = row_of(kk, bid, wave, nb); if (row < 0) break;
        f32x4 v[4];
#pragma unroll
        for (int jj = 0; jj < 4; ++jj) v[jj] = nv[jj];
        const u32x2 z0 = *((const u32x2*)(hb + (size_t)row * HC + C_Z) + lane), z1 = *((const u32x2*)(hb + (size_t)row * HC + C_Z + 256) + lane);
        const int rnext = row_of(kk + 1, bid, wave, nb);
        if (rnext >= 0) { const f32x4* q = (const f32x4*)(oraw + (size_t)rnext * DM) + lane;
#pragma unroll
            for (int jj = 0; jj < 4; ++jj) nv[jj] = q[64 * jj]; }
        float s0 = (v[0].x * v[0].x + v[0].y * v[0].y) + (v[0].z * v[0].z + v[0].w * v[0].w);
        float s1 = (v[1].x * v[1].x + v[1].y * v[1].y) + (v[1].z * v[1].z + v[1].w * v[1].w);
        float s2 = ((v[2].x * v[2].x + v[2].y * v[2].y) + (v[2].z * v[2].z + v[2].w * v[2].w)) + ((v[3].x * v[3].x + v[3].y * v[3].y) + (v[3].z * v[3].z + v[3].w * v[3].w));
#pragma unroll
        for (int o = 1; o < 32; o <<= 1) { s0 += __shfl_xor(s0, o); s1 += __shfl_xor(s1, o); s2 += __shfl_xor(s2, o); }
        s2 += __shfl_xor(s2, 32);
        const float r0s = rsqrtf(s0 * (1.f / 128.f) + 1e-6f), r1s = rsqrtf(s1 * (1.f / 128.f) + 1e-6f), r2s = rsqrtf(s2 * (1.f / 512.f) + 1e-6f);
        const f32x4 zz0 = (f32x4){bflo(z0.x), bfhi(z0.x), bflo(z0.y), bfhi(z0.y)}, zz1 = (f32x4){bflo(z1.x), bfhi(z1.x), bflo(z1.y), bfhi(z1.y)};
        f32x4 o0 = v[0] * r0s * wg, o1 = v[1] * r1s * wg;
#pragma unroll
        for (int e = 0; e < 4; ++e) { o0[e] *= silu_f(zz0[e]); o1[e] *= silu_f(zz1[e]); }
        const f32x4 o2 = v[2] * r2s * ws2, o3 = v[3] * r2s * ws3;
        u32x2* mp = (u32x2*)(mix + (size_t)row * DM) + lane;
        u32x2 q;
        q.x = pk2(o0.x, o0.y); q.y = pk2(o0.z, o0.w); mp[0] = q;
        q.x = pk2(o1.x, o1.y); q.y = pk2(o1.z, o1.w); mp[64] = q;
        q.x = pk2(o2.x, o2.y); q.y = pk2(o2.z, o2.w); mp[128] = q;
        q.x = pk2(o3.x, o3.y); q.y = pk2(o3.z, o3.w); mp[192] = q;
    }
}

#define XB_TMO      128
#define XB_XCNT(j)  (256  + 64 * (j))
#define XB_XSUB(j)  (1280 + 64 * (j))
#define XB_XGEN(j)  (2304 + 64 * (j))
#define XB_TOP      3328
#define XB_TOPGEN   3392
#define XCD_BAR_WORDS 3456
#define XB_SPIN_CAP (1u << 20)
__device__ __forceinline__ unsigned xb_ld(unsigned* p)              { return __hip_atomic_load(p, __ATOMIC_RELAXED, __HIP_MEMORY_SCOPE_AGENT); }
__device__ __forceinline__ unsigned xb_add(unsigned* p, unsigned v) { return __hip_atomic_fetch_add(p, v, __ATOMIC_RELAXED, __HIP_MEMORY_SCOPE_AGENT); }
__device__ __forceinline__ unsigned xb_xcc_id() { return (unsigned)__builtin_amdgcn_s_getreg((3 << 11) | 20) & 0xFu; }
#define XB_SPIN(cond, bar) do { unsigned _sp = 0; while (cond) { __builtin_amdgcn_s_sleep(1); \
    if ((++_sp & 255u) == 0u) { if (xb_ld(&(bar)[XB_TMO])) break; if (_sp > XB_SPIN_CAP) { atomicAdd(&(bar)[XB_TMO], 1u); break; } } } } while (0)
__device__ __forceinline__ void xcd_barrier_complete(unsigned* bar, unsigned x, unsigned& nloc, unsigned& nx) {
    const unsigned G = gridDim.x * gridDim.y * gridDim.z;
    unsigned sum, cnt, mine, sp = 0u;
    for (;;) {
        sum = 0u; cnt = 0u; mine = 0u;
#pragma unroll
        for (unsigned j = 0; j < 16; ++j) { const unsigned c = xb_ld(&bar[XB_XCNT(j)]); sum += c; cnt += (c > 0u) ? 1u : 0u; mine = (j == x) ? c : mine; }
        if (sum == G) break;
        __builtin_amdgcn_s_sleep(1);
        if ((++sp & 255u) == 0u) { if (xb_ld(&bar[XB_TMO])) break; if (sp > XB_SPIN_CAP) { atomicAdd(&bar[XB_TMO], 1u); break; } }
    }
    nloc = mine > 0u ? mine : 1u; nx = cnt > 0u ? cnt : 1u;
}
__device__ __forceinline__ void xcd_barrier(unsigned* bar, volatile LAS unsigned* st) {
    asm volatile("s_waitcnt vmcnt(0)" ::: "memory");
    __syncthreads();
    if (threadIdx.x == 0) {
        const unsigned x = xb_xcc_id();
        __builtin_amdgcn_s_waitcnt(0);
        unsigned nloc = st[0], nx = st[1];
        if (nloc == 0u) { xcd_barrier_complete(bar, x, nloc, nx); st[0] = nloc; st[1] = nx; }
        const unsigned old = xb_add(&bar[XB_XSUB(x)], 1u);
        const unsigned gen = old / nloc;
        if (old + 1u == (gen + 1u) * nloc) {
            __builtin_amdgcn_fence(__ATOMIC_RELEASE, "agent");
            asm volatile("s_waitcnt vmcnt(0)" ::: "memory");
            const unsigned og = xb_add(&bar[XB_TOP], 1u);
            const unsigned tg = og / nx;
            if (og + 1u == (tg + 1u) * nx) xb_add(&bar[XB_TOPGEN], 1u);
            else XB_SPIN(xb_ld(&bar[XB_TOPGEN]) == tg, bar);
            __builtin_amdgcn_fence(__ATOMIC_ACQUIRE, "agent");
            xb_add(&bar[XB_XGEN(x)], 1u);
            asm volatile("s_waitcnt vmcnt(0)" ::: "memory");
        } else {
            XB_SPIN(xb_ld(&bar[XB_XGEN(x)]) == gen, bar);
            __builtin_amdgcn_fence(__ATOMIC_ACQUIRE, "agent");
            asm volatile("s_waitcnt vmcnt(0)" ::: "memory");
        }
    }
    __syncthreads();
}

#ifndef PROBE_A
#define PROBE_A 1
#endif
#ifndef PROBE_C
#define PROBE_C 1
#endif
__global__ void __launch_bounds__(NTHR, 2) hymba_fwd(Params pv) {
    extern __shared__ __attribute__((aligned(16))) unsigned char smem[];
    LAS unsigned char* lds = (LAS unsigned char*)smem;
    cg::grid_group grid = cg::this_grid();
    const int bid = blockIdx.x, nb = gridDim.x;
    volatile LAS unsigned* xst = (volatile LAS unsigned*)(lds + LDS_MAIN);
    if (threadIdx.x == 0) { xst[0] = 0u; xst[1] = 0u; (void)xb_add((unsigned*)(pv.ws + WS_BAR) + XB_XCNT(xb_xcc_id()), 1u); }
    __syncthreads();
    const int ph_lo = pv.ph_lo, ph_hi = pv.ph_hi;
    int ph = 0;
#define RUN (ph >= ph_lo && ph < ph_hi)
#if defined(USE_CG_SYNC)
#define SEAM() do { ++ph; if (ph > ph_lo && ph < ph_hi) grid.sync(); } while (0)
#else
#define SEAM() do { ++ph; if (ph > ph_lo && ph < ph_hi) xcd_barrier((unsigned*)(get_params()->ws + WS_BAR), xst); } while (0)
#endif
    if (RUN) { PP p = get_params(); prep_phase(p, lds, bid, nb); }
    if (ph_hi == -12345) grid.sync();
    SEAM();
#pragma unroll 1
    for (int step = 0; step < 12; ++step) {
        const int l = step / 3, ty = step % 3;
        if (step > 0) {
            if (RUN) {
                PP p = get_params();
                float* xres = (float*)(p->ws + WS_X); bf16_t* xn = (bf16_t*)(p->ws + WS_XN);
                const float* part = (const float*)(p->ws + WS_O);
                const int nsp = ty == 2 ? DM / 256 : FF / 256; const float psc = ty == 2 ? 1.f : 0.5f;
                if (ty == 1) rms_phase<1>(xres, p->in[10] + l * DM, xn, nullptr, (float*)(p->ws + WS_BA), p->in[11] + (size_t)l * DM * INC, part, nsp, psc, bid, nb);
                else rms_phase<0>(xres, p->in[ty == 0 ? 6 : 19] + l * DM, xn, nullptr, nullptr, nullptr, part, nsp, psc, bid, nb);
            }
            SEAM();
        }
        if (RUN) {
            PP p = get_params();
            const bf16_t* wl = (const bf16_t*)(p->ws + WS_W) + (size_t)l * WL_ELEMS;
            const bf16_t* xn = (const bf16_t*)(p->ws + WS_XN); bf16_t* hbuf = (bf16_t*)(p->ws + WS_H);
            if (ty == 1) {
                pg8::Gemm g{xn, wl + O_IN, DM, DM / 64}; pg8::StaticOrder S; S.init(TT, HC, nb, bid); pg8::EpiH E{hbuf, HC};
                pg8::gemm_phase(lds, g, S, E);
            } else {
                pg8::Gemm g{xn, wl + (ty == 0 ? O_GU1 : O_GU2), DM, DM / 64}; pg8::StaticOrder S; S.init(TT, 2 * FF, nb, bid); pg8::EpiGU E{hbuf};
                pg8::gemm_phase(lds, g, S, E);
            }
        }
        SEAM();
        if (ty == 1) {
            if (RUN) {
                for (int rep = 0; rep < PROBE_A; ++rep)
                for (int it = bid; it < 1024 + 512; it += nb) {
                    PP p = get_params();
                    if (it < 1024) gdn_stage_a(p, l, it, lds);
                    else gdn_sample(p, l, it - 1024, lds);
                }
            }
            SEAM();
            if (RUN) {
                if (bid < 128 || nb < 256) { for (int rep = 0; rep < PROBE_C; ++rep) for (int c = bid; c < 128; c += nb) { PP p = get_params(); gdn_chain(p, l, c, lds); __syncthreads(); } }
                const int sb = nb >= 256 ? bid - 128 : bid, sn = nb >= 256 ? nb - 128 : nb;
                if (sb >= 0) for (int it = sb; it < 512 + 256; it += sn) {
                    PP p = get_params();
                    if (it < 512) swa_prompt(p, l, it, lds);
                    else swa_sample(p, l, it - 512, lds);
                }
            }
            SEAM();
            if (RUN) { PP p = get_params(); finalize_phase(p, l, bid, nb); }
            SEAM();
        }
        if (RUN) {
            PP p = get_params();
            const bf16_t* wl = (const bf16_t*)(p->ws + WS_W) + (size_t)l * WL_ELEMS;
            float* xres = (float*)(p->ws + WS_X);
            const bf16_t* A = ty == 1 ? (const bf16_t*)(p->ws + WS_XN) : (const bf16_t*)(p->ws + WS_H); const bf16_t* Bt = wl + (ty == 0 ? O_DN1 : ty == 1 ? O_OUT : O_DN2);
            const int K = ty == 1 ? DM : FF; const float scale = ty == 1 ? 1.f : 0.5f;
            {
                pg8::Gemm g{A, Bt, K, K / 64}; pg8::StaticOrder S; S.init(TP, DM, nb, bid); pg8::EpiRes E{xres, scale};
                pg8::gemm_phase(lds, g, S, E);
            }
            {
                pg8::Gemm g{A, Bt, K, 4}; pg8::SplitOrder S{TP / 256, TSM / 256, DM / 256, K / 256, 512, nb, bid}; pg8::EpiPart E{(float*)(p->ws + WS_O)};
                pg8::gemm_phase(lds, g, S, E);
            }
        }
        SEAM();
    }
    if (RUN) { PP p = get_params(); rms_phase<2>((float*)(p->ws + WS_X), p->in[23], nullptr, p->out + OUT_Y, nullptr, nullptr, (const float*)(p->ws + WS_O), FF / 256, 0.5f, bid, nb); }
#undef RUN
#undef SEAM
}

extern "C" void kernel_launch(void* const* d_in, const int* in_sizes, int n_in, void* d_out, int out_size, void* d_ws, size_t ws_size, hipStream_t stream) {
    static int grid = 0;
    if (grid == 0) {
        if (n_in != 24 || (size_t)out_size != OUT_END || ws_size < WS_END) { fprintf(stderr, "kernel_launch: unexpected shapes (n_in %d out %d ws %zu need %zu)\n", n_in, out_size, ws_size, (size_t)WS_END); grid = -1; return; }
        int dev = 0, cus = 0, per_cu = 0;
        (void)hipGetDevice(&dev); (void)hipDeviceGetAttribute(&cus, hipDeviceAttributeMultiprocessorCount, dev);
        (void)hipFuncSetAttribute((const void*)hymba_fwd, hipFuncAttributeMaxDynamicSharedMemorySize, LDS_BYTES);
        (void)hipOccupancyMaxActiveBlocksPerMultiprocessor(&per_cu, (const void*)hymba_fwd, NTHR, LDS_BYTES);
        (void)hipGetLastError();
        if (per_cu < 1) fprintf(stderr, "kernel_launch: occupancy query says %d blocks per CU\n", per_cu);
        grid = cus;
    }
    if (grid < 0) return;
    Params p{};
    for (int i = 0; i < 24; ++i) p.in[i] = (const float*)d_in[i];
    p.out = (float*)d_out; p.ws = (unsigned char*)d_ws; p.ph_lo = 0; p.ph_hi = 1 << 20;
    void* args[] = {&p};
    (void)hipMemsetAsync((char*)d_ws + WS_BAR, 0, 16384, stream);
    hipError_t e = hipLaunchCooperativeKernel((const void*)hymba_fwd, dim3(grid), dim3(NTHR), args, LDS_BYTES, stream);
    if (e != hipSuccess) fprintf(stderr, "cooperative launch failed: %s (grid %d)\n", hipGetErrorString(e), grid);
}
```

```cpp
#include <hip/hip_runtime.h>
#include <hip/hip_cooperative_groups.h>
#include <cstdio>
namespace cg = cooperative_groups;

#define LAS __attribute__((address_space(3)))
typedef unsigned short bf16_t;
typedef short bf16x8 __attribute__((ext_vector_type(8)));
typedef float f32x4 __attribute__((ext_vector_type(4)));
typedef float f32x2 __attribute__((ext_vector_type(2)));
typedef unsigned u32x4 __attribute__((ext_vector_type(4)));
typedef unsigned u32x2 __attribute__((ext_vector_type(2)));

constexpr int TP = 16384, TSM = 512, TT = TP + TSM, DM = 1024, FF = 2816, HC = 2816, INC = 2824;
constexpr int C_Z = 1536, C_SQ = 2048, C_SK = 2560, C_SV = 2688;
constexpr int NTHR = 512, LDS_MAIN = 131072, LDS_BYTES = LDS_MAIN + 16;
constexpr size_t E_GU = (size_t)2 * FF * DM, E_DN = (size_t)DM * FF, E_IN = (size_t)HC * DM, E_OUT = (size_t)DM * DM;
constexpr size_t O_GU1 = 0, O_DN1 = O_GU1 + E_GU, O_IN = O_DN1 + E_DN, O_OUT = O_IN + E_IN, O_GU2 = O_OUT + E_OUT, O_DN2 = O_GU2 + E_GU, WL_ELEMS = O_DN2 + E_DN;
constexpr size_t WS_W = 0;
constexpr size_t WS_X = WS_W + 4 * WL_ELEMS * 2;
constexpr size_t WS_XN = WS_X + (size_t)TT * DM * 4;
constexpr size_t WS_H = WS_XN + (size_t)TT * DM * 2;
constexpr size_t WS_O = WS_H + (size_t)TT * HC * 2;
constexpr size_t WS_G = WS_O + (size_t)TT * DM * 4;
constexpr size_t G_ITEM = 8192 * 4 + 4096;
constexpr size_t WS_CD = WS_G + (size_t)1024 * G_ITEM * 2;
constexpr size_t WS_BA = WS_CD + 131072;
constexpr size_t WS_BAR = WS_BA + (size_t)TT * 8 * 4;
constexpr size_t WS_END = WS_BAR + 16384;
constexpr size_t OUT_Y = 0;
constexpr size_t OUT_CONV_P = (size_t)TT * DM;
constexpr size_t OUT_GDN_P = OUT_CONV_P + (size_t)4 * 8 * 3 * 1536;
constexpr size_t OUT_K_P = OUT_GDN_P + (size_t)4 * 8 * 4 * 128 * 128;
constexpr size_t OUT_V_P = OUT_K_P + (size_t)4 * 8 * 128 * 128;
constexpr size_t OUT_CONV_S = OUT_V_P + (size_t)4 * 8 * 128 * 128;
constexpr size_t OUT_GDN_S = OUT_CONV_S + (size_t)4 * 128 * 3 * 1536;
constexpr size_t OUT_K_S = OUT_GDN_S + (size_t)4 * 128 * 4 * 128 * 128;
constexpr size_t OUT_V_S = OUT_K_S + (size_t)4 * 128 * 128 * 128;
constexpr size_t OUT_END = OUT_V_S + (size_t)4 * 128 * 128 * 128;

struct Params {
    const float* in[24];
    float* out;
    unsigned char* ws;
    int ph_lo, ph_hi;
};

typedef const __attribute__((address_space(4))) Params* PP;
__device__ __forceinline__ PP get_params() { PP q = (PP)__builtin_amdgcn_kernarg_segment_ptr(); asm volatile("" : "+s"(q)); return q; }
__device__ __forceinline__ int get_tid() { int t = threadIdx.x; asm volatile("" : "+v"(t)); return t; }
typedef __bf16 bf16x2_t __attribute__((ext_vector_type(2)));
__device__ __forceinline__ unsigned pk2(float lo, float hi) { const f32x2 v = {lo, hi}; return __builtin_bit_cast(unsigned, __builtin_convertvector(v, bf16x2_t)); }
__device__ __forceinline__ float bflo(unsigned w) { return __uint_as_float(w << 16); }
__device__ __forceinline__ float bfhi(unsigned w) { return __uint_as_float(w & 0xffff0000u); }
__device__ __forceinline__ float bf2f(bf16_t b) { return __uint_as_float((unsigned)b << 16); }
__device__ __forceinline__ float wave_sum(float v) {
#pragma unroll
    for (int o = 1; o < 64; o <<= 1) v += __shfl_xor(v, o);
    return v;
}
__device__ __forceinline__ float silu_f(float v) { return v * __builtin_amdgcn_rcpf(1.f + __expf(-v)); }
__device__ __forceinline__ void unpack8(const u32x4 r, float (&f)[8]) {
    f[0] = bflo(r.x); f[1] = bfhi(r.x); f[2] = bflo(r.y); f[3] = bfhi(r.y); f[4] = bflo(r.z); f[5] = bfhi(r.z); f[6] = bflo(r.w); f[7] = bfhi(r.w);
}
#define LDS_WAIT() asm volatile("s_waitcnt lgkmcnt(0)" ::: "memory")

namespace pg8 {
constexpr int BM = 256, BK = 64, HALF = 128, HTB = HALF * BK * 2, STAGE_BYTES = 8 * HTB, NXCD = 8, WGM = 8;
__device__ __forceinline__ int lds_byte(int r, int c) { const int st = (r >> 4) * 2 + (c >> 5), rr = r & 15, cc = c & 31, ob = rr * 64 + cc * 2; return st * 1024 + (ob ^ (((ob >> 9) & 1) << 5)); }
__device__ __forceinline__ void stage_rc(int b, int& R, int& C) { const int st = b / 1024, sb = b % 1024, swz = sb ^ (((sb >> 9) & 1) << 5); R = (st >> 1) * 16 + swz / 64; C = (st & 1) * 32 + (swz % 64) / 2; }
__device__ __forceinline__ int perm32(int rho) { const int n = rho >> 4, i = rho & 15; return 8 * (i >> 2) + 4 * n + (i & 3); }
struct Unit { int pm, pn, koff; };
struct Gemm { const bf16_t* A; const bf16_t* Bt; int ldk, nt; };

struct StaticOrder {
    int nM, nN, nwg, G, c;
    __device__ void init(int M, int N, int G_, int c_) { nM = M / BM; nN = N / BM; nwg = nM * nN; G = G_; c = c_; }
    __device__ bool next(int i, Unit& u) const {
        const long L = (long)i * G + c; if (L >= nwg) return false;
        int wgid = (int)L; { const int q = nwg / NXCD, r = nwg % NXCD, xcd = wgid % NXCD, off = wgid / NXCD; wgid = (xcd < r ? xcd * (q + 1) : r * (q + 1) + (xcd - r) * q) + off; }
        const int nig = WGM * nN, gid = wgid / nig, fm = gid * WGM, gsz = (nM - fm) < WGM ? (nM - fm) : WGM;
        u.pm = fm + ((wgid % nig) % gsz); u.pn = (wgid % nig) / gsz; u.koff = 0; return true;
    }
};
struct SplitOrder {
    int pm0, nM, nN, nsplit, ksb, G, c;
    __device__ bool next(int i, Unit& u) const {
        const int L = i * G + c; if (L >= nM * nN * nsplit) return false;
        const int ks = L / (nM * nN), t = L % (nM * nN);
        u.pm = pm0 + t / nN; u.pn = t % nN; u.koff = ks * ksb; return true;
    }
};

template <class Epi, class Sched>
__device__ __forceinline__ void gemm_phase(LAS unsigned char* lds, const Gemm g, const Sched& S, const Epi& E) {
    const int tid = get_tid(), wid = __builtin_amdgcn_readfirstlane(tid >> 6), lane = tid & 63, wr = wid >> 2, wc = wid & 3, fr = lane & 15, fq = lane >> 4;
    const int K = g.ldk, nt = g.nt;
    unsigned voffA[2], voffB[2];
#pragma unroll
    for (int i = 0; i < 2; ++i) { int R, C; stage_rc(tid * 16 + i * 8192, R, C); const int Rb = Epi::PERM ? ((R & ~31) + perm32(R & 31)) : R;
        voffA[i] = (unsigned)(R * K + C) * 2u; voffB[i] = (unsigned)(Rb * K + C) * 2u; }
    const size_t kstep = (size_t)(BK * 2);
    const size_t hstep = (size_t)HALF * K * 2;
    const size_t tstep = 2 * hstep;
    const unsigned ldsw = (unsigned)wid * 1024u;
    const int aoff = lds_byte(wr * 64 + fr, fq * 8), boff = lds_byte(wc * 32 + fr, fq * 8);
#define PG8_SA(b, h) (((b) * 2 + (h)) * HTB)
#define PG8_SB(b, h) ((4 + (b) * 2 + (h)) * HTB)
#define PG8_STAGE(bufoff, gbase, voff) do { _Pragma("unroll") for (int _i = 0; _i < 2; ++_i) \
        __builtin_amdgcn_global_load_lds((const unsigned*)((const char*)(gbase) + (voff)[_i]), (LAS unsigned*)(lds + (bufoff) + ldsw + _i * 8192), 16, 0, 0); } while (0)
#define PG8_LDA(dst, b, h) do { _Pragma("unroll") for (int m = 0; m < 4; ++m) _Pragma("unroll") for (int k = 0; k < 2; ++k) dst[m][k] = *(const LAS bf16x8*)(lds + PG8_SA(b, h) + aoff + m * 2048 + k * 1024); } while (0)
#define PG8_LDB(dst, b, h) do { _Pragma("unroll") for (int n = 0; n < 2; ++n) _Pragma("unroll") for (int k = 0; k < 2; ++k) dst[n][k] = *(const LAS bf16x8*)(lds + PG8_SB(b, h) + boff + n * 2048 + k * 1024); } while (0)
#define PG8_MMA(ai, bj, At, Bt) do { __builtin_amdgcn_s_setprio(1); _Pragma("unroll") for (int m = 0; m < 4; ++m) _Pragma("unroll") for (int n = 0; n < 2; ++n) _Pragma("unroll") for (int k = 0; k < 2; ++k) \
        acc[ai][bj][m][n] = __builtin_amdgcn_mfma_f32_16x16x32_bf16(Bt[n][k], At[m][k], acc[ai][bj][m][n], 0, 0, 0); __builtin_amdgcn_s_setprio(0); } while (0)
#define PG8_WAIT_V(n) asm volatile("s_waitcnt vmcnt(" #n ")" ::: "memory")
#define PG8_WAIT_L(n) asm volatile("s_waitcnt lgkmcnt(" #n ")" ::: "memory")
#define PG8_BAR __builtin_amdgcn_s_barrier()
#define PG8_SCHED __builtin_amdgcn_sched_barrier(0)
    Unit cur, nxt; int ui = 0;
    if (!S.next(0, cur)) return;
    f32x4 acc[2][2][4][2];
#pragma unroll
    for (int a = 0; a < 2; ++a)
#pragma unroll
        for (int b = 0; b < 2; ++b)
#pragma unroll
            for (int m = 0; m < 4; ++m)
#pragma unroll
                for (int n = 0; n < 2; ++n) acc[a][b][m][n] = (f32x4){0.f, 0.f, 0.f, 0.f};
    bf16x8 At[4][2], B0[2][2], B1[2][2];
    const char* cA = (const char*)g.A + (size_t)cur.pm * tstep + cur.koff; const char* cB = (const char*)g.Bt + (size_t)cur.pn * tstep + cur.koff;
    PG8_STAGE(PG8_SB(0, 0), cB, voffB); PG8_STAGE(PG8_SA(0, 0), cA, voffA); PG8_STAGE(PG8_SB(0, 1), cB + hstep, voffB); PG8_STAGE(PG8_SA(0, 1), cA + hstep, voffA);
    if (wr == 1) PG8_BAR;
    PG8_WAIT_V(4); PG8_BAR;
    PG8_STAGE(PG8_SB(1, 0), cB + kstep, voffB); PG8_STAGE(PG8_SA(1, 0), cA + kstep, voffA); PG8_STAGE(PG8_SB(1, 1), cB + hstep + kstep, voffB);
    PG8_WAIT_V(6); PG8_BAR;
    for (;;) {
        const bool has_next = S.next(ui + 1, nxt);
        const char* nA = has_next ? (const char*)g.A + (size_t)nxt.pm * tstep + nxt.koff : cA; const char* nB = has_next ? (const char*)g.Bt + (size_t)nxt.pn * tstep + nxt.koff : cB;
        for (int t = 0; t < nt; t += 2) {
            const bool last = (t == nt - 2);
            const char* a1 = cA + (size_t)(t + 1) * kstep;
            const char* a2 = last ? nA : cA + (size_t)(t + 2) * kstep; const char* b2 = last ? nB : cB + (size_t)(t + 2) * kstep;
            const char* a3 = a2 + kstep; const char* b3 = b2 + kstep;
            PG8_LDB(B0, 0, 0); PG8_SCHED; PG8_LDA(At, 0, 0); PG8_STAGE(PG8_SA(1, 1), a1 + hstep, voffA);
            PG8_WAIT_L(8); PG8_BAR; PG8_WAIT_L(0); PG8_MMA(0, 0, At, B0); PG8_BAR; PG8_SCHED;
            PG8_LDB(B1, 0, 1); PG8_STAGE(PG8_SB(0, 0), b2, voffB);
            PG8_BAR; PG8_WAIT_L(0); PG8_MMA(0, 1, At, B1); PG8_BAR;
            PG8_LDA(At, 0, 1); PG8_STAGE(PG8_SA(0, 0), a2, voffA);
            PG8_BAR; PG8_WAIT_L(0); PG8_MMA(1, 0, At, B0); PG8_BAR; PG8_SCHED;
            PG8_STAGE(PG8_SB(0, 1), b2 + hstep, voffB);
            PG8_WAIT_V(6); PG8_BAR; PG8_MMA(1, 1, At, B1); PG8_BAR;
            PG8_LDB(B0, 1, 0); PG8_SCHED; PG8_LDA(At, 1, 0); PG8_STAGE(PG8_SA(0, 1), a2 + hstep, voffA);
            PG8_WAIT_L(8); PG8_BAR; PG8_WAIT_L(0); PG8_MMA(0, 0, At, B0); PG8_BAR; PG8_SCHED;
            PG8_LDB(B1, 1, 1); PG8_STAGE(PG8_SB(1, 0), b3, voffB);
            PG8_BAR; PG8_WAIT_L(0); PG8_MMA(0, 1, At, B1); PG8_BAR;
            PG8_LDA(At, 1, 1); PG8_STAGE(PG8_SA(1, 0), a3, voffA);
            PG8_BAR; PG8_WAIT_L(0); PG8_MMA(1, 0, At, B0); PG8_BAR; PG8_SCHED;
            PG8_STAGE(PG8_SB(1, 1), b3 + hstep, voffB);
            PG8_WAIT_V(6); PG8_BAR; PG8_MMA(1, 1, At, B1); PG8_BAR;
        }
        E(acc, cur, wr, wc, fr, fq);
        if (!has_next) break;
#pragma unroll
        for (int a = 0; a < 2; ++a)
#pragma unroll
            for (int b = 0; b < 2; ++b)
#pragma unroll
                for (int m = 0; m < 4; ++m)
#pragma unroll
                    for (int n = 0; n < 2; ++n) acc[a][b][m][n] = (f32x4){0.f, 0.f, 0.f, 0.f};
        cur = nxt; cA = nA; cB = nB; ++ui;
    }
    PG8_WAIT_V(0);
    if (wr == 0) PG8_BAR;
    PG8_BAR;
#undef PG8_SA
#undef PG8_SB
#undef PG8_STAGE
#undef PG8_LDA
#undef PG8_LDB
#undef PG8_MMA
#undef PG8_WAIT_V
#undef PG8_WAIT_L
#undef PG8_BAR
#undef PG8_SCHED
}

struct EpiGU {
    static constexpr bool PERM = true;
    bf16_t* O;
    __device__ __forceinline__ void operator()(const f32x4 (&acc)[2][2][4][2], const Unit& u, int wr, int wc, int fr, int fq) const {
        const int row0 = u.pm * BM + wr * 64 + fr, col0 = u.pn * 128 + wc * 32 + 8 * fq;
#pragma unroll
        for (int ai = 0; ai < 2; ++ai)
#pragma unroll
            for (int m = 0; m < 4; ++m) { bf16_t* rowp = O + (size_t)(row0 + ai * HALF + m * 16) * FF + col0;
                const f32x4 g0 = acc[ai][0][m][0], g1 = acc[ai][0][m][1], u0 = acc[ai][1][m][0], u1 = acc[ai][1][m][1];
                u32x4 w; w.x = pk2(silu_f(g0[0]) * u0[0], silu_f(g0[1]) * u0[1]); w.y = pk2(silu_f(g0[2]) * u0[2], silu_f(g0[3]) * u0[3]);
                w.z = pk2(silu_f(g1[0]) * u1[0], silu_f(g1[1]) * u1[1]); w.w = pk2(silu_f(g1[2]) * u1[2], silu_f(g1[3]) * u1[3]);
                *(u32x4*)rowp = w; }
    }
};
struct EpiH {
    static constexpr bool PERM = true;
    bf16_t* O; int ldc;
    __device__ __forceinline__ void operator()(const f32x4 (&acc)[2][2][4][2], const Unit& u, int wr, int wc, int fr, int fq) const {
        const int row0 = u.pm * BM + wr * 64 + fr, col0 = u.pn * BM + wc * 32 + 8 * fq;
#pragma unroll
        for (int ai = 0; ai < 2; ++ai)
#pragma unroll
            for (int m = 0; m < 4; ++m) { bf16_t* rowp = O + (size_t)(row0 + ai * HALF + m * 16) * ldc + col0;
#pragma unroll
                for (int bj = 0; bj < 2; ++bj) { const f32x4 v0 = acc[ai][bj][m][0], v1 = acc[ai][bj][m][1];
                    u32x4 w; w.x = pk2(v0[0], v0[1]); w.y = pk2(v0[2], v0[3]); w.z = pk2(v1[0], v1[1]); w.w = pk2(v1[2], v1[3]);
                    *(u32x4*)(rowp + bj * HALF) = w; } }
    }
};
struct EpiRes {
    static constexpr bool PERM = false;
    float* X; float scale;
    __device__ __forceinline__ void operator()(const f32x4 (&acc)[2][2][4][2], const Unit& u, int wr, int wc, int fr, int fq) const {
        const int row0 = u.pm * BM + wr * 64 + fr, col0 = u.pn * BM + wc * 32 + 4 * fq;
#pragma unroll
        for (int ai = 0; ai < 2; ++ai) {
            f32x4 t[4][2][2];
#pragma unroll
            for (int m = 0; m < 4; ++m)
#pragma unroll
                for (int bj = 0; bj < 2; ++bj)
#pragma unroll
                    for (int n = 0; n < 2; ++n) t[m][bj][n] = *(const f32x4*)(X + (size_t)(row0 + ai * HALF + m * 16) * DM + col0 + bj * HALF + n * 16);
#pragma unroll
            for (int m = 0; m < 4; ++m)
#pragma unroll
                for (int bj = 0; bj < 2; ++bj)
#pragma unroll
                    for (int n = 0; n < 2; ++n) *(f32x4*)(X + (size_t)(row0 + ai * HALF + m * 16) * DM + col0 + bj * HALF + n * 16) = t[m][bj][n] + acc[ai][bj][m][n] * scale;
        }
    }
};
struct EpiPart {
    static constexpr bool PERM = false;
    float* P;
    __device__ __forceinline__ void operator()(const f32x4 (&acc)[2][2][4][2], const Unit& u, int wr, int wc, int fr, int fq) const {
        const int row0 = u.pm * BM - TP + wr * 64 + fr, col0 = u.pn * BM + wc * 32 + 4 * fq;
        float* base = P + (size_t)(u.koff >> 9) * TSM * DM;
#pragma unroll
        for (int ai = 0; ai < 2; ++ai)
#pragma unroll
            for (int m = 0; m < 4; ++m) { float* rowp = base + (size_t)(row0 + ai * HALF + m * 16) * DM + col0;
#pragma unroll
                for (int bj = 0; bj < 2; ++bj)
#pragma unroll
                    for (int n = 0; n < 2; ++n) *(f32x4*)(rowp + bj * HALF + n * 16) = acc[ai][bj][m][n]; }
    }
};
}

__device__ __forceinline__ void transpose_item(const float* colp, int ld, int k0, bf16_t* dst, int K, LAS float* scr, int lane) {
    float tv[32];
#pragma unroll
    for (int i = 0; i < 32; ++i) tv[i] = colp[(size_t)(k0 + 2 * i + (lane >> 5)) * ld];
#pragma unroll
    for (int i = 0; i < 32; ++i) scr[(2 * i + (lane >> 5)) * 33 + (lane & 31)] = tv[i];
    LDS_WAIT();
    const int c = lane & 7;
#pragma unroll
    for (int j = 0; j < 4; ++j) { const int n = (lane >> 3) + 8 * j; const LAS float* s = scr + (8 * c) * 33 + n;
        u32x4 o; o.x = pk2(s[0 * 33], s[1 * 33]); o.y = pk2(s[2 * 33], s[3 * 33]); o.z = pk2(s[4 * 33], s[5 * 33]); o.w = pk2(s[6 * 33], s[7 * 33]);
        *(u32x4*)(dst + (size_t)n * K + 8 * c) = o; }
    LDS_WAIT();
}
__device__ __forceinline__ void prep_phase(PP p, LAS unsigned char* lds, int bid, int nb) {
    const int tid = get_tid(), lane = tid & 63, wave = tid >> 6;
    LAS float* scr = (LAS float*)(lds + wave * 8448);
    const int gw = bid * 8 + wave, NGW = nb * 8;
    constexpr int I_GU = 16 * 176, I_DN = 44 * 32, I_IN = 16 * 88, I_OUT = 16 * 32, I_L = 2 * I_GU + 2 * I_DN + I_IN + I_OUT;
    for (int it = gw; it < 4 * I_L; it += NGW) {
        const int l = it / I_L; int r = it % I_L;
        bf16_t* wl = (bf16_t*)(p->ws + WS_W) + (size_t)l * WL_ELEMS;
        const float* colp; int ld, K, k0; bf16_t* dst;
        if (r < 2 * I_GU) {
            const int f = r >= I_GU; r -= f * I_GU; const int kb = r / 176, nb32 = r % 176;
            const float* gsrc = p->in[f ? 20 : 7] + (size_t)l * DM * FF; const float* usrc = p->in[f ? 21 : 8] + (size_t)l * DM * FF;
            colp = (((nb32 >> 2) & 1) ? usrc : gsrc) + 128 * (nb32 >> 3) + 32 * (nb32 & 3) + (lane & 31); ld = FF; K = DM; k0 = 64 * kb;
            dst = wl + (f ? O_GU2 : O_GU1) + (size_t)(32 * nb32) * DM + k0;
        } else if (r < 2 * I_GU + 2 * I_DN) {
            r -= 2 * I_GU; const int f = r >= I_DN; r -= f * I_DN; const int kb = r / 32, nb32 = r % 32;
            colp = p->in[f ? 22 : 9] + (size_t)l * FF * DM + 32 * nb32 + (lane & 31); ld = DM; K = FF; k0 = 64 * kb;
            dst = wl + (f ? O_DN2 : O_DN1) + (size_t)(32 * nb32) * FF + k0;
        } else if (r < 2 * I_GU + 2 * I_DN + I_IN) {
            r -= 2 * I_GU + 2 * I_DN; const int kb = r / 88, nb32 = r % 88; const int n = 32 * nb32 + (lane & 31);
            colp = p->in[11] + (size_t)l * DM * INC + (n < 2048 ? n : n + 8); ld = INC; K = DM; k0 = 64 * kb;
            dst = wl + O_IN + (size_t)(32 * nb32) * DM + k0;
        } else {
            r -= 2 * I_GU + 2 * I_DN + I_IN; const int kb = r / 32, nb32 = r % 32;
            colp = p->in[18] + (size_t)l * DM * DM + 32 * nb32 + (lane & 31); ld = DM; K = DM; k0 = 64 * kb;
            dst = wl + O_OUT + (size_t)(32 * nb32) * DM + k0;
        }
        transpose_item(colp, ld, k0, dst, K, scr, lane);
    }
    {
        f32x4 wv[4];
#pragma unroll
        for (int j = 0; j < 4; ++j) wv[j] = ((const f32x4*)p->in[6])[lane + 64 * j];
        for (int row = gw; row < TT; row += NGW) {
            const f32x4* xr = (const f32x4*)(row < TP ? p->in[0] + (size_t)row * DM : p->in[1] + (size_t)(row - TP) * DM) + lane;
            f32x4* xo = (f32x4*)((float*)(p->ws + WS_X) + (size_t)row * DM) + lane;
            f32x4 v[4]; float s = 0.f;
#pragma unroll
            for (int j = 0; j < 4; ++j) { v[j] = xr[64 * j]; xo[64 * j] = v[j]; s += (v[j].x * v[j].x + v[j].y * v[j].y) + (v[j].z * v[j].z + v[j].w * v[j].w); }
            const float rs = rsqrtf(wave_sum(s) * (1.f / DM) + 1e-6f);
            u32x2* o = (u32x2*)((bf16_t*)(p->ws + WS_XN) + (size_t)row * DM) + lane;
#pragma unroll
            for (int j = 0; j < 4; ++j) { const f32x4 t = v[j] * rs * wv[j]; u32x2 q; q.x = pk2(t.x, t.y); q.y = pk2(t.z, t.w); o[64 * j] = q; }
        }
    }
}

__device__ __forceinline__ int row_of(int k, int bid, int wave, int nb) {
    if (nb == 256) {
        if (k < 8) return (bid & 7) * 2048 + ((bid >> 3) * 8 + wave) + 256 * k;
        const int gw = bid * 8 + wave;
        return (k == 8 && gw < TSM) ? TP + gw : -1;
    }
    const int r = bid * 8 + wave + k * nb * 8;
    return r < TT ? r : -1;
}
template <int MODE>
__device__ __forceinline__ void rms_phase(float* x, const float* w, bf16_t* ob, float* of, float* ba, const float* win, const float* part, int nsplit, float pscale, int bid, int nb) {
    const int tid = get_tid(), lane = tid & 63, wave = tid >> 6;
    f32x4 wv[4];
#pragma unroll
    for (int j = 0; j < 4; ++j) wv[j] = ((const f32x4*)w)[lane + 64 * j];
    f32x4 wc0[4][4], wc1[4][4];
    if (MODE == 1) {
#pragma unroll
        for (int j = 0; j < 4; ++j)
#pragma unroll
            for (int e = 0; e < 4; ++e) { const float* wp = win + (size_t)(4 * lane + 256 * j + e) * INC + 2048; wc0[j][e] = *(const f32x4*)wp; wc1[j][e] = *(const f32x4*)(wp + 4); }
    }
    f32x4 nv[4];
    {
        const int r0 = row_of(0, bid, wave, nb);
        if (r0 >= 0) { const f32x4* q = (const f32x4*)(x + (size_t)r0 * DM) + lane;
#pragma unroll
            for (int j = 0; j < 4; ++j) nv[j] = q[64 * j]; }
    }
    for (int kk = 0;; ++kk) {
        const int row = row_of(kk, bid, wave, nb); if (row < 0) break;
        f32x4* xr = (f32x4*)(x + (size_t)row * DM) + lane;
        f32x4 v[4]; float s = 0.f;
#pragma unroll
        for (int j = 0; j < 4; ++j) v[j] = nv[j];
        const int rnext = row_of(kk + 1, bid, wave, nb);
        if (rnext >= 0) { const f32x4* q = (const f32x4*)(x + (size_t)rnext * DM) + lane;
#pragma unroll
            for (int j = 0; j < 4; ++j) nv[j] = q[64 * j]; }
        if (row >= TP && nsplit > 0) {
            f32x4 a[4] = {(f32x4){0.f, 0.f, 0.f, 0.f}, (f32x4){0.f, 0.f, 0.f, 0.f}, (f32x4){0.f, 0.f, 0.f, 0.f}, (f32x4){0.f, 0.f, 0.f, 0.f}};
            for (int ks = 0; ks < nsplit; ++ks) { const f32x4* pr = (const f32x4*)(part + ((size_t)ks * TSM + (row - TP)) * DM) + lane;
#pragma unroll
                for (int j = 0; j < 4; ++j) a[j] += pr[64 * j]; }
#pragma unroll
            for (int j = 0; j < 4; ++j) { v[j] += a[j] * pscale; xr[64 * j] = v[j]; }
        }
#pragma unroll
        for (int j = 0; j < 4; ++j) s += (v[j].x * v[j].x + v[j].y * v[j].y) + (v[j].z * v[j].z + v[j].w * v[j].w);
        const float rs = rsqrtf(wave_sum(s) * (1.f / DM) + 1e-6f);
#pragma unroll
        for (int j = 0; j < 4; ++j) v[j] = v[j] * rs * wv[j];
        if (MODE == 2) {
            f32x4* o = (f32x4*)(of + (size_t)row * DM) + lane;
#pragma unroll
            for (int j = 0; j < 4; ++j) o[64 * j] = v[j];
        } else {
            u32x2* o = (u32x2*)(ob + (size_t)row * DM) + lane;
#pragma unroll
            for (int j = 0; j < 4; ++j) { u32x2 q; q.x = pk2(v[j].x, v[j].y); q.y = pk2(v[j].z, v[j].w); o[64 * j] = q; }
        }
        if (MODE == 1) {
            float a8[8];
#pragma unroll
            for (int c = 0; c < 8; ++c) a8[c] = 0.f;
#pragma unroll
            for (int j = 0; j < 4; ++j)
#pragma unroll
                for (int e = 0; e < 4; ++e) {
                    const f32x4 w0 = wc0[j][e], w1 = wc1[j][e]; const float xv = v[j][e];
                    a8[0] += xv * w0.x; a8[1] += xv * w0.y; a8[2] += xv * w0.z; a8[3] += xv * w0.w; a8[4] += xv * w1.x; a8[5] += xv * w1.y; a8[6] += xv * w1.z; a8[7] += xv * w1.w;
                }
#pragma unroll
            for (int c = 0; c < 8; ++c) a8[c] = wave_sum(a8[c]);
            if (lane == 0) { *(f32x4*)(ba + (size_t)row * 8) = (f32x4){a8[0], a8[1], a8[2], a8[3]}; *(f32x4*)(ba + (size_t)row * 8 + 4) = (f32x4){a8[4], a8[5], a8[6], a8[7]}; }
        }
    }
}

__device__ __forceinline__ void gdn_stage_a(PP p, int l, int it, LAS unsigned char* lds) {
    const int tid = get_tid(), lane = tid & 63, wave = tid >> 6;
    const int hh = it & 3, n = (it >> 2) & 31, b = it >> 7;
    const int t0 = b * 2048 + n * 64;
    const bf16_t* hb = (const bf16_t*)(p->ws + WS_H);
    const float* ba = (const float*)(p->ws + WS_BA);
    bf16_t* gi_base = (bf16_t*)(p->ws + WS_G) + (size_t)it * G_ITEM;
    bf16_t* wg = gi_base; bf16_t* kcg = gi_base + 8192; bf16_t* qdg = gi_base + 16384; bf16_t* kdtg = gi_base + 24576; bf16_t* qkg = gi_base + 32768;
    LAS float* gcs = (LAS float*)lds;
    LAS float* bet = gcs + 64;
    LAS float* AT = (LAS float*)(lds + 1024);
    LAS float* vr = AT + 64 * 68;
    LAS float* kr = vr + 64 * 128;
    LAS bf16_t* qb = (LAS bf16_t*)(kr + 64 * 128);
    LAS bf16_t* kb = qb + 64 * 136;
    if (wave == 7) {
        const float av = ba[(size_t)(t0 + lane) * 8 + 4 + hh] + p->in[14][l * 4 + hh];
        const float bv = ba[(size_t)(t0 + lane) * 8 + hh];
        const float sp = av > 20.f ? av : log1pf(expf(av));
        float g = -expf(p->in[13][l * 4 + hh]) * sp;
#pragma unroll
        for (int o = 1; o < 64; o <<= 1) { const float t = __shfl_up(g, o); if (lane >= o) g += t; }
        gcs[lane] = g; bet[lane] = 1.f / (1.f + expf(-bv));
    }
    const int tb = tid / 48, r48 = tid % 48, part = r48 >> 4, gi = r48 & 15;
    const int cb = part * 512 + hh * 128 + gi * 8;
    const int tok0 = tb * 8;
    float o[8][8], ss[8];
    if (tid < 384) {
        float cw[4][8];
        const float* cwp = p->in[12] + (size_t)l * 4 * 1536 + cb;
#pragma unroll
        for (int i = 0; i < 4; ++i) { const f32x4 a = *(const f32x4*)(cwp + i * 1536), c = *(const f32x4*)(cwp + i * 1536 + 4);
            cw[i][0] = a.x; cw[i][1] = a.y; cw[i][2] = a.z; cw[i][3] = a.w; cw[i][4] = c.x; cw[i][5] = c.y; cw[i][6] = c.z; cw[i][7] = c.w; }
        float win[3][8];
#pragma unroll
        for (int i = 0; i < 3; ++i) {
            const int tl = tok0 - 3 + i;
            if (n > 0 || tl >= 0) { const u32x4 raw = *(const u32x4*)(hb + (size_t)(t0 + tl) * HC + cb); unpack8(raw, win[i]); }
            else {
#pragma unroll
                for (int c = 0; c < 8; ++c) win[i][c] = 0.f; }
        }
#pragma unroll
        for (int tt = 0; tt < 8; ++tt) {
            float cur[8];
            const u32x4 raw = *(const u32x4*)(hb + (size_t)(t0 + tok0 + tt) * HC + cb); unpack8(raw, cur);
            float s2 = 0.f;
#pragma unroll
            for (int c = 0; c < 8; ++c) { float v = cw[0][c] * win[0][c] + cw[1][c] * win[1][c] + cw[2][c] * win[2][c] + cw[3][c] * cur[c]; v = silu_f(v); o[tt][c] = v; s2 += v * v; }
            ss[tt] = s2;
            if (n == 31 && tb == 7 && tt >= 5) {
                float* cp = p->out + OUT_CONV_P + ((size_t)(l * 8 + b) * 3 + (tt - 5)) * 1536 + cb;
                *(f32x4*)cp = (f32x4){cur[0], cur[1], cur[2], cur[3]}; *(f32x4*)(cp + 4) = (f32x4){cur[4], cur[5], cur[6], cur[7]};
            }
#pragma unroll
            for (int c = 0; c < 8; ++c) { win[0][c] = win[1][c]; win[1][c] = win[2][c]; win[2][c] = cur[c]; }
        }
#pragma unroll
        for (int tt = 0; tt < 8; ++tt) {
            float s2 = ss[tt];
            s2 += __shfl_xor(s2, 1); s2 += __shfl_xor(s2, 2); s2 += __shfl_xor(s2, 4); s2 += __shfl_xor(s2, 8);
            ss[tt] = rsqrtf(s2 + 1e-6f);
        }
    }
    __syncthreads();
    const float gc_last = gcs[63];
    if (tid < 384) {
        if (part == 0) {
#pragma unroll
            for (int tt = 0; tt < 8; ++tt) {
                const int tok = tok0 + tt; const float sc = ss[tt] * 0.08838834764831845f; const float eg = __expf(gcs[tok]);
                float q[8];
#pragma unroll
                for (int c = 0; c < 8; ++c) q[c] = o[tt][c] * sc;
                u32x4 w; w.x = pk2(q[0], q[1]); w.y = pk2(q[2], q[3]); w.z = pk2(q[4], q[5]); w.w = pk2(q[6], q[7]);
                *(LAS u32x4*)(qb + tok * 136 + gi * 8) = w;
                u32x4 d; d.x = pk2(q[0] * eg, q[1] * eg); d.y = pk2(q[2] * eg, q[3] * eg); d.z = pk2(q[4] * eg, q[5] * eg); d.w = pk2(q[6] * eg, q[7] * eg);
                *(u32x4*)(qdg + tok * 128 + gi * 8) = d;
            }
        } else if (part == 1) {
            float ed[8];
#pragma unroll
            for (int tt = 0; tt < 8; ++tt) {
                const int tok = tok0 + tt; const float sc = ss[tt]; const float gct = gcs[tok]; const float be = bet[tok] * __expf(gct);
                ed[tt] = __expf(gc_last - gct);
#pragma unroll
                for (int c = 0; c < 8; ++c) o[tt][c] *= sc;
                u32x4 w; w.x = pk2(o[tt][0], o[tt][1]); w.y = pk2(o[tt][2], o[tt][3]); w.z = pk2(o[tt][4], o[tt][5]); w.w = pk2(o[tt][6], o[tt][7]);
                *(LAS u32x4*)(kb + tok * 136 + gi * 8) = w;
                *(LAS f32x4*)(kr + tok * 128 + gi * 8) = (f32x4){o[tt][0] * be, o[tt][1] * be, o[tt][2] * be, o[tt][3] * be};
                *(LAS f32x4*)(kr + tok * 128 + gi * 8 + 4) = (f32x4){o[tt][4] * be, o[tt][5] * be, o[tt][6] * be, o[tt][7] * be};
            }
#pragma unroll
            for (int c = 0; c < 8; ++c) {
                u32x4 w; w.x = pk2(o[0][c] * ed[0], o[1][c] * ed[1]); w.y = pk2(o[2][c] * ed[2], o[3][c] * ed[3]); w.z = pk2(o[4][c] * ed[4], o[5][c] * ed[5]); w.w = pk2(o[6][c] * ed[6], o[7][c] * ed[7]);
                *(u32x4*)(kdtg + (gi * 8 + c) * 64 + tok0) = w;
            }
        } else {
#pragma unroll
            for (int tt = 0; tt < 8; ++tt) {
                const int tok = tok0 + tt; const float be = bet[tok];
                *(LAS f32x4*)(vr + tok * 128 + gi * 8) = (f32x4){o[tt][0] * be, o[tt][1] * be, o[tt][2] * be, o[tt][3] * be};
                *(LAS f32x4*)(vr + tok * 128 + gi * 8 + 4) = (f32x4){o[tt][4] * be, o[tt][5] * be, o[tt][6] * be, o[tt][7] * be};
            }
        }
    }
    if (tid == 0) ((float*)(p->ws + WS_CD))[it * 32] = __expf(gc_last);
    __syncthreads();
    {
        const int prod = wave >> 2, I = wave & 3, fr = lane & 15, fq = lane >> 4;
        const LAS bf16_t* X = prod ? qb : kb;
        bf16x8 af[4];
#pragma unroll
        for (int ks = 0; ks < 4; ++ks) af[ks] = *(const LAS bf16x8*)(X + (16 * I + fr) * 136 + ks * 32 + fq * 8);
        const int i0 = 16 * I + 4 * fq;
        float gci[4];
#pragma unroll
        for (int r = 0; r < 4; ++r) gci[r] = gcs[i0 + r];
#pragma unroll
        for (int J = 0; J < 4; ++J) {
            f32x4 acc = (f32x4){0.f, 0.f, 0.f, 0.f};
            if (J <= I) {
#pragma unroll
                for (int ks = 0; ks < 4; ++ks) { const bf16x8 bfr = *(const LAS bf16x8*)(kb + (16 * J + fr) * 136 + ks * 32 + fq * 8); acc = __builtin_amdgcn_mfma_f32_16x16x32_bf16(af[ks], bfr, acc, 0, 0, 0); }
            }
            const int j = 16 * J + fr; const float gcj = gcs[j];
            if (prod == 0) {
                if (J <= I) {
                    f32x4 o4;
#pragma unroll
                    for (int r = 0; r < 4; ++r) { const int i = i0 + r; o4[r] = (i > j) ? bet[i] * acc[r] * __expf(gci[r] - gcj) : 0.f; }
                    *(LAS f32x4*)(AT + j * 68 + i0) = o4;
                }
            } else {
#pragma unroll
                for (int r = 0; r < 4; ++r) { const int i = i0 + r; const float v = (i >= j) ? acc[r] * __expf(gci[r] - gcj) : 0.f; qkg[i * 64 + j] = (bf16_t)(pk2(v, 0.f) & 0xffffu); }
            }
        }
    }
    __syncthreads();
    if (tid < 256) {
        const LAS float* src = tid < 128 ? vr + tid : kr + (tid - 128);
        f32x2 ap[32];
#pragma unroll
        for (int k = 0; k < 32; ++k) ap[k] = (f32x2){src[(2 * k) * 128], src[(2 * k + 1) * 128]};
        f32x4 cur[16], nxt[16];
#pragma unroll
        for (int c = 0; c < 16; ++c) cur[c] = *(const LAS f32x4*)(AT + 4 * c);
#pragma unroll
        for (int j = 0; j < 63; ++j) {
#pragma unroll
            for (int c = 0; c < 16; ++c) if (j < 62 && 4 * c + 3 > j + 1) nxt[c] = *(const LAS f32x4*)(AT + (j + 1) * 68 + 4 * c);
            __builtin_amdgcn_sched_barrier(0);
            const float xj = (j & 1) ? ap[j >> 1].y : ap[j >> 1].x;
            if (!(j & 1)) ap[j >> 1].y -= cur[j >> 2][(j & 3) + 1] * xj;
#pragma unroll
            for (int k = (j >> 1) + 1; k < 32; ++k) { const int c = k >> 1, lo = (k & 1) * 2; ap[k] -= (f32x2){cur[c][lo], cur[c][lo + 1]} * xj; }
            __builtin_amdgcn_sched_barrier(0);
#pragma unroll
            for (int c = 0; c < 16; ++c) cur[c] = nxt[c];
        }
        bf16_t* dst = tid < 128 ? wg + tid : kcg + (tid - 128);
#pragma unroll
        for (int k = 0; k < 32; ++k) { const unsigned w2 = pk2(ap[k].x, ap[k].y); dst[(2 * k) * 128] = (bf16_t)(w2 & 0xffffu); dst[(2 * k + 1) * 128] = (bf16_t)(w2 >> 16); }
    }
}

__device__ __forceinline__ void gdn_sample(PP p, int l, int it, LAS unsigned char* lds) {
    const int tid = get_tid(), lane = tid & 63, wave = tid >> 6;
    const int hh = it & 3, b = it >> 2;
    const bf16_t* hb = (const bf16_t*)(p->ws + WS_H);
    const float* ba = (const float*)(p->ws + WS_BA);
    float* oraw = (float*)(p->ws + WS_O);
    LAS float* val = (LAS float*)lds;
    LAS float* valn = val + 4 * 384;
    LAS float* red = valn + 4 * 256;
    LAS float* kqs = red + 4 * 2 * 512;
    const int trow = TP + b * 4;
    const int dv = tid & 127, kq = tid >> 7;
    const size_t sbase = ((size_t)(l * 128 + b) * 4 + hh) * 16384 + (size_t)(32 * kq) * 128 + dv;
    if (tid < 384) {
        const int part = tid >> 7, d = tid & 127, col = part * 512 + hh * 128 + d;
        float full[7];
#pragma unroll
        for (int r = 0; r < 3; ++r) full[r] = p->in[2][((size_t)(l * 128 + b) * 3 + r) * 1536 + col];
#pragma unroll
        for (int i = 0; i < 4; ++i) full[3 + i] = bf2f(hb[(size_t)(trow + i) * HC + col]);
        float cw[4];
#pragma unroll
        for (int i = 0; i < 4; ++i) cw[i] = p->in[12][((size_t)l * 4 + i) * 1536 + col];
#pragma unroll
        for (int t = 0; t < 4; ++t) val[t * 384 + tid] = silu_f(cw[0] * full[t] + cw[1] * full[t + 1] + cw[2] * full[t + 2] + cw[3] * full[t + 3]);
#pragma unroll
        for (int r = 0; r < 3; ++r) p->out[OUT_CONV_S + ((size_t)(l * 128 + b) * 3 + r) * 1536 + col] = full[4 + r];
    }
    __syncthreads();
    {
        const int t = wave & 3, part = wave >> 2;
        const float q0 = val[t * 384 + lane], q1 = val[t * 384 + 64 + lane], k0 = val[t * 384 + 128 + lane], k1 = val[t * 384 + 192 + lane];
        const float scq = rsqrtf(wave_sum(q0 * q0 + q1 * q1) + 1e-6f) * 0.08838834764831845f, sck = rsqrtf(wave_sum(k0 * k0 + k1 * k1) + 1e-6f);
        const float dqk = wave_sum(q0 * k0 + q1 * k1);
        if (part == 0) { valn[t * 256 + lane] = q0 * scq; valn[t * 256 + 64 + lane] = q1 * scq; if (lane == 0) kqs[t] = dqk * scq * sck; }
        else { valn[t * 256 + 128 + lane] = k0 * sck; valn[t * 256 + 192 + lane] = k1 * sck; }
    }
    float dec[4], beta[4];
    {
        const float alog = -expf(p->in[13][l * 4 + hh]), dtb = p->in[14][l * 4 + hh];
#pragma unroll
        for (int t = 0; t < 4; ++t) {
            const float av = ba[(size_t)(trow + t) * 8 + 4 + hh] + dtb, bv = ba[(size_t)(trow + t) * 8 + hh];
            const float sp = av > 20.f ? av : log1pf(expf(av));
            dec[t] = expf(alog * sp); beta[t] = 1.f / (1.f + expf(-bv));
        }
    }
    __syncthreads();
    float S[32];
#pragma unroll
    for (int i = 0; i < 32; ++i) S[i] = p->in[3][sbase + (size_t)i * 128];
#pragma unroll
    for (int t = 0; t < 4; ++t) {
        const LAS float* qv = valn + t * 256 + 32 * kq; const LAS float* kv = qv + 128;
        float pk = 0.f, pq = 0.f;
#pragma unroll
        for (int i = 0; i < 32; ++i) { S[i] *= dec[t]; pk += S[i] * kv[i]; pq += S[i] * qv[i]; }
        LAS float* r0 = red + (t * 2 + 0) * 512; LAS float* r1 = red + (t * 2 + 1) * 512;
        r0[kq * 128 + dv] = pk; r1[kq * 128 + dv] = pq;
        __syncthreads();
        const float sk = (r0[dv] + r0[128 + dv]) + (r0[256 + dv] + r0[384 + dv]);
        const float u = beta[t] * (val[t * 384 + 256 + dv] - sk);
#pragma unroll
        for (int i = 0; i < 32; ++i) S[i] += kv[i] * u;
        if (kq == 0) oraw[(size_t)(trow + t) * DM + hh * 128 + dv] = ((r1[dv] + r1[128 + dv]) + (r1[256 + dv] + r1[384 + dv])) + u * kqs[t];
    }
    float* so = p->out + OUT_GDN_S + sbase;
#pragma unroll
    for (int i = 0; i < 32; ++i) so[(size_t)i * 128] = S[i];
    __syncthreads();
}

__device__ __forceinline__ void swa_prompt(PP p, int l, int it, LAS unsigned char* lds) {
    const int tid = get_tid(), lane = tid & 63, wave = tid >> 6, fr = lane & 15, fq = lane >> 4;
    const int rr = it >> 3, pr = (rr >> 5) * 8 + (it & 7), qt = rr & 31, b = pr >> 1, kvh = pr & 1;
    const int q0 = qt * 64, kbase = q0 - 128;
    const bf16_t* hb = (const bf16_t*)(p->ws + WS_H) + (size_t)(b * 2048) * HC;
    float* oraw = (float*)(p->ws + WS_O) + (size_t)(b * 2048) * DM;
    LAS bf16_t* Ks = (LAS bf16_t*)lds;
    LAS bf16_t* VT = Ks + 192 * 72;
#pragma unroll
    for (int i = 0; i < 3; ++i) {
        const int id = tid + 512 * i, row = id >> 3, c8 = id & 7, kp = kbase + row;
        u32x4 kr4 = (u32x4){0u, 0u, 0u, 0u}, vr4 = kr4;
        if (kp >= 0) { kr4 = *(const u32x4*)(hb + (size_t)kp * HC + C_SK + kvh * 64 + c8 * 8); vr4 = *(const u32x4*)(hb + (size_t)kp * HC + C_SV + kvh * 64 + c8 * 8); }
        *(LAS u32x4*)(Ks + row * 72 + c8 * 8) = kr4;
        LAS bf16_t* vt = VT + (c8 * 8) * 200 + row;
        vt[0 * 200] = (bf16_t)(vr4.x & 0xffffu); vt[1 * 200] = (bf16_t)(vr4.x >> 16); vt[2 * 200] = (bf16_t)(vr4.y & 0xffffu); vt[3 * 200] = (bf16_t)(vr4.y >> 16);
        vt[4 * 200] = (bf16_t)(vr4.z & 0xffffu); vt[5 * 200] = (bf16_t)(vr4.z >> 16); vt[6 * 200] = (bf16_t)(vr4.w & 0xffffu); vt[7 * 200] = (bf16_t)(vr4.w >> 16);
        if (qt >= 30 && row >= 128) {
            float kf[8], vf[8]; unpack8(kr4, kf); unpack8(vr4, vf);
            const size_t o = ((size_t)(l * 8 + b) * 128 + (kp - 1920)) * 128 + kvh * 64 + c8 * 8;
            *(f32x4*)(p->out + OUT_K_P + o) = (f32x4){kf[0], kf[1], kf[2], kf[3]}; *(f32x4*)(p->out + OUT_K_P + o + 4) = (f32x4){kf[4], kf[5], kf[6], kf[7]};
            *(f32x4*)(p->out + OUT_V_P + o) = (f32x4){vf[0], vf[1], vf[2], vf[3]}; *(f32x4*)(p->out + OUT_V_P + o + 4) = (f32x4){vf[4], vf[5], vf[6], vf[7]};
        }
    }
    const int g = wave >> 1, half = wave & 1, hq = kvh * 4 + g;
    const int qrow0 = q0 + 32 * half, kl0 = 32 * half;
    bf16x8 qf[2][2];
#pragma unroll
    for (int qt2 = 0; qt2 < 2; ++qt2)
#pragma unroll
        for (int ks = 0; ks < 2; ++ks) qf[qt2][ks] = *(const bf16x8*)(hb + (size_t)(qrow0 + 16 * qt2 + fr) * HC + C_SQ + hq * 64 + ks * 32 + fq * 8);
    __syncthreads();
    f32x4 sacc[2][10];
#pragma unroll
    for (int kt = 0; kt < 10; ++kt) {
        bf16x8 kf[2];
#pragma unroll
        for (int ks = 0; ks < 2; ++ks) kf[ks] = *(const LAS bf16x8*)(Ks + (kl0 + 16 * kt + fr) * 72 + ks * 32 + fq * 8);
#pragma unroll
        for (int qt2 = 0; qt2 < 2; ++qt2) {
            f32x4 a = (f32x4){0.f, 0.f, 0.f, 0.f};
            a = __builtin_amdgcn_mfma_f32_16x16x32_bf16(kf[0], qf[qt2][0], a, 0, 0, 0);
            a = __builtin_amdgcn_mfma_f32_16x16x32_bf16(kf[1], qf[qt2][1], a, 0, 0, 0);
            sacc[qt2][kt] = a;
        }
    }
    const float sink = p->in[16][l * 8 + hq];
    float inv[2];
    bf16x8 pf[2][5];
#pragma unroll
    for (int qt2 = 0; qt2 < 2; ++qt2) {
        float m = sink;
#pragma unroll
        for (int kt = 0; kt < 10; ++kt)
#pragma unroll
            for (int r = 0; r < 4; ++r) {
                const int diff = 128 + 16 * qt2 + fr - 16 * kt - 4 * fq - r;
                const int kp = kbase + kl0 + 16 * kt + 4 * fq + r;
                const bool ok = (diff >= 0) && (diff < 128) && (kp >= 0);
                const float s = ok ? sacc[qt2][kt][r] * 0.125f : -__builtin_inff();
                sacc[qt2][kt][r] = s; m = fmaxf(m, s);
            }
        m = fmaxf(m, __shfl_xor(m, 16)); m = fmaxf(m, __shfl_xor(m, 32));
        float sum = 0.f;
#pragma unroll
        for (int kt = 0; kt < 10; ++kt)
#pragma unroll
            for (int r = 0; r < 4; ++r) { const float e = __expf(sacc[qt2][kt][r] - m); sacc[qt2][kt][r] = e; sum += e; }
        sum += __shfl_xor(sum, 16); sum += __shfl_xor(sum, 32);
        sum += __expf(sink - m);
        inv[qt2] = 1.f / sum;
#pragma unroll
        for (int s5 = 0; s5 < 5; ++s5) {
            const f32x4 a = sacc[qt2][2 * s5], c = sacc[qt2][2 * s5 + 1];
            u32x4 w; w.x = pk2(a[0], a[1]); w.y = pk2(a[2], a[3]); w.z = pk2(c[0], c[1]); w.w = pk2(c[2], c[3]);
            pf[qt2][s5] = __builtin_bit_cast(bf16x8, w);
        }
    }
#pragma unroll
    for (int dt = 0; dt < 4; ++dt) {
        f32x4 oa[2] = {(f32x4){0.f, 0.f, 0.f, 0.f}, (f32x4){0.f, 0.f, 0.f, 0.f}};
#pragma unroll
        for (int s5 = 0; s5 < 5; ++s5) {
            const LAS bf16_t* vp = VT + (16 * dt + fr) * 200 + kl0 + 32 * s5 + 4 * fq;
            const u32x2 lo = *(const LAS u32x2*)vp, hi = *(const LAS u32x2*)(vp + 16);
            const bf16x8 vf = __builtin_bit_cast(bf16x8, (u32x4){lo.x, lo.y, hi.x, hi.y});
            oa[0] = __builtin_amdgcn_mfma_f32_16x16x32_bf16(vf, pf[0][s5], oa[0], 0, 0, 0);
            oa[1] = __builtin_amdgcn_mfma_f32_16x16x32_bf16(vf, pf[1][s5], oa[1], 0, 0, 0);
        }
#pragma unroll
        for (int qt2 = 0; qt2 < 2; ++qt2)
            *(f32x4*)(oraw + (size_t)(qrow0 + 16 * qt2 + fr) * DM + 512 + hq * 64 + 16 * dt + 4 * fq) = oa[qt2] * inv[qt2];
    }
    __syncthreads();
}

__device__ __forceinline__ void swa_sample(PP p, int l, int it, LAS unsigned char* lds) {
    const int tid = get_tid(), lane = tid & 63, wave = tid >> 6;
    const int kvh = it & 1, b = it >> 1;
    const bf16_t* hb = (const bf16_t*)(p->ws + WS_H) + (size_t)(TP + b * 4) * HC;
    float* oraw = (float*)(p->ws + WS_O) + (size_t)(TP + b * 4) * DM;
    LAS float* Kc = (LAS float*)lds;
    LAS float* Vc = Kc + 132 * 68;
    LAS float* Qs = Vc + 132 * 68;
    LAS float* sc = Qs + 16 * 64;
    for (int id = tid; id < 132 * 16; id += NTHR) {
        const int row = id >> 4, c4 = (id & 15) * 4;
        f32x4 kv, vv;
        if (row < 128) {
            const size_t o = ((size_t)(l * 128 + b) * 128 + row) * 128 + kvh * 64 + c4;
            kv = *(const f32x4*)(p->in[4] + o); vv = *(const f32x4*)(p->in[5] + o);
        } else {
            const bf16_t* hp = hb + (size_t)(row - 128) * HC + kvh * 64 + c4;
            const u32x2 kr = *(const u32x2*)(hp + C_SK), vr = *(const u32x2*)(hp + C_SV);
            kv = (f32x4){bflo(kr.x), bfhi(kr.x), bflo(kr.y), bfhi(kr.y)}; vv = (f32x4){bflo(vr.x), bfhi(vr.x), bflo(vr.y), bfhi(vr.y)};
        }
        *(LAS f32x4*)(Kc + row * 68 + c4) = kv; *(LAS f32x4*)(Vc + row * 68 + c4) = vv;
        if (row >= 4) {
            const size_t o = ((size_t)(l * 128 + b) * 128 + (row - 4)) * 128 + kvh * 64 + c4;
            *(f32x4*)(p->out + OUT_K_S + o) = kv; *(f32x4*)(p->out + OUT_V_S + o) = vv;
        }
    }
    for (int id = tid; id < 16 * 64; id += NTHR) {
        const int row = id >> 6, d = id & 63, g = row >> 2, i = row & 3;
        Qs[id] = bf2f(hb[(size_t)i * HC + C_SQ + (kvh * 4 + g) * 64 + d]);
    }
    __syncthreads();
    for (int id = tid; id < 16 * 132; id += NTHR) {
        const int row = id / 132, key = id % 132, i = row & 3;
        const LAS float* kp = Kc + key * 68; const LAS float* qp = Qs + row * 64;
        float s = 0.f;
#pragma unroll
        for (int d = 0; d < 64; d += 4) { const f32x4 a = *(const LAS f32x4*)(kp + d), c = *(const LAS f32x4*)(qp + d); s += (a.x * c.x + a.y * c.y) + (a.z * c.z + a.w * c.w); }
        const bool ok = (key >= i + 1) && (key <= i + 128);
        sc[row * 136 + key] = ok ? s * 0.125f : -__builtin_inff();
    }
    __syncthreads();
#pragma unroll
    for (int rr = 0; rr < 2; ++rr) {
        const int row = wave * 2 + rr, g = row >> 2;
        const float sink = p->in[16][l * 8 + kvh * 4 + g];
        const float s0 = sc[row * 136 + lane], s1 = sc[row * 136 + 64 + lane], s2 = lane < 4 ? sc[row * 136 + 128 + lane] : -__builtin_inff();
        float m = fmaxf(fmaxf(s0, s1), fmaxf(s2, sink));
#pragma unroll
        for (int o = 1; o < 64; o <<= 1) m = fmaxf(m, __shfl_xor(m, o));
        const float e0 = __expf(s0 - m), e1 = __expf(s1 - m), e2 = __expf(s2 - m);
        const float inv = 1.f / (wave_sum(e0 + e1 + e2) + __expf(sink - m));
        sc[row * 136 + lane] = e0 * inv; sc[row * 136 + 64 + lane] = e1 * inv; if (lane < 4) sc[row * 136 + 128 + lane] = e2 * inv;
    }
    __syncthreads();
    {
        const int row = tid >> 5, d2 = (tid & 31) * 2, g = row >> 2, i = row & 3;
        float o0 = 0.f, o1 = 0.f;
#pragma unroll 6
        for (int key = 0; key < 132; ++key) { const float pr = sc[row * 136 + key]; const f32x2 v = *(const LAS f32x2*)(Vc + key * 68 + d2); o0 += pr * v.x; o1 += pr * v.y; }
        *(f32x2*)(oraw + (size_t)i * DM + 512 + (kvh * 4 + g) * 64 + d2) = (f32x2){o0, o1};
    }
    __syncthreads();
}

__device__ __forceinline__ void gdn_chain(PP p, int l, int c, LAS unsigned char* lds) {
    const int tid = get_tid(), lane = tid & 63, wave = tid >> 6, fr = lane & 15, fq = lane >> 4;
    const int xg = c & 7, jg = c >> 3, vs = jg & 3, grp = (jg >> 2) * 8 + xg, hh = grp & 3, b = grp >> 2;
    float* oraw = (float*)(p->ws + WS_O);
    const float* cdg = (const float*)(p->ws + WS_CD);
    LAS bf16_t* STb = (LAS bf16_t*)lds;
    LAS bf16_t* kcs = STb + 32 * 136;
    LAS bf16_t* qds = kcs + 64 * 136;
    LAS bf16_t* kdts = qds + 64 * 136;
    LAS bf16_t* qks = kdts + 128 * 72;
    LAS bf16_t* wsl = qks + 64 * 72;
    LAS bf16_t* uT = wsl + 64 * 40;
    u32x4 rk[2], rq[2], rd[2], rqk, rw;
    auto prefetch = [&](int n) {
        const bf16_t* gb = (const bf16_t*)(p->ws + WS_G) + (size_t)(((b * 32 + n) << 2) + hh) * G_ITEM;
#pragma unroll
        for (int i = 0; i < 2; ++i) { const int id = tid + 512 * i;
            rk[i] = *(const u32x4*)(gb + 8192 + (id >> 4) * 128 + (id & 15) * 8);
            rq[i] = *(const u32x4*)(gb + 16384 + (id >> 4) * 128 + (id & 15) * 8);
            rd[i] = *(const u32x4*)(gb + 24576 + (id >> 3) * 64 + (id & 7) * 8); }
        rqk = *(const u32x4*)(gb + 32768 + (tid >> 3) * 64 + (tid & 7) * 8);
        if (tid < 256) rw = *(const u32x4*)(gb + (tid >> 2) * 128 + 32 * vs + (tid & 3) * 8);
    };
    auto commit = [&]() {
#pragma unroll
        for (int i = 0; i < 2; ++i) { const int id = tid + 512 * i;
            *(LAS u32x4*)(kcs + (id >> 4) * 136 + (id & 15) * 8) = rk[i];
            *(LAS u32x4*)(qds + (id >> 4) * 136 + (id & 15) * 8) = rq[i];
            *(LAS u32x4*)(kdts + (id >> 3) * 72 + (id & 7) * 8) = rd[i]; }
        *(LAS u32x4*)(qks + (tid >> 3) * 72 + (tid & 7) * 8) = rqk;
        if (tid < 256) *(LAS u32x4*)(wsl + (tid >> 2) * 40 + (tid & 3) * 8) = rw;
    };
    LAS float* cds = (LAS float*)(uT + 32 * 72);
    if (tid < 32) cds[tid] = cdg[(((b * 32 + tid) << 2) + hh) * 32];
    prefetch(0);
    for (int i = tid; i < 32 * 136 / 2; i += NTHR) ((LAS unsigned*)STb)[i] = 0u;
    commit();
    f32x4 sa[2] = {(f32x4){0.f, 0.f, 0.f, 0.f}, (f32x4){0.f, 0.f, 0.f, 0.f}};
    const int I = wave >> 1, Jt = wave & 1;
    __syncthreads();
    for (int n = 0; n < 32; ++n) {
        const float cd = cds[n];
        if (n + 1 < 32) prefetch(n + 1);
        bf16x8 sfr[4];
        {
            f32x4 a = (f32x4){0.f, 0.f, 0.f, 0.f};
            bf16x8 af[4];
#pragma unroll
            for (int ks = 0; ks < 4; ++ks) { af[ks] = *(const LAS bf16x8*)(kcs + (16 * I + fr) * 136 + ks * 32 + fq * 8); sfr[ks] = *(const LAS bf16x8*)(STb + (16 * Jt + fr) * 136 + ks * 32 + fq * 8); }
            float w4[4];
#pragma unroll
            for (int r = 0; r < 4; ++r) w4[r] = bf2f(wsl[(16 * I + 4 * fq + r) * 40 + 16 * Jt + fr]);
            __builtin_amdgcn_sched_barrier(0);
#pragma unroll
            for (int ks = 0; ks < 4; ++ks) a = __builtin_amdgcn_mfma_f32_16x16x32_bf16(af[ks], sfr[ks], a, 0, 0, 0);
            float u4[4];
#pragma unroll
            for (int r = 0; r < 4; ++r) u4[r] = w4[r] - a[r];
            u32x2 w; w.x = pk2(u4[0], u4[1]); w.y = pk2(u4[2], u4[3]);
            *(LAS u32x2*)(uT + (16 * Jt + fr) * 72 + 16 * I + 4 * fq) = w;
        }
        __syncthreads();
        {
            f32x4 a = (f32x4){0.f, 0.f, 0.f, 0.f};
            bf16x8 af[6], ufo[2], kf[2], ufx[2];
#pragma unroll
            for (int ks = 0; ks < 4; ++ks) af[ks] = *(const LAS bf16x8*)(qds + (16 * I + fr) * 136 + ks * 32 + fq * 8);
#pragma unroll
            for (int ks = 0; ks < 2; ++ks) { af[4 + ks] = *(const LAS bf16x8*)(qks + (16 * I + fr) * 72 + ks * 32 + fq * 8); ufo[ks] = *(const LAS bf16x8*)(uT + (16 * Jt + fr) * 72 + ks * 32 + fq * 8); }
#pragma unroll
            for (int ks = 0; ks < 2; ++ks) { kf[ks] = *(const LAS bf16x8*)(kdts + (16 * wave + fr) * 72 + ks * 32 + fq * 8); ufx[ks] = *(const LAS bf16x8*)(uT + (16 * (Jt ^ 1) + fr) * 72 + ks * 32 + fq * 8); }
            __builtin_amdgcn_sched_barrier(0);
#pragma unroll
            for (int ks = 0; ks < 4; ++ks) a = __builtin_amdgcn_mfma_f32_16x16x32_bf16(sfr[ks], af[ks], a, 0, 0, 0);
#pragma unroll
            for (int ks = 0; ks < 2; ++ks) a = __builtin_amdgcn_mfma_f32_16x16x32_bf16(ufo[ks], af[4 + ks], a, 0, 0, 0);
            {
                f32x4 s0 = sa[0] * cd, s1 = sa[1] * cd;
#pragma unroll
                for (int ks = 0; ks < 2; ++ks) { s0 = __builtin_amdgcn_mfma_f32_16x16x32_bf16(kf[ks], ufo[ks], s0, 0, 0, 0); s1 = __builtin_amdgcn_mfma_f32_16x16x32_bf16(kf[ks], ufx[ks], s1, 0, 0, 0); }
                sa[0] = s0; sa[1] = s1;
            }
            *(f32x4*)(oraw + (size_t)(b * 2048 + n * 64 + 16 * I + fr) * DM + hh * 128 + 32 * vs + 16 * Jt + 4 * fq) = a;
        }
        __syncthreads();
#pragma unroll
        for (int j2 = 0; j2 < 2; ++j2) { u32x2 w; w.x = pk2(sa[j2][0], sa[j2][1]); w.y = pk2(sa[j2][2], sa[j2][3]);
            *(LAS u32x2*)(STb + (16 * (Jt ^ j2) + fr) * 136 + 16 * wave + 4 * fq) = w; }
        if (n + 1 < 32) commit();
        __syncthreads();
    }
    float* so = p->out + OUT_GDN_P + ((size_t)(l * 8 + b) * 4 + hh) * 16384;
#pragma unroll
    for (int j2 = 0; j2 < 2; ++j2)
#pragma unroll
        for (int r = 0; r < 4; ++r) so[(size_t)(16 * wave + 4 * fq + r) * 128 + 32 * vs + 16 * (Jt ^ j2) + fr] = sa[j2][r];
}

__device__ __forceinline__ void finalize_phase(PP p, int l, int bid, int nb) {
    const int tid = get_tid(), lane = tid & 63, wave = tid >> 6;
    const float* oraw = (const float*)(p->ws + WS_O);
    const bf16_t* hb = (const bf16_t*)(p->ws + WS_H);
    bf16_t* mix = (bf16_t*)(p->ws + WS_XN);
    float wv[16];
    {
        const float* wp = lane < 32 ? p->in[15] + l * 128 + (lane & 7) * 16 : p->in[17] + l * 512 + (lane - 32) * 16;
#pragma unroll
        for (int e = 0; e < 16; ++e) wv[e] = wp[e];
    }
    for (int kk = 0;; ++kk) {
        const int row = row_of(kk, bid, wave, nb); if (row < 0) break;
        const f32x4* op = (const f32x4*)(oraw + (size_t)row * DM + 16 * lane);
        float v[16]; float s = 0.f;
#pragma unroll
        for (int j = 0; j < 4; ++j) { const f32x4 a = op[j]; v[4 * j] = a.x; v[4 * j + 1] = a.y; v[4 * j + 2] = a.z; v[4 * j + 3] = a.w; s += (a.x * a.x + a.y * a.y) + (a.z * a.z + a.w * a.w); }
        s += __shfl_xor(s, 1); s += __shfl_xor(s, 2); s += __shfl_xor(s, 4);
        float s5 = s; s5 += __shfl_xor(s5, 8); s5 += __shfl_xor(s5, 16);
        const float rs = lane < 32 ? rsqrtf(s * (1.f / 128.f) + 1e-6f) : rsqrtf(s5 * (1.f / 512.f) + 1e-6f);
        if (lane < 32) {
            const u32x4* zp = (const u32x4*)(hb + (size_t)row * HC + C_Z + 16 * lane);
            float z[16]; { float t8[8]; unpack8(zp[0], t8);
#pragma unroll
                for (int e = 0; e < 8; ++e) z[e] = t8[e];
                unpack8(zp[1], t8);
#pragma unroll
                for (int e = 0; e < 8; ++e) z[8 + e] = t8[e]; }
#pragma unroll
            for (int e = 0; e < 16; ++e) v[e] = v[e] * rs * wv[e] * silu_f(z[e]);
        } else {
#pragma unroll
            for (int e = 0; e < 16; ++e) v[e] = v[e] * rs * wv[e];
        }
        u32x4 o0, o1;
        o0.x = pk2(v[0], v[1]); o0.y = pk2(v[2], v[3]); o0.z = pk2(v[4], v[5]); o0.w = pk2(v[6], v[7]);
        o1.x = pk2(v[8], v[9]); o1.y = pk2(v[10], v[11]); o1.z = pk2(v[12], v[13]); o1.w = pk2(v[14], v[15]);
        u32x4* mp = (u32x4*)(mix + (size_t)row * DM + 16 * lane); mp[0] = o0; mp[1] = o1;
    }
}

#define XB_TMO      128
#define XB_XCNT(j)  (256  + 64 * (j))
#define XB_XSUB(j)  (1280 + 64 * (j))
#define XB_XGEN(j)  (2304 + 64 * (j))
#define XB_TOP      3328
#define XB_TOPGEN   3392
#define XCD_BAR_WORDS 3456
#define XB_SPIN_CAP (1u << 20)
__device__ __forceinline__ unsigned xb_ld(unsigned* p)              { return __hip_atomic_load(p, __ATOMIC_RELAXED, __HIP_MEMORY_SCOPE_AGENT); }
__device__ __forceinline__ unsigned xb_add(unsigned* p, unsigned v) { return __hip_atomic_fetch_add(p, v, __ATOMIC_RELAXED, __HIP_MEMORY_SCOPE_AGENT); }
__device__ __forceinline__ unsigned xb_xcc_id() { return (unsigned)__builtin_amdgcn_s_getreg((3 << 11) | 20) & 0xFu; }
#define XB_SPIN(cond, bar) do { unsigned _sp = 0; while (cond) { __builtin_amdgcn_s_sleep(1); \
    if ((++_sp & 255u) == 0u) { if (xb_ld(&(bar)[XB_TMO])) break; if (_sp > XB_SPIN_CAP) { atomicAdd(&(bar)[XB_TMO], 1u); break; } } } } while (0)
__device__ __forceinline__ void xcd_barrier_complete(unsigned* bar, unsigned x, unsigned& nloc, unsigned& nx) {
    const unsigned G = gridDim.x * gridDim.y * gridDim.z;
    unsigned sum, cnt, mine, sp = 0u;
    for (;;) {
        sum = 0u; cnt = 0u; mine = 0u;
#pragma unroll
        for (unsigned j = 0; j < 16; ++j) { const unsigned c = xb_ld(&bar[XB_XCNT(j)]); sum += c; cnt += (c > 0u) ? 1u : 0u; mine = (j == x) ? c : mine; }
        if (sum == G) break;
        __builtin_amdgcn_s_sleep(1);
        if ((++sp & 255u) == 0u) { if (xb_ld(&bar[XB_TMO])) break; if (sp > XB_SPIN_CAP) { atomicAdd(&bar[XB_TMO], 1u); break; } }
    }
    nloc = mine > 0u ? mine : 1u; nx = cnt > 0u ? cnt : 1u;
}
__device__ __forceinline__ void xcd_barrier(unsigned* bar, volatile LAS unsigned* st) {
    asm volatile("s_waitcnt vmcnt(0)" ::: "memory");
    __syncthreads();
    if (threadIdx.x == 0) {
        const unsigned x = xb_xcc_id();
        __builtin_amdgcn_s_waitcnt(0);
        unsigned nloc = st[0], nx = st[1];
        if (nloc == 0u) { xcd_barrier_complete(bar, x, nloc, nx); st[0] = nloc; st[1] = nx; }
        const unsigned old = xb_add(&bar[XB_XSUB(x)], 1u);
        const unsigned gen = old / nloc;
        if (old + 1u == (gen + 1u) * nloc) {
            __builtin_amdgcn_fence(__ATOMIC_RELEASE, "agent");
            asm volatile("s_waitcnt vmcnt(0)" ::: "memory");
            const unsigned og = xb_add(&bar[XB_TOP], 1u);
            const unsigned tg = og / nx;
            if (og + 1u == (tg + 1u) * nx) xb_add(&bar[XB_TOPGEN], 1u);
            else XB_SPIN(xb_ld(&bar[XB_TOPGEN]) == tg, bar);
            __builtin_amdgcn_fence(__ATOMIC_ACQUIRE, "agent");
            xb_add(&bar[XB_XGEN(x)], 1u);
            asm volatile("s_waitcnt vmcnt(0)" ::: "memory");
        } else {
            XB_SPIN(xb_ld(&bar[XB_XGEN(x)]) == gen, bar);
            __builtin_amdgcn_fence(__ATOMIC_ACQUIRE, "agent");
            asm volatile("s_waitcnt vmcnt(0)" ::: "memory");
        }
    }
    __syncthreads();
}

#ifndef PROBE_A
#define PROBE_A 1
#endif
#ifndef PROBE_C
#define PROBE_C 1
#endif
__global__ void __launch_bounds__(NTHR, 2) hymba_fwd(Params pv) {
    extern __shared__ __attribute__((aligned(16))) unsigned char smem[];
    LAS unsigned char* lds = (LAS unsigned char*)smem;
    cg::grid_group grid = cg::this_grid();
    const int bid = blockIdx.x, nb = gridDim.x;
    volatile LAS unsigned* xst = (volatile LAS unsigned*)(lds + LDS_MAIN);
    if (threadIdx.x == 0) { xst[0] = 0u; xst[1] = 0u; (void)xb_add((unsigned*)(pv.ws + WS_BAR) + XB_XCNT(xb_xcc_id()), 1u); }
    __syncthreads();
    const int ph_lo = pv.ph_lo, ph_hi = pv.ph_hi;
    int ph = 0;
#define RUN (ph >= ph_lo && ph < ph_hi)
#if defined(USE_CG_SYNC)
#define SEAM() do { ++ph; if (ph > ph_lo && ph < ph_hi) grid.sync(); } while (0)
#else
#define SEAM() do { ++ph; if (ph > ph_lo && ph < ph_hi) xcd_barrier((unsigned*)(get_params()->ws + WS_BAR), xst); } while (0)
#endif
    if (RUN) { PP p = get_params(); prep_phase(p, lds, bid, nb); }
    if (ph_hi == -12345) grid.sync();
    SEAM();
#pragma unroll 1
    for (int step = 0; step < 12; ++step) {
        const int l = step / 3, ty = step % 3;
        if (step > 0) {
            if (RUN) {
                PP p = get_params();
                float* xres = (float*)(p->ws + WS_X); bf16_t* xn = (bf16_t*)(p->ws + WS_XN);
                const float* part = (const float*)(p->ws + WS_O);
                const int nsp = ty == 2 ? DM / 256 : FF / 256; const float psc = ty == 2 ? 1.f : 0.5f;
                if (ty == 1) rms_phase<1>(xres, p->in[10] + l * DM, xn, nullptr, (float*)(p->ws + WS_BA), p->in[11] + (size_t)l * DM * INC, part, nsp, psc, bid, nb);
                else rms_phase<0>(xres, p->in[ty == 0 ? 6 : 19] + l * DM, xn, nullptr, nullptr, nullptr, part, nsp, psc, bid, nb);
            }
            SEAM();
        }
        if (RUN) {
            PP p = get_params();
            const bf16_t* wl = (const bf16_t*)(p->ws + WS_W) + (size_t)l * WL_ELEMS;
            const bf16_t* xn = (const bf16_t*)(p->ws + WS_XN); bf16_t* hbuf = (bf16_t*)(p->ws + WS_H);
            if (ty == 1) {
                pg8::Gemm g{xn, wl + O_IN, DM, DM / 64}; pg8::StaticOrder S; S.init(TT, HC, nb, bid); pg8::EpiH E{hbuf, HC};
                pg8::gemm_phase(lds, g, S, E);
            } else {
                pg8::Gemm g{xn, wl + (ty == 0 ? O_GU1 : O_GU2), DM, DM / 64}; pg8::StaticOrder S; S.init(TT, 2 * FF, nb, bid); pg8::EpiGU E{hbuf};
                pg8::gemm_phase(lds, g, S, E);
            }
        }
        SEAM();
        if (ty == 1) {
            if (RUN) {
                for (int rep = 0; rep < PROBE_A; ++rep)
                for (int it = bid; it < 1024 + 512; it += nb) {
                    PP p = get_params();
                    if (it < 1024) gdn_stage_a(p, l, it, lds);
                    else { __syncthreads(); gdn_sample(p, l, it - 1024, lds); }
                }
            }
            SEAM();
            if (RUN) {
                if (bid < 128 || nb < 256) { for (int rep = 0; rep < PROBE_C; ++rep) for (int c = bid; c < 128; c += nb) { PP p = get_params(); gdn_chain(p, l, c, lds); __syncthreads(); } }
                const int sb = nb >= 256 ? bid - 128 : bid, sn = nb >= 256 ? nb - 128 : nb;
                if (sb >= 0) for (int it = sb; it < 512 + 256; it += sn) {
                    PP p = get_params();
                    if (it < 512) swa_prompt(p, l, it, lds);
                    else swa_sample(p, l, it - 512, lds);
                }
            }
            SEAM();
            if (RUN) { PP p = get_params(); finalize_phase(p, l, bid, nb); }
            SEAM();
        }
        if (RUN) {
            PP p = get_params();
            const bf16_t* wl = (const bf16_t*)(p->ws + WS_W) + (size_t)l * WL_ELEMS;
            float* xres = (float*)(p->ws + WS_X);
            const bf16_t* A = ty == 1 ? (const bf16_t*)(p->ws + WS_XN) : (const bf16_t*)(p->ws + WS_H); const bf16_t* Bt = wl + (ty == 0 ? O_DN1 : ty == 1 ? O_OUT : O_DN2);
            const int K = ty == 1 ? DM : FF; const float scale = ty == 1 ? 1.f : 0.5f;
            {
                pg8::Gemm g{A, Bt, K, K / 64}; pg8::StaticOrder S; S.init(TP, DM, nb, bid); pg8::EpiRes E{xres, scale};
                pg8::gemm_phase(lds, g, S, E);
            }
            {
                pg8::Gemm g{A, Bt, K, 4}; pg8::SplitOrder S{TP / 256, TSM / 256, DM / 256, K / 256, 512, nb, bid}; pg8::EpiPart E{(float*)(p->ws + WS_O)};
                pg8::gemm_phase(lds, g, S, E);
            }
        }
        SEAM();
    }
    if (RUN) { PP p = get_params(); rms_phase<2>((float*)(p->ws + WS_X), p->in[23], nullptr, p->out + OUT_Y, nullptr, nullptr, (const float*)(p->ws + WS_O), FF / 256, 0.5f, bid, nb); }
#undef RUN
#undef SEAM
}

extern "C" void kernel_launch(void* const* d_in, const int* in_sizes, int n_in, void* d_out, int out_size, void* d_ws, size_t ws_size, hipStream_t stream) {
    static int grid = 0;
    if (grid == 0) {
        if (n_in != 24 || (size_t)out_size != OUT_END || ws_size < WS_END) { fprintf(stderr, "kernel_launch: unexpected shapes (n_in %d out %d ws %zu need %zu)\n", n_in, out_size, ws_size, (size_t)WS_END); grid = -1; return; }
        int dev = 0, cus = 0, per_cu = 0;
        (void)hipGetDevice(&dev); (void)hipDeviceGetAttribute(&cus, hipDeviceAttributeMultiprocessorCount, dev);
        (void)hipFuncSetAttribute((const void*)hymba_fwd, hipFuncAttributeMaxDynamicSharedMemorySize, LDS_BYTES);
        (void)hipOccupancyMaxActiveBlocksPerMultiprocessor(&per_cu, (const void*)hymba_fwd, NTHR, LDS_BYTES);
        (void)hipGetLastError();
        if (per_cu < 1) fprintf(stderr, "kernel_launch: occupancy query says %d blocks per CU\n", per_cu);
        grid = cus;
    }
    if (grid < 0) return;
    Params p{};
    for (int i = 0; i < 24; ++i) p.in[i] = (const float*)d_in[i];
    p.out = (float*)d_out; p.ws = (unsigned char*)d_ws; p.ph_lo = 0; p.ph_hi = 1 << 20;
    void* args[] = {&p};
    (void)hipMemsetAsync((char*)d_ws + WS_BAR, 0, 16384, stream);
    hipError_t e = hipLaunchCooperativeKernel((const void*)hymba_fwd, dim3(grid), dim3(NTHR), args, LDS_BYTES, stream);
    if (e != hipSuccess) fprintf(stderr, "cooperative launch failed: %s (grid %d)\n", hipGetErrorString(e), grid);
}
```

```cpp
#include <hip/hip_runtime.h>
#include <hip/hip_cooperative_groups.h>
#include <cstdio>
namespace cg = cooperative_groups;

#define LAS __attribute__((address_space(3)))
typedef unsigned short bf16_t;
typedef short bf16x8 __attribute__((ext_vector_type(8)));
typedef float f32x4 __attribute__((ext_vector_type(4)));
typedef float f32x2 __attribute__((ext_vector_type(2)));
typedef unsigned u32x4 __attribute__((ext_vector_type(4)));
typedef unsigned u32x2 __attribute__((ext_vector_type(2)));

constexpr int TP = 16384, TSM = 512, TT = TP + TSM, DM = 1024, FF = 2816, HC = 2816, INC = 2824;
constexpr int C_Z = 1536, C_SQ = 2048, C_SK = 2560, C_SV = 2688;
constexpr int NTHR = 512, LDS_MAIN = 131072, LDS_BYTES = LDS_MAIN + 16;
constexpr size_t E_GU = (size_t)2 * FF * DM, E_DN = (size_t)DM * FF, E_IN = (size_t)HC * DM, E_OUT = (size_t)DM * DM;
constexpr size_t O_GU1 = 0, O_DN1 = O_GU1 + E_GU, O_IN = O_DN1 + E_DN, O_OUT = O_IN + E_IN, O_GU2 = O_OUT + E_OUT, O_DN2 = O_GU2 + E_GU, WL_ELEMS = O_DN2 + E_DN;
constexpr size_t WS_W = 0;
constexpr size_t WS_X = WS_W + 4 * WL_ELEMS * 2;
constexpr size_t WS_XN = WS_X + (size_t)TT * DM * 4;
constexpr size_t WS_H = WS_XN + (size_t)TT * DM * 2;
constexpr size_t WS_O = WS_H + (size_t)TT * HC * 2;
constexpr size_t WS_G = WS_O + (size_t)TT * DM * 4;
constexpr size_t G_ITEM = 8192 * 4 + 4096;
constexpr size_t WS_CD = WS_G + (size_t)1024 * G_ITEM * 2;
constexpr size_t WS_BA = WS_CD + 131072;
constexpr size_t WS_BAR = WS_BA + (size_t)TT * 8 * 4;
constexpr size_t WS_END = WS_BAR + 16384;
constexpr size_t OUT_Y = 0;
constexpr size_t OUT_CONV_P = (size_t)TT * DM;
constexpr size_t OUT_GDN_P = OUT_CONV_P + (size_t)4 * 8 * 3 * 1536;
constexpr size_t OUT_K_P = OUT_GDN_P + (size_t)4 * 8 * 4 * 128 * 128;
constexpr size_t OUT_V_P = OUT_K_P + (size_t)4 * 8 * 128 * 128;
constexpr size_t OUT_CONV_S = OUT_V_P + (size_t)4 * 8 * 128 * 128;
constexpr size_t OUT_GDN_S = OUT_CONV_S + (size_t)4 * 128 * 3 * 1536;
constexpr size_t OUT_K_S = OUT_GDN_S + (size_t)4 * 128 * 4 * 128 * 128;
constexpr size_t OUT_V_S = OUT_K_S + (size_t)4 * 128 * 128 * 128;
constexpr size_t OUT_END = OUT_V_S + (size_t)4 * 128 * 128 * 128;

struct Params {
    const float* in[24];
    float* out;
    unsigned char* ws;
    int ph_lo, ph_hi;
};

typedef const __attribute__((address_space(4))) Params* PP;
__device__ __forceinline__ PP get_params() { PP q = (PP)__builtin_amdgcn_kernarg_segment_ptr(); asm volatile("" : "+s"(q)); return q; }
__device__ __forceinline__ int get_tid() { int t = threadIdx.x; asm volatile("" : "+v"(t)); return t; }
typedef __bf16 bf16x2_t __attribute__((ext_vector_type(2)));
__device__ __forceinline__ unsigned pk2(float lo, float hi) { const f32x2 v = {lo, hi}; return __builtin_bit_cast(unsigned, __builtin_convertvector(v, bf16x2_t)); }
__device__ __forceinline__ float bflo(unsigned w) { return __uint_as_float(w << 16); }
__device__ __forceinline__ float bfhi(unsigned w) { return __uint_as_float(w & 0xffff0000u); }
__device__ __forceinline__ float bf2f(bf16_t b) { return __uint_as_float((unsigned)b << 16); }
__device__ __forceinline__ float wave_sum(float v) {
#pragma unroll
    for (int o = 1; o < 64; o <<= 1) v += __shfl_xor(v, o);
    return v;
}
__device__ __forceinline__ float silu_f(float v) { return v * __builtin_amdgcn_rcpf(1.f + __expf(-v)); }
__device__ __forceinline__ void unpack8(const u32x4 r, float (&f)[8]) {
    f[0] = bflo(r.x); f[1] = bfhi(r.x); f[2] = bflo(r.y); f[3] = bfhi(r.y); f[4] = bflo(r.z); f[5] = bfhi(r.z); f[6] = bflo(r.w); f[7] = bfhi(r.w);
}
#define LDS_WAIT() asm volatile("s_waitcnt lgkmcnt(0)" ::: "memory")

namespace pg8 {
constexpr int BM = 256, BK = 64, HALF = 128, HTB = HALF * BK * 2, STAGE_BYTES = 8 * HTB, NXCD = 8, WGM = 8;
__device__ __forceinline__ int lds_byte(int r, int c) { const int st = (r >> 4) * 2 + (c >> 5), rr = r & 15, cc = c & 31, ob = rr * 64 + cc * 2; return st * 1024 + (ob ^ (((ob >> 9) & 1) << 5)); }
__device__ __forceinline__ void stage_rc(int b, int& R, int& C) { const int st = b / 1024, sb = b % 1024, swz = sb ^ (((sb >> 9) & 1) << 5); R = (st >> 1) * 16 + swz / 64; C = (st & 1) * 32 + (swz % 64) / 2; }
__device__ __forceinline__ int perm32(int rho) { const int n = rho >> 4, i = rho & 15; return 8 * (i >> 2) + 4 * n + (i & 3); }
struct Unit { int pm, pn, koff; };
struct Gemm { const bf16_t* A; const bf16_t* Bt; int ldk, nt; };

struct StaticOrder {
    int nM, nN, nwg, G, c;
    __device__ void init(int M, int N, int G_, int c_) { nM = M / BM; nN = N / BM; nwg = nM * nN; G = G_; c = c_; }
    __device__ bool next(int i, Unit& u) const {
        const long L = (long)i * G + c; if (L >= nwg) return false;
        int wgid = (int)L; { const int q = nwg / NXCD, r = nwg % NXCD, xcd = wgid % NXCD, off = wgid / NXCD; wgid = (xcd < r ? xcd * (q + 1) : r * (q + 1) + (xcd - r) * q) + off; }
        const int nig = WGM * nN, gid = wgid / nig, fm = gid * WGM, gsz = (nM - fm) < WGM ? (nM - fm) : WGM;
        u.pm = fm + ((wgid % nig) % gsz); u.pn = (wgid % nig) / gsz; u.koff = 0; return true;
    }
};
struct SplitOrder {
    int pm0, nM, nN, nsplit, ksb, G, c;
    __device__ bool next(int i, Unit& u) const {
        const int L = i * G + c; if (L >= nM * nN * nsplit) return false;
        const int ks = L / (nM * nN), t = L % (nM * nN);
        u.pm = pm0 + t / nN; u.pn = t % nN; u.koff = ks * ksb; return true;
    }
};

template <class Epi, class Sched>
__device__ __forceinline__ void gemm_phase(LAS unsigned char* lds, const Gemm g, const Sched& S, const Epi& E) {
    const int tid = get_tid(), wid = __builtin_amdgcn_readfirstlane(tid >> 6), lane = tid & 63, wr = wid >> 2, wc = wid & 3, fr = lane & 15, fq = lane >> 4;
    const int K = g.ldk, nt = g.nt;
    unsigned voffA[2], voffB[2];
#pragma unroll
    for (int i = 0; i < 2; ++i) { int R, C; stage_rc(tid * 16 + i * 8192, R, C); const int Rb = Epi::PERM ? ((R & ~31) + perm32(R & 31)) : R;
        voffA[i] = (unsigned)(R * K + C) * 2u; voffB[i] = (unsigned)(Rb * K + C) * 2u; }
    const size_t kstep = (size_t)(BK * 2);
    const size_t hstep = (size_t)HALF * K * 2;
    const size_t tstep = 2 * hstep;
    const unsigned ldsw = (unsigned)wid * 1024u;
    const int aoff = lds_byte(wr * 64 + fr, fq * 8), boff = lds_byte(wc * 32 + fr, fq * 8);
#define PG8_SA(b, h) (((b) * 2 + (h)) * HTB)
#define PG8_SB(b, h) ((4 + (b) * 2 + (h)) * HTB)
#define PG8_STAGE(bufoff, gbase, voff) do { _Pragma("unroll") for (int _i = 0; _i < 2; ++_i) \
        __builtin_amdgcn_global_load_lds((const unsigned*)((const char*)(gbase) + (voff)[_i]), (LAS unsigned*)(lds + (bufoff) + ldsw + _i * 8192), 16, 0, 0); } while (0)
#define PG8_LDA(dst, b, h) do { _Pragma("unroll") for (int m = 0; m < 4; ++m) _Pragma("unroll") for (int k = 0; k < 2; ++k) dst[m][k] = *(const LAS bf16x8*)(lds + PG8_SA(b, h) + aoff + m * 2048 + k * 1024); } while (0)
#define PG8_LDB(dst, b, h) do { _Pragma("unroll") for (int n = 0; n < 2; ++n) _Pragma("unroll") for (int k = 0; k < 2; ++k) dst[n][k] = *(const LAS bf16x8*)(lds + PG8_SB(b, h) + boff + n * 2048 + k * 1024); } while (0)
#define PG8_MMA(ai, bj, At, Bt) do { __builtin_amdgcn_s_setprio(1); _Pragma("unroll") for (int m = 0; m < 4; ++m) _Pragma("unroll") for (int n = 0; n < 2; ++n) _Pragma("unroll") for (int k = 0; k < 2; ++k) \
        acc[ai][bj][m][n] = __builtin_amdgcn_mfma_f32_16x16x32_bf16(Bt[n][k], At[m][k], acc[ai][bj][m][n], 0, 0, 0); __builtin_amdgcn_s_setprio(0); } while (0)
#define PG8_WAIT_V(n) asm volatile("s_waitcnt vmcnt(" #n ")" ::: "memory")
#define PG8_WAIT_L(n) asm volatile("s_waitcnt lgkmcnt(" #n ")" ::: "memory")
#define PG8_BAR __builtin_amdgcn_s_barrier()
#define PG8_SCHED __builtin_amdgcn_sched_barrier(0)
    Unit cur, nxt; int ui = 0;
    if (!S.next(0, cur)) return;
    f32x4 acc[2][2][4][2];
#pragma unroll
    for (int a = 0; a < 2; ++a)
#pragma unroll
        for (int b = 0; b < 2; ++b)
#pragma unroll
            for (int m = 0; m < 4; ++m)
#pragma unroll
                for (int n = 0; n < 2; ++n) acc[a][b][m][n] = (f32x4){0.f, 0.f, 0.f, 0.f};
    bf16x8 At[4][2], B0[2][2], B1[2][2];
    const char* cA = (const char*)g.A + (size_t)cur.pm * tstep + cur.koff; const char* cB = (const char*)g.Bt + (size_t)cur.pn * tstep + cur.koff;
    PG8_STAGE(PG8_SB(0, 0), cB, voffB); PG8_STAGE(PG8_SA(0, 0), cA, voffA); PG8_STAGE(PG8_SB(0, 1), cB + hstep, voffB); PG8_STAGE(PG8_SA(0, 1), cA + hstep, voffA);
    if (wr == 1) PG8_BAR;
    PG8_WAIT_V(4); PG8_BAR;
    PG8_STAGE(PG8_SB(1, 0), cB + kstep, voffB); PG8_STAGE(PG8_SA(1, 0), cA + kstep, voffA); PG8_STAGE(PG8_SB(1, 1), cB + hstep + kstep, voffB);
    PG8_WAIT_V(6); PG8_BAR;
    for (;;) {
        const bool has_next = S.next(ui + 1, nxt);
        const char* nA = has_next ? (const char*)g.A + (size_t)nxt.pm * tstep + nxt.koff : cA; const char* nB = has_next ? (const char*)g.Bt + (size_t)nxt.pn * tstep + nxt.koff : cB;
        for (int t = 0; t < nt; t += 2) {
            const bool last = (t == nt - 2);
            const char* a1 = cA + (size_t)(t + 1) * kstep;
            const char* a2 = last ? nA : cA + (size_t)(t + 2) * kstep; const char* b2 = last ? nB : cB + (size_t)(t + 2) * kstep;
            const char* a3 = a2 + kstep; const char* b3 = b2 + kstep;
            PG8_LDB(B0, 0, 0); PG8_SCHED; PG8_LDA(At, 0, 0); PG8_STAGE(PG8_SA(1, 1), a1 + hstep, voffA);
            PG8_WAIT_L(8); PG8_BAR; PG8_WAIT_L(0); PG8_MMA(0, 0, At, B0); PG8_BAR; PG8_SCHED;
            PG8_LDB(B1, 0, 1); PG8_STAGE(PG8_SB(0, 0), b2, voffB);
            PG8_BAR; PG8_WAIT_L(0); PG8_MMA(0, 1, At, B1); PG8_BAR;
            PG8_LDA(At, 0, 1); PG8_STAGE(PG8_SA(0, 0), a2, voffA);
            PG8_BAR; PG8_WAIT_L(0); PG8_MMA(1, 0, At, B0); PG8_BAR; PG8_SCHED;
            PG8_STAGE(PG8_SB(0, 1), b2 + hstep, voffB);
            PG8_WAIT_V(6); PG8_BAR; PG8_MMA(1, 1, At, B1); PG8_BAR;
            PG8_LDB(B0, 1, 0); PG8_SCHED; PG8_LDA(At, 1, 0); PG8_STAGE(PG8_SA(0, 1), a2 + hstep, voffA);
            PG8_WAIT_L(8); PG8_BAR; PG8_WAIT_L(0); PG8_MMA(0, 0, At, B0); PG8_BAR; PG8_SCHED;
            PG8_LDB(B1, 1, 1); PG8_STAGE(PG8_SB(1, 0), b3, voffB);
            PG8_BAR; PG8_WAIT_L(0); PG8_MMA(0, 1, At, B1); PG8_BAR;
            PG8_LDA(At, 1, 1); PG8_STAGE(PG8_SA(1, 0), a3, voffA);
            PG8_BAR; PG8_WAIT_L(0); PG8_MMA(1, 0, At, B0); PG8_BAR; PG8_SCHED;
            PG8_STAGE(PG8_SB(1, 1), b3 + hstep, voffB);
            PG8_WAIT_V(6); PG8_BAR; PG8_MMA(1, 1, At, B1); PG8_BAR;
        }
        E(acc, cur, wr, wc, fr, fq);
        if (!has_next) break;
#pragma unroll
        for (int a = 0; a < 2; ++a)
#pragma unroll
            for (int b = 0; b < 2; ++b)
#pragma unroll
                for (int m = 0; m < 4; ++m)
#pragma unroll
                    for (int n = 0; n < 2; ++n) acc[a][b][m][n] = (f32x4){0.f, 0.f, 0.f, 0.f};
        cur = nxt; cA = nA; cB = nB; ++ui;
    }
    PG8_WAIT_V(0);
    if (wr == 0) PG8_BAR;
    PG8_BAR;
#undef PG8_SA
#undef PG8_SB
#undef PG8_STAGE
#undef PG8_LDA
#undef PG8_LDB
#undef PG8_MMA
#undef PG8_WAIT_V
#undef PG8_WAIT_L
#undef PG8_BAR
#undef PG8_SCHED
}

struct EpiGU {
    static constexpr bool PERM = true;
    bf16_t* O;
    __device__ __forceinline__ void operator()(const f32x4 (&acc)[2][2][4][2], const Unit& u, int wr, int wc, int fr, int fq) const {
        const int row0 = u.pm * BM + wr * 64 + fr, col0 = u.pn * 128 + wc * 32 + 8 * fq;
#pragma unroll
        for (int ai = 0; ai < 2; ++ai)
#pragma unroll
            for (int m = 0; m < 4; ++m) { bf16_t* rowp = O + (size_t)(row0 + ai * HALF + m * 16) * FF + col0;
                const f32x4 g0 = acc[ai][0][m][0], g1 = acc[ai][0][m][1], u0 = acc[ai][1][m][0], u1 = acc[ai][1][m][1];
                u32x4 w; w.x = pk2(silu_f(g0[0]) * u0[0], silu_f(g0[1]) * u0[1]); w.y = pk2(silu_f(g0[2]) * u0[2], silu_f(g0[3]) * u0[3]);
                w.z = pk2(silu_f(g1[0]) * u1[0], silu_f(g1[1]) * u1[1]); w.w = pk2(silu_f(g1[2]) * u1[2], silu_f(g1[3]) * u1[3]);
                *(u32x4*)rowp = w; }
    }
};
struct EpiH {
    static constexpr bool PERM = true;
    bf16_t* O; int ldc;
    __device__ __forceinline__ void operator()(const f32x4 (&acc)[2][2][4][2], const Unit& u, int wr, int wc, int fr, int fq) const {
        const int row0 = u.pm * BM + wr * 64 + fr, col0 = u.pn * BM + wc * 32 + 8 * fq;
#pragma unroll
        for (int ai = 0; ai < 2; ++ai)
#pragma unroll
            for (int m = 0; m < 4; ++m) { bf16_t* rowp = O + (size_t)(row0 + ai * HALF + m * 16) * ldc + col0;
#pragma unroll
                for (int bj = 0; bj < 2; ++bj) { const f32x4 v0 = acc[ai][bj][m][0], v1 = acc[ai][bj][m][1];
                    u32x4 w; w.x = pk2(v0[0], v0[1]); w.y = pk2(v0[2], v0[3]); w.z = pk2(v1[0], v1[1]); w.w = pk2(v1[2], v1[3]);
                    *(u32x4*)(rowp + bj * HALF) = w; } }
    }
};
struct EpiRes {
    static constexpr bool PERM = false;
    float* X; float scale;
    __device__ __forceinline__ void operator()(const f32x4 (&acc)[2][2][4][2], const Unit& u, int wr, int wc, int fr, int fq) const {
        const int row0 = u.pm * BM + wr * 64 + fr, col0 = u.pn * BM + wc * 32 + 4 * fq;
#pragma unroll
        for (int ai = 0; ai < 2; ++ai) {
            f32x4 t[4][2][2];
#pragma unroll
            for (int m = 0; m < 4; ++m)
#pragma unroll
                for (int bj = 0; bj < 2; ++bj)
#pragma unroll
                    for (int n = 0; n < 2; ++n) t[m][bj][n] = *(const f32x4*)(X + (size_t)(row0 + ai * HALF + m * 16) * DM + col0 + bj * HALF + n * 16);
#pragma unroll
            for (int m = 0; m < 4; ++m)
#pragma unroll
                for (int bj = 0; bj < 2; ++bj)
#pragma unroll
                    for (int n = 0; n < 2; ++n) *(f32x4*)(X + (size_t)(row0 + ai * HALF + m * 16) * DM + col0 + bj * HALF + n * 16) = t[m][bj][n] + acc[ai][bj][m][n] * scale;
        }
    }
};
struct EpiPart {
    static constexpr bool PERM = false;
    float* P;
    __device__ __forceinline__ void operator()(const f32x4 (&acc)[2][2][4][2], const Unit& u, int wr, int wc, int fr, int fq) const {
        const int row0 = u.pm * BM - TP + wr * 64 + fr, col0 = u.pn * BM + wc * 32 + 4 * fq;
        float* base = P + (size_t)(u.koff >> 9) * TSM * DM;
#pragma unroll
        for (int ai = 0; ai < 2; ++ai)
#pragma unroll
            for (int m = 0; m < 4; ++m) { float* rowp = base + (size_t)(row0 + ai * HALF + m * 16) * DM + col0;
#pragma unroll
                for (int bj = 0; bj < 2; ++bj)
#pragma unroll
                    for (int n = 0; n < 2; ++n) *(f32x4*)(rowp + bj * HALF + n * 16) = acc[ai][bj][m][n]; }
    }
};
}

__device__ __forceinline__ void transpose_item(const float* colp, int ld, int k0, bf16_t* dst, int K, LAS float* scr, int lane) {
    float tv[32];
#pragma unroll
    for (int i = 0; i < 32; ++i) tv[i] = colp[(size_t)(k0 + 2 * i + (lane >> 5)) * ld];
#pragma unroll
    for (int i = 0; i < 32; ++i) scr[(2 * i + (lane >> 5)) * 33 + (lane & 31)] = tv[i];
    LDS_WAIT();
    const int c = lane & 7;
#pragma unroll
    for (int j = 0; j < 4; ++j) { const int n = (lane >> 3) + 8 * j; const LAS float* s = scr + (8 * c) * 33 + n;
        u32x4 o; o.x = pk2(s[0 * 33], s[1 * 33]); o.y = pk2(s[2 * 33], s[3 * 33]); o.z = pk2(s[4 * 33], s[5 * 33]); o.w = pk2(s[6 * 33], s[7 * 33]);
        *(u32x4*)(dst + (size_t)n * K + 8 * c) = o; }
    LDS_WAIT();
}
__device__ __forceinline__ void prep_phase(PP p, LAS unsigned char* lds, int bid, int nb) {
    const int tid = get_tid(), lane = tid & 63, wave = tid >> 6;
    LAS float* scr = (LAS float*)(lds + wave * 8448);
    const int gw = bid * 8 + wave, NGW = nb * 8;
    constexpr int I_GU = 16 * 176, I_DN = 44 * 32, I_IN = 16 * 88, I_OUT = 16 * 32, I_L = 2 * I_GU + 2 * I_DN + I_IN + I_OUT;
    for (int it = gw; it < 4 * I_L; it += NGW) {
        const int l = it / I_L; int r = it % I_L;
        bf16_t* wl = (bf16_t*)(p->ws + WS_W) + (size_t)l * WL_ELEMS;
        const float* colp; int ld, K, k0; bf16_t* dst;
        if (r < 2 * I_GU) {
            const int f = r >= I_GU; r -= f * I_GU; const int kb = r / 176, nb32 = r % 176;
            const float* gsrc = p->in[f ? 20 : 7] + (size_t)l * DM * FF; const float* usrc = p->in[f ? 21 : 8] + (size_t)l * DM * FF;
            colp = (((nb32 >> 2) & 1) ? usrc : gsrc) + 128 * (nb32 >> 3) + 32 * (nb32 & 3) + (lane & 31); ld = FF; K = DM; k0 = 64 * kb;
            dst = wl + (f ? O_GU2 : O_GU1) + (size_t)(32 * nb32) * DM + k0;
        } else if (r < 2 * I_GU + 2 * I_DN) {
            r -= 2 * I_GU; const int f = r >= I_DN; r -= f * I_DN; const int kb = r / 32, nb32 = r % 32;
            colp = p->in[f ? 22 : 9] + (size_t)l * FF * DM + 32 * nb32 + (lane & 31); ld = DM; K = FF; k0 = 64 * kb;
            dst = wl + (f ? O_DN2 : O_DN1) + (size_t)(32 * nb32) * FF + k0;
        } else if (r < 2 * I_GU + 2 * I_DN + I_IN) {
            r -= 2 * I_GU + 2 * I_DN; const int kb = r / 88, nb32 = r % 88; const int n = 32 * nb32 + (lane & 31);
            colp = p->in[11] + (size_t)l * DM * INC + (n < 2048 ? n : n + 8); ld = INC; K = DM; k0 = 64 * kb;
            dst = wl + O_IN + (size_t)(32 * nb32) * DM + k0;
        } else {
            r -= 2 * I_GU + 2 * I_DN + I_IN; const int kb = r / 32, nb32 = r % 32;
            colp = p->in[18] + (size_t)l * DM * DM + 32 * nb32 + (lane & 31); ld = DM; K = DM; k0 = 64 * kb;
            dst = wl + O_OUT + (size_t)(32 * nb32) * DM + k0;
        }
        transpose_item(colp, ld, k0, dst, K, scr, lane);
    }
    {
        f32x4 wv[4];
#pragma unroll
        for (int j = 0; j < 4; ++j) wv[j] = ((const f32x4*)p->in[6])[lane + 64 * j];
        for (int row = gw; row < TT; row += NGW) {
            const f32x4* xr = (const f32x4*)(row < TP ? p->in[0] + (size_t)row * DM : p->in[1] + (size_t)(row - TP) * DM) + lane;
            f32x4* xo = (f32x4*)((float*)(p->ws + WS_X) + (size_t)row * DM) + lane;
            f32x4 v[4]; float s = 0.f;
#pragma unroll
            for (int j = 0; j < 4; ++j) { v[j] = xr[64 * j]; xo[64 * j] = v[j]; s += (v[j].x * v[j].x + v[j].y * v[j].y) + (v[j].z * v[j].z + v[j].w * v[j].w); }
            const float rs = rsqrtf(wave_sum(s) * (1.f / DM) + 1e-6f);
            u32x2* o = (u32x2*)((bf16_t*)(p->ws + WS_XN) + (size_t)row * DM) + lane;
#pragma unroll
            for (int j = 0; j < 4; ++j) { const f32x4 t = v[j] * rs * wv[j]; u32x2 q; q.x = pk2(t.x, t.y); q.y = pk2(t.z, t.w); o[64 * j] = q; }
        }
    }
}

__device__ __forceinline__ int row_of(int k, int bid, int wave, int nb) {
    if (nb == 256) {
        if (k < 8) return (bid & 7) * 2048 + ((bid >> 3) * 8 + wave) + 256 * k;
        const int gw = bid * 8 + wave;
        return (k == 8 && gw < TSM) ? TP + gw : -1;
    }
    const int r = bid * 8 + wave + k * nb * 8;
    return r < TT ? r : -1;
}
template <int MODE>
__device__ __forceinline__ void rms_phase(float* x, const float* w, bf16_t* ob, float* of, float* ba, const float* win, const float* part, int nsplit, float pscale, int bid, int nb) {
    const int tid = get_tid(), lane = tid & 63, wave = tid >> 6;
    f32x4 wv[4];
#pragma unroll
    for (int j = 0; j < 4; ++j) wv[j] = ((const f32x4*)w)[lane + 64 * j];
    f32x4 wc0[4][4], wc1[4][4];
    if (MODE == 1) {
#pragma unroll
        for (int j = 0; j < 4; ++j)
#pragma unroll
            for (int e = 0; e < 4; ++e) { const float* wp = win + (size_t)(4 * lane + 256 * j + e) * INC + 2048; wc0[j][e] = *(const f32x4*)wp; wc1[j][e] = *(const f32x4*)(wp + 4); }
    }
    f32x4 nv[4];
    {
        const int r0 = row_of(0, bid, wave, nb);
        if (r0 >= 0) { const f32x4* q = (const f32x4*)(x + (size_t)r0 * DM) + lane;
#pragma unroll
            for (int j = 0; j < 4; ++j) nv[j] = q[64 * j]; }
    }
    for (int kk = 0;; ++kk) {
        const int row = row_of(kk, bid, wave, nb); if (row < 0) break;
        f32x4* xr = (f32x4*)(x + (size_t)row * DM) + lane;
        f32x4 v[4]; float s = 0.f;
#pragma unroll
        for (int j = 0; j < 4; ++j) v[j] = nv[j];
        const int rnext = row_of(kk + 1, bid, wave, nb);
        if (rnext >= 0) { const f32x4* q = (const f32x4*)(x + (size_t)rnext * DM) + lane;
#pragma unroll
            for (int j = 0; j < 4; ++j) nv[j] = q[64 * j]; }
        if (row >= TP && nsplit > 0) {
            f32x4 a[4] = {(f32x4){0.f, 0.f, 0.f, 0.f}, (f32x4){0.f, 0.f, 0.f, 0.f}, (f32x4){0.f, 0.f, 0.f, 0.f}, (f32x4){0.f, 0.f, 0.f, 0.f}};
            for (int ks = 0; ks < nsplit; ++ks) { const f32x4* pr = (const f32x4*)(part + ((size_t)ks * TSM + (row - TP)) * DM) + lane;
#pragma unroll
                for (int j = 0; j < 4; ++j) a[j] += pr[64 * j]; }
#pragma unroll
            for (int j = 0; j < 4; ++j) { v[j] += a[j] * pscale; xr[64 * j] = v[j]; }
        }
#pragma unroll
        for (int j = 0; j < 4; ++j) s += (v[j].x * v[j].x + v[j].y * v[j].y) + (v[j].z * v[j].z + v[j].w * v[j].w);
        const float rs = rsqrtf(wave_sum(s) * (1.f / DM) + 1e-6f);
#pragma unroll
        for (int j = 0; j < 4; ++j) v[j] = v[j] * rs * wv[j];
        if (MODE == 2) {
            f32x4* o = (f32x4*)(of + (size_t)row * DM) + lane;
#pragma unroll
            for (int j = 0; j < 4; ++j) o[64 * j] = v[j];
        } else {
            u32x2* o = (u32x2*)(ob + (size_t)row * DM) + lane;
#pragma unroll
            for (int j = 0; j < 4; ++j) { u32x2 q; q.x = pk2(v[j].x, v[j].y); q.y = pk2(v[j].z, v[j].w); o[64 * j] = q; }
        }
        if (MODE == 1) {
            float a8[8];
#pragma unroll
            for (int c = 0; c < 8; ++c) a8[c] = 0.f;
#pragma unroll
            for (int j = 0; j < 4; ++j)
#pragma unroll
                for (int e = 0; e < 4; ++e) {
                    const f32x4 w0 = wc0[j][e], w1 = wc1[j][e]; const float xv = v[j][e];
                    a8[0] += xv * w0.x; a8[1] += xv * w0.y; a8[2] += xv * w0.z; a8[3] += xv * w0.w; a8[4] += xv * w1.x; a8[5] += xv * w1.y; a8[6] += xv * w1.z; a8[7] += xv * w1.w;
                }
#pragma unroll
            for (int c = 0; c < 8; ++c) a8[c] = wave_sum(a8[c]);
            if (lane == 0) { *(f32x4*)(ba + (size_t)row * 8) = (f32x4){a8[0], a8[1], a8[2], a8[3]}; *(f32x4*)(ba + (size_t)row * 8 + 4) = (f32x4){a8[4], a8[5], a8[6], a8[7]}; }
        }
    }
}

__device__ __forceinline__ void gdn_stage_a(PP p, int l, int it, LAS unsigned char* lds) {
    const int tid = get_tid(), lane = tid & 63, wave = tid >> 6;
    const int hh = it & 3, n = (it >> 2) & 31, b = it >> 7;
    const int t0 = b * 2048 + n * 64;
    const bf16_t* hb = (const bf16_t*)(p->ws + WS_H);
    const float* ba = (const float*)(p->ws + WS_BA);
    bf16_t* gi_base = (bf16_t*)(p->ws + WS_G) + (size_t)it * G_ITEM;
    bf16_t* wg = gi_base; bf16_t* kcg = gi_base + 8192; bf16_t* qdg = gi_base + 16384; bf16_t* kdtg = gi_base + 24576; bf16_t* qkg = gi_base + 32768;
    LAS float* gcs = (LAS float*)lds;
    LAS float* bet = gcs + 64;
    LAS float* AT = (LAS float*)(lds + 1024);
    LAS float* vr = AT + 64 * 68;
    LAS float* kr = vr + 64 * 128;
    LAS bf16_t* qb = (LAS bf16_t*)(kr + 64 * 128);
    LAS bf16_t* kb = qb + 64 * 136;
    if (wave == 7) {
        const float av = ba[(size_t)(t0 + lane) * 8 + 4 + hh] + p->in[14][l * 4 + hh];
        const float bv = ba[(size_t)(t0 + lane) * 8 + hh];
        const float sp = av > 20.f ? av : log1pf(expf(av));
        float g = -expf(p->in[13][l * 4 + hh]) * sp;
#pragma unroll
        for (int o = 1; o < 64; o <<= 1) { const float t = __shfl_up(g, o); if (lane >= o) g += t; }
        gcs[lane] = g; bet[lane] = 1.f / (1.f + expf(-bv));
    }
    const int gi = tid & 15, cgrp = (tid - 256) >> 4, partA = cgrp >> 3, tbA = cgrp & 7;
    auto conv_task = [&](const int part, const int tb, float (&o)[8][8], float (&ss)[8]) {
        const int cb = part * 512 + hh * 128 + gi * 8, tok0 = tb * 8;
        float cw[4][8];
        const float* cwp = p->in[12] + (size_t)l * 4 * 1536 + cb;
#pragma unroll
        for (int i = 0; i < 4; ++i) { const f32x4 a = *(const f32x4*)(cwp + i * 1536), c = *(const f32x4*)(cwp + i * 1536 + 4);
            cw[i][0] = a.x; cw[i][1] = a.y; cw[i][2] = a.z; cw[i][3] = a.w; cw[i][4] = c.x; cw[i][5] = c.y; cw[i][6] = c.z; cw[i][7] = c.w; }
        float win[3][8];
#pragma unroll
        for (int i = 0; i < 3; ++i) {
            const int tl = tok0 - 3 + i;
            if (n > 0 || tl >= 0) { const u32x4 raw = *(const u32x4*)(hb + (size_t)(t0 + tl) * HC + cb); unpack8(raw, win[i]); }
            else {
#pragma unroll
                for (int c = 0; c < 8; ++c) win[i][c] = 0.f; }
        }
#pragma unroll
        for (int tt = 0; tt < 8; ++tt) {
            float cur[8];
            const u32x4 raw = *(const u32x4*)(hb + (size_t)(t0 + tok0 + tt) * HC + cb); unpack8(raw, cur);
            float s2 = 0.f;
#pragma unroll
            for (int c = 0; c < 8; ++c) { float v = cw[0][c] * win[0][c] + cw[1][c] * win[1][c] + cw[2][c] * win[2][c] + cw[3][c] * cur[c]; v = silu_f(v); o[tt][c] = v; s2 += v * v; }
            ss[tt] = s2;
            if (n == 31 && tb == 7 && tt >= 5) {
                float* cp = p->out + OUT_CONV_P + ((size_t)(l * 8 + b) * 3 + (tt - 5)) * 1536 + cb;
                *(f32x4*)cp = (f32x4){cur[0], cur[1], cur[2], cur[3]}; *(f32x4*)(cp + 4) = (f32x4){cur[4], cur[5], cur[6], cur[7]};
            }
#pragma unroll
            for (int c = 0; c < 8; ++c) { win[0][c] = win[1][c]; win[1][c] = win[2][c]; win[2][c] = cur[c]; }
        }
#pragma unroll
        for (int tt = 0; tt < 8; ++tt) {
            float s2 = ss[tt];
            s2 += __shfl_xor(s2, 1); s2 += __shfl_xor(s2, 2); s2 += __shfl_xor(s2, 4); s2 += __shfl_xor(s2, 8);
            ss[tt] = rsqrtf(s2 + 1e-6f);
        }
    };
    float oA[8][8], ssA[8], oB[8][8], ssB[8];
    if (tid >= 256) { conv_task(partA, tbA, oA, ssA); if (cgrp < 8) conv_task(2, tbA, oB, ssB); }
    __syncthreads();
    const float gc_last = gcs[63];
    auto write_task = [&](const int part, const int tb, float (&o)[8][8], float (&ss)[8]) {
        const int tok0 = tb * 8;
        if (part == 0) {
#pragma unroll
            for (int tt = 0; tt < 8; ++tt) {
                const int tok = tok0 + tt; const float sc = ss[tt] * 0.08838834764831845f; const float eg = __expf(gcs[tok]);
                float q[8];
#pragma unroll
                for (int c = 0; c < 8; ++c) q[c] = o[tt][c] * sc;
                u32x4 w; w.x = pk2(q[0], q[1]); w.y = pk2(q[2], q[3]); w.z = pk2(q[4], q[5]); w.w = pk2(q[6], q[7]);
                *(LAS u32x4*)(qb + tok * 136 + gi * 8) = w;
                u32x4 d; d.x = pk2(q[0] * eg, q[1] * eg); d.y = pk2(q[2] * eg, q[3] * eg); d.z = pk2(q[4] * eg, q[5] * eg); d.w = pk2(q[6] * eg, q[7] * eg);
                *(u32x4*)(qdg + tok * 128 + gi * 8) = d;
            }
        } else if (part == 1) {
            float ed[8];
#pragma unroll
            for (int tt = 0; tt < 8; ++tt) {
                const int tok = tok0 + tt; const float sc = ss[tt]; const float gct = gcs[tok]; const float be = bet[tok] * __expf(gct);
                ed[tt] = __expf(gc_last - gct);
#pragma unroll
                for (int c = 0; c < 8; ++c) o[tt][c] *= sc;
                u32x4 w; w.x = pk2(o[tt][0], o[tt][1]); w.y = pk2(o[tt][2], o[tt][3]); w.z = pk2(o[tt][4], o[tt][5]); w.w = pk2(o[tt][6], o[tt][7]);
                *(LAS u32x4*)(kb + tok * 136 + gi * 8) = w;
                *(LAS f32x4*)(kr + tok * 128 + gi * 8) = (f32x4){o[tt][0] * be, o[tt][1] * be, o[tt][2] * be, o[tt][3] * be};
                *(LAS f32x4*)(kr + tok * 128 + gi * 8 + 4) = (f32x4){o[tt][4] * be, o[tt][5] * be, o[tt][6] * be, o[tt][7] * be};
            }
#pragma unroll
            for (int c = 0; c < 8; ++c) {
                u32x4 w; w.x = pk2(o[0][c] * ed[0], o[1][c] * ed[1]); w.y = pk2(o[2][c] * ed[2], o[3][c] * ed[3]); w.z = pk2(o[4][c] * ed[4], o[5][c] * ed[5]); w.w = pk2(o[6][c] * ed[6], o[7][c] * ed[7]);
                *(u32x4*)(kdtg + (gi * 8 + c) * 64 + tok0) = w;
            }
        } else {
#pragma unroll
            for (int tt = 0; tt < 8; ++tt) {
                const int tok = tok0 + tt; const float be = bet[tok];
                *(LAS f32x4*)(vr + tok * 128 + gi * 8) = (f32x4){o[tt][0] * be, o[tt][1] * be, o[tt][2] * be, o[tt][3] * be};
                *(LAS f32x4*)(vr + tok * 128 + gi * 8 + 4) = (f32x4){o[tt][4] * be, o[tt][5] * be, o[tt][6] * be, o[tt][7] * be};
            }
        }
    };
    if (tid >= 256) { write_task(partA, tbA, oA, ssA); if (cgrp < 8) write_task(2, tbA, oB, ssB); }
    if (tid == 0) ((float*)(p->ws + WS_CD))[it * 32] = __expf(gc_last);
    __syncthreads();
    {
        const int prod = wave >> 2, I = wave & 3, fr = lane & 15, fq = lane >> 4;
        const LAS bf16_t* X = prod ? qb : kb;
        bf16x8 af[4];
#pragma unroll
        for (int ks = 0; ks < 4; ++ks) af[ks] = *(const LAS bf16x8*)(X + (16 * I + fr) * 136 + ks * 32 + fq * 8);
        const int i0 = 16 * I + 4 * fq;
        float gci[4];
#pragma unroll
        for (int r = 0; r < 4; ++r) gci[r] = gcs[i0 + r];
#pragma unroll
        for (int J = 0; J < 4; ++J) {
            f32x4 acc = (f32x4){0.f, 0.f, 0.f, 0.f};
            if (J <= I) {
#pragma unroll
                for (int ks = 0; ks < 4; ++ks) { const bf16x8 bfr = *(const LAS bf16x8*)(kb + (16 * J + fr) * 136 + ks * 32 + fq * 8); acc = __builtin_amdgcn_mfma_f32_16x16x32_bf16(af[ks], bfr, acc, 0, 0, 0); }
            }
            const int j = 16 * J + fr; const float gcj = gcs[j];
            if (prod == 0) {
                if (J <= I) {
                    f32x4 o4;
#pragma unroll
                    for (int r = 0; r < 4; ++r) { const int i = i0 + r; o4[r] = (i > j) ? bet[i] * acc[r] * __expf(gci[r] - gcj) : 0.f; }
                    *(LAS f32x4*)(AT + j * 68 + i0) = o4;
                }
            } else {
#pragma unroll
                for (int r = 0; r < 4; ++r) { const int i = i0 + r; const float v = (i >= j) ? acc[r] * __expf(gci[r] - gcj) : 0.f; qkg[i * 64 + j] = (bf16_t)(pk2(v, 0.f) & 0xffffu); }
            }
        }
    }
    __syncthreads();
    if (tid < 256) {
        const LAS float* src = tid < 128 ? vr + tid : kr + (tid - 128);
        f32x2 ap[32];
#pragma unroll
        for (int k = 0; k < 32; ++k) ap[k] = (f32x2){src[(2 * k) * 128], src[(2 * k + 1) * 128]};
        f32x4 cur[16], nxt[16];
#pragma unroll
        for (int c = 0; c < 16; ++c) cur[c] = *(const LAS f32x4*)(AT + 4 * c);
#pragma unroll
        for (int j = 0; j < 63; ++j) {
#pragma unroll
            for (int c = 0; c < 16; ++c) if (j < 62 && 4 * c + 3 > j + 1) nxt[c] = *(const LAS f32x4*)(AT + (j + 1) * 68 + 4 * c);
            __builtin_amdgcn_sched_barrier(0);
            const float xj = (j & 1) ? ap[j >> 1].y : ap[j >> 1].x;
            if (!(j & 1)) ap[j >> 1].y -= cur[j >> 2][(j & 3) + 1] * xj;
#pragma unroll
            for (int k = (j >> 1) + 1; k < 32; ++k) { const int c = k >> 1, lo = (k & 1) * 2; ap[k] -= (f32x2){cur[c][lo], cur[c][lo + 1]} * xj; }
            __builtin_amdgcn_sched_barrier(0);
#pragma unroll
            for (int c = 0; c < 16; ++c) cur[c] = nxt[c];
        }
        bf16_t* dst = tid < 128 ? wg + tid : kcg + (tid - 128);
#pragma unroll
        for (int k = 0; k < 32; ++k) { const unsigned w2 = pk2(ap[k].x, ap[k].y); dst[(2 * k) * 128] = (bf16_t)(w2 & 0xffffu); dst[(2 * k + 1) * 128] = (bf16_t)(w2 >> 16); }
    }
}

__device__ __forceinline__ void gdn_sample(PP p, int l, int it, LAS unsigned char* lds) {
    const int tid = get_tid(), lane = tid & 63, wave = tid >> 6;
    const int hh = it & 3, b = it >> 2;
    const bf16_t* hb = (const bf16_t*)(p->ws + WS_H);
    const float* ba = (const float*)(p->ws + WS_BA);
    float* oraw = (float*)(p->ws + WS_O);
    LAS float* val = (LAS float*)lds;
    LAS float* valn = val + 4 * 384;
    LAS float* red = valn + 4 * 256;
    LAS float* kqs = red + 4 * 2 * 512;
    const int trow = TP + b * 4;
    const int dv = tid & 127, kq = tid >> 7;
    const size_t sbase = ((size_t)(l * 128 + b) * 4 + hh) * 16384 + (size_t)(32 * kq) * 128 + dv;
    if (tid < 384) {
        const int part = tid >> 7, d = tid & 127, col = part * 512 + hh * 128 + d;
        float full[7];
#pragma unroll
        for (int r = 0; r < 3; ++r) full[r] = p->in[2][((size_t)(l * 128 + b) * 3 + r) * 1536 + col];
#pragma unroll
        for (int i = 0; i < 4; ++i) full[3 + i] = bf2f(hb[(size_t)(trow + i) * HC + col]);
        float cw[4];
#pragma unroll
        for (int i = 0; i < 4; ++i) cw[i] = p->in[12][((size_t)l * 4 + i) * 1536 + col];
#pragma unroll
        for (int t = 0; t < 4; ++t) val[t * 384 + tid] = silu_f(cw[0] * full[t] + cw[1] * full[t + 1] + cw[2] * full[t + 2] + cw[3] * full[t + 3]);
#pragma unroll
        for (int r = 0; r < 3; ++r) p->out[OUT_CONV_S + ((size_t)(l * 128 + b) * 3 + r) * 1536 + col] = full[4 + r];
    }
    __syncthreads();
    {
        const int t = wave & 3, part = wave >> 2;
        const float q0 = val[t * 384 + lane], q1 = val[t * 384 + 64 + lane], k0 = val[t * 384 + 128 + lane], k1 = val[t * 384 + 192 + lane];
        const float scq = rsqrtf(wave_sum(q0 * q0 + q1 * q1) + 1e-6f) * 0.08838834764831845f, sck = rsqrtf(wave_sum(k0 * k0 + k1 * k1) + 1e-6f);
        const float dqk = wave_sum(q0 * k0 + q1 * k1);
        if (part == 0) { valn[t * 256 + lane] = q0 * scq; valn[t * 256 + 64 + lane] = q1 * scq; if (lane == 0) kqs[t] = dqk * scq * sck; }
        else { valn[t * 256 + 128 + lane] = k0 * sck; valn[t * 256 + 192 + lane] = k1 * sck; }
    }
    float dec[4], beta[4];
    {
        const float alog = -expf(p->in[13][l * 4 + hh]), dtb = p->in[14][l * 4 + hh];
#pragma unroll
        for (int t = 0; t < 4; ++t) {
            const float av = ba[(size_t)(trow + t) * 8 + 4 + hh] + dtb, bv = ba[(size_t)(trow + t) * 8 + hh];
            const float sp = av > 20.f ? av : log1pf(expf(av));
            dec[t] = expf(alog * sp); beta[t] = 1.f / (1.f + expf(-bv));
        }
    }
    __syncthreads();
    float S[32];
#pragma unroll
    for (int i = 0; i < 32; ++i) S[i] = p->in[3][sbase + (size_t)i * 128];
#pragma unroll
    for (int t = 0; t < 4; ++t) {
        const LAS float* qv = valn + t * 256 + 32 * kq; const LAS float* kv = qv + 128;
        float pk = 0.f, pq = 0.f;
#pragma unroll
        for (int i = 0; i < 32; ++i) { S[i] *= dec[t]; pk += S[i] * kv[i]; pq += S[i] * qv[i]; }
        LAS float* r0 = red + (t * 2 + 0) * 512; LAS float* r1 = red + (t * 2 + 1) * 512;
        r0[kq * 128 + dv] = pk; r1[kq * 128 + dv] = pq;
        __syncthreads();
        const float sk = (r0[dv] + r0[128 + dv]) + (r0[256 + dv] + r0[384 + dv]);
        const float u = beta[t] * (val[t * 384 + 256 + dv] - sk);
#pragma unroll
        for (int i = 0; i < 32; ++i) S[i] += kv[i] * u;
        if (kq == 0) oraw[(size_t)(trow + t) * DM + hh * 128 + dv] = ((r1[dv] + r1[128 + dv]) + (r1[256 + dv] + r1[384 + dv])) + u * kqs[t];
    }
    float* so = p->out + OUT_GDN_S + sbase;
#pragma unroll
    for (int i = 0; i < 32; ++i) so[(size_t)i * 128] = S[i];
    __syncthreads();
}

__device__ __forceinline__ void swa_prompt(PP p, int l, int it, LAS unsigned char* lds) {
    const int tid = get_tid(), lane = tid & 63, wave = tid >> 6, fr = lane & 15, fq = lane >> 4;
    const int rr = it >> 3, pr = (rr >> 5) * 8 + (it & 7), qt = rr & 31, b = pr >> 1, kvh = pr & 1;
    const int q0 = qt * 64, kbase = q0 - 128;
    const bf16_t* hb = (const bf16_t*)(p->ws + WS_H) + (size_t)(b * 2048) * HC;
    float* oraw = (float*)(p->ws + WS_O) + (size_t)(b * 2048) * DM;
    LAS bf16_t* Ks = (LAS bf16_t*)lds;
    LAS bf16_t* VT = Ks + 192 * 72;
#pragma unroll
    for (int i = 0; i < 3; ++i) {
        const int id = tid + 512 * i, row = id >> 3, c8 = id & 7, kp = kbase + row;
        u32x4 kr4 = (u32x4){0u, 0u, 0u, 0u}, vr4 = kr4;
        if (kp >= 0) { kr4 = *(const u32x4*)(hb + (size_t)kp * HC + C_SK + kvh * 64 + c8 * 8); vr4 = *(const u32x4*)(hb + (size_t)kp * HC + C_SV + kvh * 64 + c8 * 8); }
        *(LAS u32x4*)(Ks + row * 72 + c8 * 8) = kr4;
        LAS bf16_t* vt = VT + (c8 * 8) * 200 + row;
        vt[0 * 200] = (bf16_t)(vr4.x & 0xffffu); vt[1 * 200] = (bf16_t)(vr4.x >> 16); vt[2 * 200] = (bf16_t)(vr4.y & 0xffffu); vt[3 * 200] = (bf16_t)(vr4.y >> 16);
        vt[4 * 200] = (bf16_t)(vr4.z & 0xffffu); vt[5 * 200] = (bf16_t)(vr4.z >> 16); vt[6 * 200] = (bf16_t)(vr4.w & 0xffffu); vt[7 * 200] = (bf16_t)(vr4.w >> 16);
        if (qt >= 30 && row >= 128) {
            float kf[8], vf[8]; unpack8(kr4, kf); unpack8(vr4, vf);
            const size_t o = ((size_t)(l * 8 + b) * 128 + (kp - 1920)) * 128 + kvh * 64 + c8 * 8;
            *(f32x4*)(p->out + OUT_K_P + o) = (f32x4){kf[0], kf[1], kf[2], kf[3]}; *(f32x4*)(p->out + OUT_K_P + o + 4) = (f32x4){kf[4], kf[5], kf[6], kf[7]};
            *(f32x4*)(p->out + OUT_V_P + o) = (f32x4){vf[0], vf[1], vf[2], vf[3]}; *(f32x4*)(p->out + OUT_V_P + o + 4) = (f32x4){vf[4], vf[5], vf[6], vf[7]};
        }
    }
    const int g = wave >> 1, half = wave & 1, hq = kvh * 4 + g;
    const int qrow0 = q0 + 32 * half, kl0 = 32 * half;
    bf16x8 qf[2][2];
#pragma unroll
    for (int qt2 = 0; qt2 < 2; ++qt2)
#pragma unroll
        for (int ks = 0; ks < 2; ++ks) qf[qt2][ks] = *(const bf16x8*)(hb + (size_t)(qrow0 + 16 * qt2 + fr) * HC + C_SQ + hq * 64 + ks * 32 + fq * 8);
    __syncthreads();
    f32x4 sacc[2][10];
#pragma unroll
    for (int kt = 0; kt < 10; ++kt) {
        bf16x8 kf[2];
#pragma unroll
        for (int ks = 0; ks < 2; ++ks) kf[ks] = *(const LAS bf16x8*)(Ks + (kl0 + 16 * kt + fr) * 72 + ks * 32 + fq * 8);
#pragma unroll
        for (int qt2 = 0; qt2 < 2; ++qt2) {
            f32x4 a = (f32x4){0.f, 0.f, 0.f, 0.f};
            a = __builtin_amdgcn_mfma_f32_16x16x32_bf16(kf[0], qf[qt2][0], a, 0, 0, 0);
            a = __builtin_amdgcn_mfma_f32_16x16x32_bf16(kf[1], qf[qt2][1], a, 0, 0, 0);
            sacc[qt2][kt] = a;
        }
    }
    const float sink = p->in[16][l * 8 + hq];
    float inv[2];
    bf16x8 pf[2][5];
#pragma unroll
    for (int qt2 = 0; qt2 < 2; ++qt2) {
        float m = sink;
#pragma unroll
        for (int kt = 0; kt < 10; ++kt)
#pragma unroll
            for (int r = 0; r < 4; ++r) {
                const int diff = 128 + 16 * qt2 + fr - 16 * kt - 4 * fq - r;
                const int kp = kbase + kl0 + 16 * kt + 4 * fq + r;
                const bool ok = (diff >= 0) && (diff < 128) && (kp >= 0);
                const float s = ok ? sacc[qt2][kt][r] * 0.125f : -__builtin_inff();
                sacc[qt2][kt][r] = s; m = fmaxf(m, s);
            }
        m = fmaxf(m, __shfl_xor(m, 16)); m = fmaxf(m, __shfl_xor(m, 32));
        float sum = 0.f;
#pragma unroll
        for (int kt = 0; kt < 10; ++kt)
#pragma unroll
            for (int r = 0; r < 4; ++r) { const float e = __expf(sacc[qt2][kt][r] - m); sacc[qt2][kt][r] = e; sum += e; }
        sum += __shfl_xor(sum, 16); sum += __shfl_xor(sum, 32);
        sum += __expf(sink - m);
        inv[qt2] = 1.f / sum;
#pragma unroll
        for (int s5 = 0; s5 < 5; ++s5) {
            const f32x4 a = sacc[qt2][2 * s5], c = sacc[qt2][2 * s5 + 1];
            u32x4 w; w.x = pk2(a[0], a[1]); w.y = pk2(a[2], a[3]); w.z = pk2(c[0], c[1]); w.w = pk2(c[2], c[3]);
            pf[qt2][s5] = __builtin_bit_cast(bf16x8, w);
        }
    }
#pragma unroll
    for (int dt = 0; dt < 4; ++dt) {
        f32x4 oa[2] = {(f32x4){0.f, 0.f, 0.f, 0.f}, (f32x4){0.f, 0.f, 0.f, 0.f}};
#pragma unroll
        for (int s5 = 0; s5 < 5; ++s5) {
            const LAS bf16_t* vp = VT + (16 * dt + fr) * 200 + kl0 + 32 * s5 + 4 * fq;
            const u32x2 lo = *(const LAS u32x2*)vp, hi = *(const LAS u32x2*)(vp + 16);
            const bf16x8 vf = __builtin_bit_cast(bf16x8, (u32x4){lo.x, lo.y, hi.x, hi.y});
            oa[0] = __builtin_amdgcn_mfma_f32_16x16x32_bf16(vf, pf[0][s5], oa[0], 0, 0, 0);
            oa[1] = __builtin_amdgcn_mfma_f32_16x16x32_bf16(vf, pf[1][s5], oa[1], 0, 0, 0);
        }
#pragma unroll
        for (int qt2 = 0; qt2 < 2; ++qt2)
            *(f32x4*)(oraw + (size_t)(qrow0 + 16 * qt2 + fr) * DM + 512 + hq * 64 + 16 * dt + 4 * fq) = oa[qt2] * inv[qt2];
    }
    __syncthreads();
}

__device__ __forceinline__ void swa_sample(PP p, int l, int it, LAS unsigned char* lds) {
    const int tid = get_tid(), lane = tid & 63, wave = tid >> 6;
    const int kvh = it & 1, b = it >> 1;
    const bf16_t* hb = (const bf16_t*)(p->ws + WS_H) + (size_t)(TP + b * 4) * HC;
    float* oraw = (float*)(p->ws + WS_O) + (size_t)(TP + b * 4) * DM;
    LAS float* Kc = (LAS float*)lds;
    LAS float* Vc = Kc + 132 * 68;
    LAS float* Qs = Vc + 132 * 68;
    LAS float* sc = Qs + 16 * 64;
    for (int id = tid; id < 132 * 16; id += NTHR) {
        const int row = id >> 4, c4 = (id & 15) * 4;
        f32x4 kv, vv;
        if (row < 128) {
            const size_t o = ((size_t)(l * 128 + b) * 128 + row) * 128 + kvh * 64 + c4;
            kv = *(const f32x4*)(p->in[4] + o); vv = *(const f32x4*)(p->in[5] + o);
        } else {
            const bf16_t* hp = hb + (size_t)(row - 128) * HC + kvh * 64 + c4;
            const u32x2 kr = *(const u32x2*)(hp + C_SK), vr = *(const u32x2*)(hp + C_SV);
            kv = (f32x4){bflo(kr.x), bfhi(kr.x), bflo(kr.y), bfhi(kr.y)}; vv = (f32x4){bflo(vr.x), bfhi(vr.x), bflo(vr.y), bfhi(vr.y)};
        }
        *(LAS f32x4*)(Kc + row * 68 + c4) = kv; *(LAS f32x4*)(Vc + row * 68 + c4) = vv;
        if (row >= 4) {
            const size_t o = ((size_t)(l * 128 + b) * 128 + (row - 4)) * 128 + kvh * 64 + c4;
            *(f32x4*)(p->out + OUT_K_S + o) = kv; *(f32x4*)(p->out + OUT_V_S + o) = vv;
        }
    }
    for (int id = tid; id < 16 * 64; id += NTHR) {
        const int row = id >> 6, d = id & 63, g = row >> 2, i = row & 3;
        Qs[id] = bf2f(hb[(size_t)i * HC + C_SQ + (kvh * 4 + g) * 64 + d]);
    }
    __syncthreads();
    for (int id = tid; id < 16 * 132; id += NTHR) {
        const int row = id / 132, key = id % 132, i = row & 3;
        const LAS float* kp = Kc + key * 68; const LAS float* qp = Qs + row * 64;
        float s = 0.f;
#pragma unroll
        for (int d = 0; d < 64; d += 4) { const f32x4 a = *(const LAS f32x4*)(kp + d), c = *(const LAS f32x4*)(qp + d); s += (a.x * c.x + a.y * c.y) + (a.z * c.z + a.w * c.w); }
        const bool ok = (key >= i + 1) && (key <= i + 128);
        sc[row * 136 + key] = ok ? s * 0.125f : -__builtin_inff();
    }
    __syncthreads();
#pragma unroll
    for (int rr = 0; rr < 2; ++rr) {
        const int row = wave * 2 + rr, g = row >> 2;
        const float sink = p->in[16][l * 8 + kvh * 4 + g];
        const float s0 = sc[row * 136 + lane], s1 = sc[row * 136 + 64 + lane], s2 = lane < 4 ? sc[row * 136 + 128 + lane] : -__builtin_inff();
        float m = fmaxf(fmaxf(s0, s1), fmaxf(s2, sink));
#pragma unroll
        for (int o = 1; o < 64; o <<= 1) m = fmaxf(m, __shfl_xor(m, o));
        const float e0 = __expf(s0 - m), e1 = __expf(s1 - m), e2 = __expf(s2 - m);
        const float inv = 1.f / (wave_sum(e0 + e1 + e2) + __expf(sink - m));
        sc[row * 136 + lane] = e0 * inv; sc[row * 136 + 64 + lane] = e1 * inv; if (lane < 4) sc[row * 136 + 128 + lane] = e2 * inv;
    }
    __syncthreads();
    {
        const int row = tid >> 5, d2 = (tid & 31) * 2, g = row >> 2, i = row & 3;
        float o0 = 0.f, o1 = 0.f;
#pragma unroll 6
        for (int key = 0; key < 132; ++key) { const float pr = sc[row * 136 + key]; const f32x2 v = *(const LAS f32x2*)(Vc + key * 68 + d2); o0 += pr * v.x; o1 += pr * v.y; }
        *(f32x2*)(oraw + (size_t)i * DM + 512 + (kvh * 4 + g) * 64 + d2) = (f32x2){o0, o1};
    }
    __syncthreads();
}

__device__ __forceinline__ void gdn_chain(PP p, int l, int c, LAS unsigned char* lds) {
    const int tid = get_tid(), lane = tid & 63, wave = tid >> 6, fr = lane & 15, fq = lane >> 4;
    const int xg = c & 7, jg = c >> 3, vs = jg & 3, grp = (jg >> 2) * 8 + xg, hh = grp & 3, b = grp >> 2;
    float* oraw = (float*)(p->ws + WS_O);
    const float* cdg = (const float*)(p->ws + WS_CD);
    LAS bf16_t* STb = (LAS bf16_t*)lds;
    LAS bf16_t* kcs = STb + 32 * 136;
    LAS bf16_t* qds = kcs + 64 * 136;
    LAS bf16_t* kdts = qds + 64 * 136;
    LAS bf16_t* qks = kdts + 128 * 72;
    LAS bf16_t* wsl = qks + 64 * 72;
    LAS bf16_t* uT = wsl + 64 * 40;
    u32x4 rk[2], rq[2], rd[2], rqk, rw;
    auto prefetch = [&](int n) {
        const bf16_t* gb = (const bf16_t*)(p->ws + WS_G) + (size_t)(((b * 32 + n) << 2) + hh) * G_ITEM;
#pragma unroll
        for (int i = 0; i < 2; ++i) { const int id = tid + 512 * i;
            rk[i] = *(const u32x4*)(gb + 8192 + (id >> 4) * 128 + (id & 15) * 8);
            rq[i] = *(const u32x4*)(gb + 16384 + (id >> 4) * 128 + (id & 15) * 8);
            rd[i] = *(const u32x4*)(gb + 24576 + (id >> 3) * 64 + (id & 7) * 8); }
        rqk = *(const u32x4*)(gb + 32768 + (tid >> 3) * 64 + (tid & 7) * 8);
        if (tid < 256) rw = *(const u32x4*)(gb + (tid >> 2) * 128 + 32 * vs + (tid & 3) * 8);
    };
    auto commit = [&]() {
#pragma unroll
        for (int i = 0; i < 2; ++i) { const int id = tid + 512 * i;
            *(LAS u32x4*)(kcs + (id >> 4) * 136 + (id & 15) * 8) = rk[i];
            *(LAS u32x4*)(qds + (id >> 4) * 136 + (id & 15) * 8) = rq[i];
            *(LAS u32x4*)(kdts + (id >> 3) * 72 + (id & 7) * 8) = rd[i]; }
        *(LAS u32x4*)(qks + (tid >> 3) * 72 + (tid & 7) * 8) = rqk;
        if (tid < 256) *(LAS u32x4*)(wsl + (tid >> 2) * 40 + (tid & 3) * 8) = rw;
    };
    LAS float* cds = (LAS float*)(uT + 32 * 72);
    if (tid < 32) cds[tid] = cdg[(((b * 32 + tid) << 2) + hh) * 32];
    prefetch(0);
    for (int i = tid; i < 32 * 136 / 2; i += NTHR) ((LAS unsigned*)STb)[i] = 0u;
    commit();
    f32x4 sa[2] = {(f32x4){0.f, 0.f, 0.f, 0.f}, (f32x4){0.f, 0.f, 0.f, 0.f}};
    const int I = wave >> 1, Jt = wave & 1;
    __syncthreads();
    for (int n = 0; n < 32; ++n) {
        const float cd = cds[n];
        if (n + 1 < 32) prefetch(n + 1);
        bf16x8 sfr[4];
        {
            f32x4 a = (f32x4){0.f, 0.f, 0.f, 0.f};
            bf16x8 af[4];
#pragma unroll
            for (int ks = 0; ks < 4; ++ks) { af[ks] = *(const LAS bf16x8*)(kcs + (16 * I + fr) * 136 + ks * 32 + fq * 8); sfr[ks] = *(const LAS bf16x8*)(STb + (16 * Jt + fr) * 136 + ks * 32 + fq * 8); }
            float w4[4];
#pragma unroll
            for (int r = 0; r < 4; ++r) w4[r] = bf2f(wsl[(16 * I + 4 * fq + r) * 40 + 16 * Jt + fr]);
            __builtin_amdgcn_sched_barrier(0);
#pragma unroll
            for (int ks = 0; ks < 4; ++ks) a = __builtin_amdgcn_mfma_f32_16x16x32_bf16(af[ks], sfr[ks], a, 0, 0, 0);
            float u4[4];
#pragma unroll
            for (int r = 0; r < 4; ++r) u4[r] = w4[r] - a[r];
            u32x2 w; w.x = pk2(u4[0], u4[1]); w.y = pk2(u4[2], u4[3]);
            *(LAS u32x2*)(uT + (16 * Jt + fr) * 72 + 16 * I + 4 * fq) = w;
        }
        __syncthreads();
        {
            f32x4 a = (f32x4){0.f, 0.f, 0.f, 0.f};
            bf16x8 af[6], ufo[2], kf[2], ufx[2];
#pragma unroll
            for (int ks = 0; ks < 4; ++ks) af[ks] = *(const LAS bf16x8*)(qds + (16 * I + fr) * 136 + ks * 32 + fq * 8);
#pragma unroll
            for (int ks = 0; ks < 2; ++ks) { af[4 + ks] = *(const LAS bf16x8*)(qks + (16 * I + fr) * 72 + ks * 32 + fq * 8); ufo[ks] = *(const LAS bf16x8*)(uT + (16 * Jt + fr) * 72 + ks * 32 + fq * 8); }
#pragma unroll
            for (int ks = 0; ks < 2; ++ks) { kf[ks] = *(const LAS bf16x8*)(kdts + (16 * wave + fr) * 72 + ks * 32 + fq * 8); ufx[ks] = *(const LAS bf16x8*)(uT + (16 * (Jt ^ 1) + fr) * 72 + ks * 32 + fq * 8); }
            __builtin_amdgcn_sched_barrier(0);
#pragma unroll
            for (int ks = 0; ks < 4; ++ks) a = __builtin_amdgcn_mfma_f32_16x16x32_bf16(sfr[ks], af[ks], a, 0, 0, 0);
#pragma unroll
            for (int ks = 0; ks < 2; ++ks) a = __builtin_amdgcn_mfma_f32_16x16x32_bf16(ufo[ks], af[4 + ks], a, 0, 0, 0);
            {
                f32x4 s0 = sa[0] * cd, s1 = sa[1] * cd;
#pragma unroll
                for (int ks = 0; ks < 2; ++ks) { s0 = __builtin_amdgcn_mfma_f32_16x16x32_bf16(kf[ks], ufo[ks], s0, 0, 0, 0); s1 = __builtin_amdgcn_mfma_f32_16x16x32_bf16(kf[ks], ufx[ks], s1, 0, 0, 0); }
                sa[0] = s0; sa[1] = s1;
            }
            *(f32x4*)(oraw + (size_t)(b * 2048 + n * 64 + 16 * I + fr) * DM + hh * 128 + 32 * vs + 16 * Jt + 4 * fq) = a;
        }
        __syncthreads();
#pragma unroll
        for (int j2 = 0; j2 < 2; ++j2) { u32x2 w; w.x = pk2(sa[j2][0], sa[j2][1]); w.y = pk2(sa[j2][2], sa[j2][3]);
            *(LAS u32x2*)(STb + (16 * (Jt ^ j2) + fr) * 136 + 16 * wave + 4 * fq) = w; }
        if (n + 1 < 32) commit();
        __syncthreads();
    }
    float* so = p->out + OUT_GDN_P + ((size_t)(l * 8 + b) * 4 + hh) * 16384;
#pragma unroll
    for (int j2 = 0; j2 < 2; ++j2)
#pragma unroll
        for (int r = 0; r < 4; ++r) so[(size_t)(16 * wave + 4 * fq + r) * 128 + 32 * vs + 16 * (Jt ^ j2) + fr] = sa[j2][r];
}

__device__ __forceinline__ void finalize_phase(PP p, int l, int bid, int nb) {
    const int tid = get_tid(), lane = tid & 63, wave = tid >> 6;
    const float* oraw = (const float*)(p->ws + WS_O);
    const bf16_t* hb = (const bf16_t*)(p->ws + WS_H);
    bf16_t* mix = (bf16_t*)(p->ws + WS_XN);
    float wv[16];
    {
        const float* wp = lane < 32 ? p->in[15] + l * 128 + (lane & 7) * 16 : p->in[17] + l * 512 + (lane - 32) * 16;
#pragma unroll
        for (int e = 0; e < 16; ++e) wv[e] = wp[e];
    }
    for (int kk = 0;; ++kk) {
        const int row = row_of(kk, bid, wave, nb); if (row < 0) break;
        const f32x4* op = (const f32x4*)(oraw + (size_t)row * DM + 16 * lane);
        float v[16]; float s = 0.f;
#pragma unroll
        for (int j = 0; j < 4; ++j) { const f32x4 a = op[j]; v[4 * j] = a.x; v[4 * j + 1] = a.y; v[4 * j + 2] = a.z; v[4 * j + 3] = a.w; s += (a.x * a.x + a.y * a.y) + (a.z * a.z + a.w * a.w); }
        s += __shfl_xor(s, 1); s += __shfl_xor(s, 2); s += __shfl_xor(s, 4);
        float s5 = s; s5 += __shfl_xor(s5, 8); s5 += __shfl_xor(s5, 16);
        const float rs = lane < 32 ? rsqrtf(s * (1.f / 128.f) + 1e-6f) : rsqrtf(s5 * (1.f / 512.f) + 1e-6f);
        if (lane < 32) {
            const u32x4* zp = (const u32x4*)(hb + (size_t)row * HC + C_Z + 16 * lane);
            float z[16]; { float t8[8]; unpack8(zp[0], t8);
#pragma unroll
                for (int e = 0; e < 8; ++e) z[e] = t8[e];
                unpack8(zp[1], t8);
#pragma unroll
                for (int e = 0; e < 8; ++e) z[8 + e] = t8[e]; }
#pragma unroll
            for (int e = 0; e < 16; ++e) v[e] = v[e] * rs * wv[e] * silu_f(z[e]);
        } else {
#pragma unroll
            for (int e = 0; e < 16; ++e) v[e] = v[e] * rs * wv[e];
        }
        u32x4 o0, o1;
        o0.x = pk2(v[0], v[1]); o0.y = pk2(v[2], v[3]); o0.z = pk2(v[4], v[5]); o0.w = pk2(v[6], v[7]);
        o1.x = pk2(v[8], v[9]); o1.y = pk2(v[10], v[11]); o1.z = pk2(v[12], v[13]); o1.w = pk2(v[14], v[15]);
        u32x4* mp = (u32x4*)(mix + (size_t)row * DM + 16 * lane); mp[0] = o0; mp[1] = o1;
    }
}

#define XB_TMO      128
#define XB_XCNT(j)  (256  + 64 * (j))
#define XB_XSUB(j)  (1280 + 64 * (j))
#define XB_XGEN(j)  (2304 + 64 * (j))
#define XB_TOP      3328
#define XB_TOPGEN   3392
#define XCD_BAR_WORDS 3456
#define XB_SPIN_CAP (1u << 20)
__device__ __forceinline__ unsigned xb_ld(unsigned* p)              { return __hip_atomic_load(p, __ATOMIC_RELAXED, __HIP_MEMORY_SCOPE_AGENT); }
__device__ __forceinline__ unsigned xb_add(unsigned* p, unsigned v) { return __hip_atomic_fetch_add(p, v, __ATOMIC_RELAXED, __HIP_MEMORY_SCOPE_AGENT); }
__device__ __forceinline__ unsigned xb_xcc_id() { return (unsigned)__builtin_amdgcn_s_getreg((3 << 11) | 20) & 0xFu; }
#define XB_SPIN(cond, bar) do { unsigned _sp = 0; while (cond) { __builtin_amdgcn_s_sleep(1); \
    if ((++_sp & 255u) == 0u) { if (xb_ld(&(bar)[XB_TMO])) break; if (_sp > XB_SPIN_CAP) { atomicAdd(&(bar)[XB_TMO], 1u); break; } } } } while (0)
__device__ __forceinline__ void xcd_barrier_complete(unsigned* bar, unsigned x, unsigned& nloc, unsigned& nx) {
    const unsigned G = gridDim.x * gridDim.y * gridDim.z;
    unsigned sum, cnt, mine, sp = 0u;
    for (;;) {
        sum = 0u; cnt = 0u; mine = 0u;
#pragma unroll
        for (unsigned j = 0; j < 16; ++j) { const unsigned c = xb_ld(&bar[XB_XCNT(j)]); sum += c; cnt += (c > 0u) ? 1u : 0u; mine = (j == x) ? c : mine; }
        if (sum == G) break;
        __builtin_amdgcn_s_sleep(1);
        if ((++sp & 255u) == 0u) { if (xb_ld(&bar[XB_TMO])) break; if (sp > XB_SPIN_CAP) { atomicAdd(&bar[XB_TMO], 1u); break; } }
    }
    nloc = mine > 0u ? mine : 1u; nx = cnt > 0u ? cnt : 1u;
}
__device__ __forceinline__ void xcd_barrier(unsigned* bar, volatile LAS unsigned* st) {
    asm volatile("s_waitcnt vmcnt(0)" ::: "memory");
    __syncthreads();
    if (threadIdx.x == 0) {
        const unsigned x = xb_xcc_id();
        __builtin_amdgcn_s_waitcnt(0);
        unsigned nloc = st[0], nx = st[1];
        if (nloc == 0u) { xcd_barrier_complete(bar, x, nloc, nx); st[0] = nloc; st[1] = nx; }
        const unsigned old = xb_add(&bar[XB_XSUB(x)], 1u);
        const unsigned gen = old / nloc;
        if (old + 1u == (gen + 1u) * nloc) {
            __builtin_amdgcn_fence(__ATOMIC_RELEASE, "agent");
            asm volatile("s_waitcnt vmcnt(0)" ::: "memory");
            const unsigned og = xb_add(&bar[XB_TOP], 1u);
            const unsigned tg = og / nx;
            if (og + 1u == (tg + 1u) * nx) xb_add(&bar[XB_TOPGEN], 1u);
            else XB_SPIN(xb_ld(&bar[XB_TOPGEN]) == tg, bar);
            __builtin_amdgcn_fence(__ATOMIC_ACQUIRE, "agent");
            xb_add(&bar[XB_XGEN(x)], 1u);
            asm volatile("s_waitcnt vmcnt(0)" ::: "memory");
        } else {
            XB_SPIN(xb_ld(&bar[XB_XGEN(x)]) == gen, bar);
            __builtin_amdgcn_fence(__ATOMIC_ACQUIRE, "agent");
            asm volatile("s_waitcnt vmcnt(0)" ::: "memory");
        }
    }
    __syncthreads();
}

#ifndef PROBE_A
#define PROBE_A 1
#endif
#ifndef PROBE_C
#define PROBE_C 1
#endif
__global__ void __launch_bounds__(NTHR, 2) hymba_fwd(Params pv) {
    extern __shared__ __attribute__((aligned(16))) unsigned char smem[];
    LAS unsigned char* lds = (LAS unsigned char*)smem;
    cg::grid_group grid = cg::this_grid();
    const int bid = blockIdx.x, nb = gridDim.x;
    volatile LAS unsigned* xst = (volatile LAS unsigned*)(lds + LDS_MAIN);
    if (threadIdx.x == 0) { xst[0] = 0u; xst[1] = 0u; (void)xb_add((unsigned*)(pv.ws + WS_BAR) + XB_XCNT(xb_xcc_id()), 1u); }
    __syncthreads();
    const int ph_lo = pv.ph_lo, ph_hi = pv.ph_hi;
    int ph = 0;
#define RUN (ph >= ph_lo && ph < ph_hi)
#if defined(USE_CG_SYNC)
#define SEAM() do { ++ph; if (ph > ph_lo && ph < ph_hi) grid.sync(); } while (0)
#else
#define SEAM() do { ++ph; if (ph > ph_lo && ph < ph_hi) xcd_barrier((unsigned*)(get_params()->ws + WS_BAR), xst); } while (0)
#endif
    if (RUN) { PP p = get_params(); prep_phase(p, lds, bid, nb); }
    if (ph_hi == -12345) grid.sync();
    SEAM();
#pragma unroll 1
    for (int step = 0; step < 12; ++step) {
        const int l = step / 3, ty = step % 3;
        if (step > 0) {
            if (RUN) {
                PP p = get_params();
                float* xres = (float*)(p->ws + WS_X); bf16_t* xn = (bf16_t*)(p->ws + WS_XN);
                const float* part = (const float*)(p->ws + WS_O);
                const int nsp = ty == 2 ? DM / 256 : FF / 256; const float psc = ty == 2 ? 1.f : 0.5f;
                if (ty == 1) rms_phase<1>(xres, p->in[10] + l * DM, xn, nullptr, (float*)(p->ws + WS_BA), p->in[11] + (size_t)l * DM * INC, part, nsp, psc, bid, nb);
                else rms_phase<0>(xres, p->in[ty == 0 ? 6 : 19] + l * DM, xn, nullptr, nullptr, nullptr, part, nsp, psc, bid, nb);
            }
            SEAM();
        }
        if (RUN) {
            PP p = get_params();
            const bf16_t* wl = (const bf16_t*)(p->ws + WS_W) + (size_t)l * WL_ELEMS;
            const bf16_t* xn = (const bf16_t*)(p->ws + WS_XN); bf16_t* hbuf = (bf16_t*)(p->ws + WS_H);
            if (ty == 1) {
                pg8::Gemm g{xn, wl + O_IN, DM, DM / 64}; pg8::StaticOrder S; S.init(TT, HC, nb, bid); pg8::EpiH E{hbuf, HC};
                pg8::gemm_phase(lds, g, S, E);
            } else {
                pg8::Gemm g{xn, wl + (ty == 0 ? O_GU1 : O_GU2), DM, DM / 64}; pg8::StaticOrder S; S.init(TT, 2 * FF, nb, bid); pg8::EpiGU E{hbuf};
                pg8::gemm_phase(lds, g, S, E);
            }
        }
        SEAM();
        if (ty == 1) {
            if (RUN) {
                for (int rep = 0; rep < PROBE_A; ++rep)
                for (int it = bid; it < 1024 + 512; it += nb) {
                    PP p = get_params();
                    if (it < 1024) gdn_stage_a(p, l, it, lds);
                    else { __syncthreads(); gdn_sample(p, l, it - 1024, lds); }
                }
            }
            SEAM();
            if (RUN) {
                if (bid < 128 || nb < 256) { for (int rep = 0; rep < PROBE_C; ++rep) for (int c = bid; c < 128; c += nb) { PP p = get_params(); gdn_chain(p, l, c, lds); __syncthreads(); } }
                const int sb = nb >= 256 ? bid - 128 : bid, sn = nb >= 256 ? nb - 128 : nb;
                if (sb >= 0) for (int it = sb; it < 512 + 256; it += sn) {
                    PP p = get_params();
                    if (it < 512) swa_prompt(p, l, it, lds);
                    else swa_sample(p, l, it - 512, lds);
                }
            }
            SEAM();
            if (RUN) { PP p = get_params(); finalize_phase(p, l, bid, nb); }
            SEAM();
        }
        if (RUN) {
            PP p = get_params();
            const bf16_t* wl = (const bf16_t*)(p->ws + WS_W) + (size_t)l * WL_ELEMS;
            float* xres = (float*)(p->ws + WS_X);
            const bf16_t* A = ty == 1 ? (const bf16_t*)(p->ws + WS_XN) : (const bf16_t*)(p->ws + WS_H); const bf16_t* Bt = wl + (ty == 0 ? O_DN1 : ty == 1 ? O_OUT : O_DN2);
            const int K = ty == 1 ? DM : FF; const float scale = ty == 1 ? 1.f : 0.5f;
            {
                pg8::Gemm g{A, Bt, K, K / 64}; pg8::StaticOrder S; S.init(TP, DM, nb, bid); pg8::EpiRes E{xres, scale};
                pg8::gemm_phase(lds, g, S, E);
            }
            {
                pg8::Gemm g{A, Bt, K, 4}; pg8::SplitOrder S{TP / 256, TSM / 256, DM / 256, K / 256, 512, nb, bid}; pg8::EpiPart E{(float*)(p->ws + WS_O)};
                pg8::gemm_phase(lds, g, S, E);
            }
        }
        SEAM();
    }
    if (RUN) { PP p = get_params(); rms_phase<2>((float*)(p->ws + WS_X), p->in[23], nullptr, p->out + OUT_Y, nullptr, nullptr, (const float*)(p->ws + WS_O), FF / 256, 0.5f, bid, nb); }
#undef RUN
#undef SEAM
}

extern "C" void kernel_launch(void* const* d_in, const int* in_sizes, int n_in, void* d_out, int out_size, void* d_ws, size_t ws_size, hipStream_t stream) {
    static int grid = 0;
    if (grid == 0) {
        if (n_in != 24 || (size_t)out_size != OUT_END || ws_size < WS_END) { fprintf(stderr, "kernel_launch: unexpected shapes (n_in %d out %d ws %zu need %zu)\n", n_in, out_size, ws_size, (size_t)WS_END); grid = -1; return; }
        int dev = 0, cus = 0, per_cu = 0;
        (void)hipGetDevice(&dev); (void)hipDeviceGetAttribute(&cus, hipDeviceAttributeMultiprocessorCount, dev);
        (void)hipFuncSetAttribute((const void*)hymba_fwd, hipFuncAttributeMaxDynamicSharedMemorySize, LDS_BYTES);
        (void)hipOccupancyMaxActiveBlocksPerMultiprocessor(&per_cu, (const void*)hymba_fwd, NTHR, LDS_BYTES);
        (void)hipGetLastError();
        if (per_cu < 1) fprintf(stderr, "kernel_launch: occupancy query says %d blocks per CU\n", per_cu);
        grid = cus;
    }
    if (grid < 0) return;
    Params p{};
    for (int i = 0; i < 24; ++i) p.in[i] = (const float*)d_in[i];
    p.out = (float*)d_out; p.ws = (unsigned char*)d_ws; p.ph_lo = 0; p.ph_hi = 1 << 20;
    void* args[] = {&p};
    (void)hipMemsetAsync((char*)d_ws + WS_BAR, 0, 16384, stream);
    hipError_t e = hipLaunchCooperativeKernel((const void*)hymba_fwd, dim3(grid), dim3(NTHR), args, LDS_BYTES, stream);
    if (e != hipSuccess) fprintf(stderr, "cooperative launch failed: %s (grid %d)\n", hipGetErrorString(e), grid);
}
```

```cpp
#include <hip/hip_runtime.h>
#include <hip/hip_cooperative_groups.h>
#include <cstdio>
#include <type_traits>
namespace cg = cooperative_groups;

#define LAS __attribute__((address_space(3)))
typedef unsigned short bf16_t;
typedef short bf16x8 __attribute__((ext_vector_type(8)));
typedef float f32x4 __attribute__((ext_vector_type(4)));
typedef float f32x2 __attribute__((ext_vector_type(2)));
typedef unsigned u32x4 __attribute__((ext_vector_type(4)));
typedef unsigned u32x2 __attribute__((ext_vector_type(2)));

constexpr int TP = 16384, TSM = 512, TT = TP + TSM, DM = 1024, FF = 2816, HC = 2816, INC = 2824;
constexpr int C_Z = 1536, C_SQ = 2048, C_SK = 2560, C_SV = 2688;
constexpr int NTHR = 512, LDS_MAIN = 131072, LDS_BYTES = LDS_MAIN + 16;
constexpr size_t E_GU = (size_t)2 * FF * DM, E_DN = (size_t)DM * FF, E_IN = (size_t)HC * DM, E_OUT = (size_t)DM * DM;
constexpr size_t O_GU1 = 0, O_DN1 = O_GU1 + E_GU, O_IN = O_DN1 + E_DN, O_OUT = O_IN + E_IN, O_GU2 = O_OUT + E_OUT, O_DN2 = O_GU2 + E_GU, WL_ELEMS = O_DN2 + E_DN;
constexpr size_t WS_W = 0;
constexpr size_t WS_X = WS_W + 4 * WL_ELEMS * 2;
constexpr size_t WS_XN = WS_X + (size_t)TT * DM * 4;
constexpr size_t WS_H = WS_XN + (size_t)TT * DM * 2;
constexpr size_t WS_O = WS_H + (size_t)TT * HC * 2;
constexpr size_t WS_G = WS_O + (size_t)TT * DM * 4;
constexpr size_t G_ITEM = 8192 * 4 + 4096;
constexpr size_t WS_CD = WS_G + (size_t)1024 * G_ITEM * 2;
constexpr size_t WS_BA = WS_CD + 131072;
constexpr size_t WS_BAR = WS_BA + (size_t)TT * 8 * 4;
constexpr size_t WS_END = WS_BAR + 16384;
constexpr size_t OUT_Y = 0;
constexpr size_t OUT_CONV_P = (size_t)TT * DM;
constexpr size_t OUT_GDN_P = OUT_CONV_P + (size_t)4 * 8 * 3 * 1536;
constexpr size_t OUT_K_P = OUT_GDN_P + (size_t)4 * 8 * 4 * 128 * 128;
constexpr size_t OUT_V_P = OUT_K_P + (size_t)4 * 8 * 128 * 128;
constexpr size_t OUT_CONV_S = OUT_V_P + (size_t)4 * 8 * 128 * 128;
constexpr size_t OUT_GDN_S = OUT_CONV_S + (size_t)4 * 128 * 3 * 1536;
constexpr size_t OUT_K_S = OUT_GDN_S + (size_t)4 * 128 * 4 * 128 * 128;
constexpr size_t OUT_V_S = OUT_K_S + (size_t)4 * 128 * 128 * 128;
constexpr size_t OUT_END = OUT_V_S + (size_t)4 * 128 * 128 * 128;

struct Params {
    const float* in[24];
    float* out;
    unsigned char* ws;
    int ph_lo, ph_hi;
};

typedef const __attribute__((address_space(4))) Params* PP;
__device__ __forceinline__ PP get_params() { PP q = (PP)__builtin_amdgcn_kernarg_segment_ptr(); asm volatile("" : "+s"(q)); return q; }
__device__ __forceinline__ int get_tid() { int t = threadIdx.x; asm volatile("" : "+v"(t)); return t; }
typedef __bf16 bf16x2_t __attribute__((ext_vector_type(2)));
__device__ __forceinline__ unsigned pk2(float lo, float hi) { const f32x2 v = {lo, hi}; return __builtin_bit_cast(unsigned, __builtin_convertvector(v, bf16x2_t)); }
__device__ __forceinline__ float bflo(unsigned w) { return __uint_as_float(w << 16); }
__device__ __forceinline__ float bfhi(unsigned w) { return __uint_as_float(w & 0xffff0000u); }
__device__ __forceinline__ float bf2f(bf16_t b) { return __uint_as_float((unsigned)b << 16); }
__device__ __forceinline__ float wave_sum(float v) {
#pragma unroll
    for (int o = 1; o < 64; o <<= 1) v += __shfl_xor(v, o);
    return v;
}
__device__ __forceinline__ float silu_f(float v) { return v * __builtin_amdgcn_rcpf(1.f + __expf(-v)); }
__device__ __forceinline__ void unpack8(const u32x4 r, float (&f)[8]) {
    f[0] = bflo(r.x); f[1] = bfhi(r.x); f[2] = bflo(r.y); f[3] = bfhi(r.y); f[4] = bflo(r.z); f[5] = bfhi(r.z); f[6] = bflo(r.w); f[7] = bfhi(r.w);
}
#define LDS_WAIT() asm volatile("s_waitcnt lgkmcnt(0)" ::: "memory")

namespace pg8 {
constexpr int BM = 256, BK = 64, HALF = 128, HTB = HALF * BK * 2, STAGE_BYTES = 8 * HTB, NXCD = 8, WGM = 8;
__device__ __forceinline__ int lds_byte(int r, int c) { const int st = (r >> 4) * 2 + (c >> 5), rr = r & 15, cc = c & 31, ob = rr * 64 + cc * 2; return st * 1024 + (ob ^ (((ob >> 9) & 1) << 5)); }
__device__ __forceinline__ void stage_rc(int b, int& R, int& C) { const int st = b / 1024, sb = b % 1024, swz = sb ^ (((sb >> 9) & 1) << 5); R = (st >> 1) * 16 + swz / 64; C = (st & 1) * 32 + (swz % 64) / 2; }
__device__ __forceinline__ int perm32(int rho) { const int n = rho >> 4, i = rho & 15; return 8 * (i >> 2) + 4 * n + (i & 3); }
struct Unit { int pm, pn, koff; };
struct Gemm { const bf16_t* A; const bf16_t* Bt; int ldk, nt; };

struct StaticOrder {
    int nM, nN, nwg, G, c;
    __device__ void init(int M, int N, int G_, int c_) { nM = M / BM; nN = N / BM; nwg = nM * nN; G = G_; c = c_; }
    __device__ bool next(int i, Unit& u) const {
        const long L = (long)i * G + c; if (L >= nwg) return false;
        int wgid = (int)L; { const int q = nwg / NXCD, r = nwg % NXCD, xcd = wgid % NXCD, off = wgid / NXCD; wgid = (xcd < r ? xcd * (q + 1) : r * (q + 1) + (xcd - r) * q) + off; }
        const int nig = WGM * nN, gid = wgid / nig, fm = gid * WGM, gsz = (nM - fm) < WGM ? (nM - fm) : WGM;
        u.pm = fm + ((wgid % nig) % gsz); u.pn = (wgid % nig) / gsz; u.koff = 0; return true;
    }
};
struct SplitOrder {
    int pm0, nM, nN, nsplit, ksb, G, c;
    __device__ bool next(int i, Unit& u) const {
        const int L = i * G + c; if (L >= nM * nN * nsplit) return false;
        const int ks = L / (nM * nN), t = L % (nM * nN);
        u.pm = pm0 + t / nN; u.pn = t % nN; u.koff = ks * ksb; return true;
    }
};

template <class Epi, class Sched>
__device__ __forceinline__ void gemm_phase(LAS unsigned char* lds, const Gemm g, const Sched& S, const Epi& E) {
    const int tid = get_tid(), wid = __builtin_amdgcn_readfirstlane(tid >> 6), lane = tid & 63, wr = wid >> 2, wc = wid & 3, fr = lane & 15, fq = lane >> 4;
    const int K = g.ldk, nt = g.nt;
    unsigned voffA[2], voffB[2];
#pragma unroll
    for (int i = 0; i < 2; ++i) { int R, C; stage_rc(tid * 16 + i * 8192, R, C); const int Rb = Epi::PERM ? ((R & ~31) + perm32(R & 31)) : R;
        voffA[i] = (unsigned)(R * K + C) * 2u; voffB[i] = (unsigned)(Rb * K + C) * 2u; }
    const size_t kstep = (size_t)(BK * 2);
    const size_t hstep = (size_t)HALF * K * 2;
    const size_t tstep = 2 * hstep;
    const unsigned ldsw = (unsigned)wid * 1024u;
    const int aoff = lds_byte(wr * 64 + fr, fq * 8), boff = lds_byte(wc * 32 + fr, fq * 8);
#define PG8_SA(b, h) (((b) * 2 + (h)) * HTB)
#define PG8_SB(b, h) ((4 + (b) * 2 + (h)) * HTB)
#define PG8_STAGE(bufoff, gbase, voff) do { _Pragma("unroll") for (int _i = 0; _i < 2; ++_i) \
        __builtin_amdgcn_global_load_lds((const unsigned*)((const char*)(gbase) + (voff)[_i]), (LAS unsigned*)(lds + (bufoff) + ldsw + _i * 8192), 16, 0, 0); } while (0)
#define PG8_LDA(dst, b, h) do { _Pragma("unroll") for (int m = 0; m < 4; ++m) _Pragma("unroll") for (int k = 0; k < 2; ++k) dst[m][k] = *(const LAS bf16x8*)(lds + PG8_SA(b, h) + aoff + m * 2048 + k * 1024); } while (0)
#define PG8_LDB(dst, b, h) do { _Pragma("unroll") for (int n = 0; n < 2; ++n) _Pragma("unroll") for (int k = 0; k < 2; ++k) dst[n][k] = *(const LAS bf16x8*)(lds + PG8_SB(b, h) + boff + n * 2048 + k * 1024); } while (0)
#define PG8_MMA(ai, bj, At, Bt) do { __builtin_amdgcn_s_setprio(1); _Pragma("unroll") for (int m = 0; m < 4; ++m) _Pragma("unroll") for (int n = 0; n < 2; ++n) _Pragma("unroll") for (int k = 0; k < 2; ++k) \
        acc[ai][bj][m][n] = __builtin_amdgcn_mfma_f32_16x16x32_bf16(Bt[n][k], At[m][k], acc[ai][bj][m][n], 0, 0, 0); __builtin_amdgcn_s_setprio(0); } while (0)
#define PG8_WAIT_V(n) asm volatile("s_waitcnt vmcnt(" #n ")" ::: "memory")
#define PG8_WAIT_L(n) asm volatile("s_waitcnt lgkmcnt(" #n ")" ::: "memory")
#define PG8_BAR __builtin_amdgcn_s_barrier()
#define PG8_SCHED __builtin_amdgcn_sched_barrier(0)
    Unit cur, nxt; int ui = 0;
    if (!S.next(0, cur)) return;
    f32x4 acc[2][2][4][2];
#pragma unroll
    for (int a = 0; a < 2; ++a)
#pragma unroll
        for (int b = 0; b < 2; ++b)
#pragma unroll
            for (int m = 0; m < 4; ++m)
#pragma unroll
                for (int n = 0; n < 2; ++n) acc[a][b][m][n] = (f32x4){0.f, 0.f, 0.f, 0.f};
    bf16x8 At[4][2], B0[2][2], B1[2][2];
    const char* cA = (const char*)g.A + (size_t)cur.pm * tstep + cur.koff; const char* cB = (const char*)g.Bt + (size_t)cur.pn * tstep + cur.koff;
    PG8_STAGE(PG8_SB(0, 0), cB, voffB); PG8_STAGE(PG8_SA(0, 0), cA, voffA); PG8_STAGE(PG8_SB(0, 1), cB + hstep, voffB); PG8_STAGE(PG8_SA(0, 1), cA + hstep, voffA);
    if (wr == 1) PG8_BAR;
    PG8_WAIT_V(4); PG8_BAR;
    PG8_STAGE(PG8_SB(1, 0), cB + kstep, voffB); PG8_STAGE(PG8_SA(1, 0), cA + kstep, voffA); PG8_STAGE(PG8_SB(1, 1), cB + hstep + kstep, voffB);
    PG8_WAIT_V(6); PG8_BAR;
    for (;;) {
        const bool has_next = S.next(ui + 1, nxt);
        const char* nA = has_next ? (const char*)g.A + (size_t)nxt.pm * tstep + nxt.koff : cA; const char* nB = has_next ? (const char*)g.Bt + (size_t)nxt.pn * tstep + nxt.koff : cB;
        for (int t = 0; t < nt; t += 2) {
            const bool last = (t == nt - 2);
            const char* a1 = cA + (size_t)(t + 1) * kstep;
            const char* a2 = last ? nA : cA + (size_t)(t + 2) * kstep; const char* b2 = last ? nB : cB + (size_t)(t + 2) * kstep;
            const char* a3 = a2 + kstep; const char* b3 = b2 + kstep;
            PG8_LDB(B0, 0, 0); PG8_SCHED; PG8_LDA(At, 0, 0); PG8_STAGE(PG8_SA(1, 1), a1 + hstep, voffA);
            PG8_WAIT_L(8); PG8_BAR; PG8_WAIT_L(0); PG8_MMA(0, 0, At, B0); PG8_BAR; PG8_SCHED;
            PG8_LDB(B1, 0, 1); PG8_STAGE(PG8_SB(0, 0), b2, voffB);
            PG8_BAR; PG8_WAIT_L(0); PG8_MMA(0, 1, At, B1); PG8_BAR;
            PG8_LDA(At, 0, 1); PG8_STAGE(PG8_SA(0, 0), a2, voffA);
            PG8_BAR; PG8_WAIT_L(0); PG8_MMA(1, 0, At, B0); PG8_BAR; PG8_SCHED;
            PG8_STAGE(PG8_SB(0, 1), b2 + hstep, voffB);
            PG8_WAIT_V(6); PG8_BAR; PG8_MMA(1, 1, At, B1); PG8_BAR;
            PG8_LDB(B0, 1, 0); PG8_SCHED; PG8_LDA(At, 1, 0); PG8_STAGE(PG8_SA(0, 1), a2 + hstep, voffA);
            PG8_WAIT_L(8); PG8_BAR; PG8_WAIT_L(0); PG8_MMA(0, 0, At, B0); PG8_BAR; PG8_SCHED;
            PG8_LDB(B1, 1, 1); PG8_STAGE(PG8_SB(1, 0), b3, voffB);
            PG8_BAR; PG8_WAIT_L(0); PG8_MMA(0, 1, At, B1); PG8_BAR;
            PG8_LDA(At, 1, 1); PG8_STAGE(PG8_SA(1, 0), a3, voffA);
            PG8_BAR; PG8_WAIT_L(0); PG8_MMA(1, 0, At, B0); PG8_BAR; PG8_SCHED;
            PG8_STAGE(PG8_SB(1, 1), b3 + hstep, voffB);
            PG8_WAIT_V(6); PG8_BAR; PG8_MMA(1, 1, At, B1); PG8_BAR;
        }
        E(acc, cur, wr, wc, fr, fq);
        if (!has_next) break;
#pragma unroll
        for (int a = 0; a < 2; ++a)
#pragma unroll
            for (int b = 0; b < 2; ++b)
#pragma unroll
                for (int m = 0; m < 4; ++m)
#pragma unroll
                    for (int n = 0; n < 2; ++n) acc[a][b][m][n] = (f32x4){0.f, 0.f, 0.f, 0.f};
        cur = nxt; cA = nA; cB = nB; ++ui;
    }
    PG8_WAIT_V(0);
    if (wr == 0) PG8_BAR;
    PG8_BAR;
#undef PG8_SA
#undef PG8_SB
#undef PG8_STAGE
#undef PG8_LDA
#undef PG8_LDB
#undef PG8_MMA
#undef PG8_WAIT_V
#undef PG8_WAIT_L
#undef PG8_BAR
#undef PG8_SCHED
}

struct EpiGU {
    static constexpr bool PERM = true;
    bf16_t* O;
    __device__ __forceinline__ void operator()(const f32x4 (&acc)[2][2][4][2], const Unit& u, int wr, int wc, int fr, int fq) const {
        const int row0 = u.pm * BM + wr * 64 + fr, col0 = u.pn * 128 + wc * 32 + 8 * fq;
#pragma unroll
        for (int ai = 0; ai < 2; ++ai)
#pragma unroll
            for (int m = 0; m < 4; ++m) { bf16_t* rowp = O + (size_t)(row0 + ai * HALF + m * 16) * FF + col0;
                const f32x4 g0 = acc[ai][0][m][0], g1 = acc[ai][0][m][1], u0 = acc[ai][1][m][0], u1 = acc[ai][1][m][1];
                u32x4 w; w.x = pk2(silu_f(g0[0]) * u0[0], silu_f(g0[1]) * u0[1]); w.y = pk2(silu_f(g0[2]) * u0[2], silu_f(g0[3]) * u0[3]);
                w.z = pk2(silu_f(g1[0]) * u1[0], silu_f(g1[1]) * u1[1]); w.w = pk2(silu_f(g1[2]) * u1[2], silu_f(g1[3]) * u1[3]);
                *(u32x4*)rowp = w; }
    }
};
struct EpiH {
    static constexpr bool PERM = true;
    bf16_t* O; int ldc;
    __device__ __forceinline__ void operator()(const f32x4 (&acc)[2][2][4][2], const Unit& u, int wr, int wc, int fr, int fq) const {
        const int row0 = u.pm * BM + wr * 64 + fr, col0 = u.pn * BM + wc * 32 + 8 * fq;
#pragma unroll
        for (int ai = 0; ai < 2; ++ai)
#pragma unroll
            for (int m = 0; m < 4; ++m) { bf16_t* rowp = O + (size_t)(row0 + ai * HALF + m * 16) * ldc + col0;
#pragma unroll
                for (int bj = 0; bj < 2; ++bj) { const f32x4 v0 = acc[ai][bj][m][0], v1 = acc[ai][bj][m][1];
                    u32x4 w; w.x = pk2(v0[0], v0[1]); w.y = pk2(v0[2], v0[3]); w.z = pk2(v1[0], v1[1]); w.w = pk2(v1[2], v1[3]);
                    *(u32x4*)(rowp + bj * HALF) = w; } }
    }
};
struct EpiRes {
    static constexpr bool PERM = false;
    float* X; float scale;
    __device__ __forceinline__ void operator()(const f32x4 (&acc)[2][2][4][2], const Unit& u, int wr, int wc, int fr, int fq) const {
        const int row0 = u.pm * BM + wr * 64 + fr, col0 = u.pn * BM + wc * 32 + 4 * fq;
#pragma unroll
        for (int ai = 0; ai < 2; ++ai) {
            f32x4 t[4][2][2];
#pragma unroll
            for (int m = 0; m < 4; ++m)
#pragma unroll
                for (int bj = 0; bj < 2; ++bj)
#pragma unroll
                    for (int n = 0; n < 2; ++n) t[m][bj][n] = *(const f32x4*)(X + (size_t)(row0 + ai * HALF + m * 16) * DM + col0 + bj * HALF + n * 16);
#pragma unroll
            for (int m = 0; m < 4; ++m)
#pragma unroll
                for (int bj = 0; bj < 2; ++bj)
#pragma unroll
                    for (int n = 0; n < 2; ++n) *(f32x4*)(X + (size_t)(row0 + ai * HALF + m * 16) * DM + col0 + bj * HALF + n * 16) = t[m][bj][n] + acc[ai][bj][m][n] * scale;
        }
    }
};
struct EpiPart {
    static constexpr bool PERM = false;
    float* P;
    __device__ __forceinline__ void operator()(const f32x4 (&acc)[2][2][4][2], const Unit& u, int wr, int wc, int fr, int fq) const {
        const int row0 = u.pm * BM - TP + wr * 64 + fr, col0 = u.pn * BM + wc * 32 + 4 * fq;
        float* base = P + (size_t)(u.koff >> 9) * TSM * DM;
#pragma unroll
        for (int ai = 0; ai < 2; ++ai)
#pragma unroll
            for (int m = 0; m < 4; ++m) { float* rowp = base + (size_t)(row0 + ai * HALF + m * 16) * DM + col0;
#pragma unroll
                for (int bj = 0; bj < 2; ++bj)
#pragma unroll
                    for (int n = 0; n < 2; ++n) *(f32x4*)(rowp + bj * HALF + n * 16) = acc[ai][bj][m][n]; }
    }
};
}

__device__ __forceinline__ void transpose_item(const float* colp, int ld, int k0, bf16_t* dst, int K, LAS float* scr, int lane) {
    float tv[32];
#pragma unroll
    for (int i = 0; i < 32; ++i) tv[i] = colp[(size_t)(k0 + 2 * i + (lane >> 5)) * ld];
#pragma unroll
    for (int i = 0; i < 32; ++i) scr[(2 * i + (lane >> 5)) * 33 + (lane & 31)] = tv[i];
    LDS_WAIT();
    const int c = lane & 7;
#pragma unroll
    for (int j = 0; j < 4; ++j) { const int n = (lane >> 3) + 8 * j; const LAS float* s = scr + (8 * c) * 33 + n;
        u32x4 o; o.x = pk2(s[0 * 33], s[1 * 33]); o.y = pk2(s[2 * 33], s[3 * 33]); o.z = pk2(s[4 * 33], s[5 * 33]); o.w = pk2(s[6 * 33], s[7 * 33]);
        *(u32x4*)(dst + (size_t)n * K + 8 * c) = o; }
    LDS_WAIT();
}
__device__ __forceinline__ void prep_phase(PP p, LAS unsigned char* lds, int bid, int nb) {
    const int tid = get_tid(), lane = tid & 63, wave = tid >> 6;
    LAS float* scr = (LAS float*)(lds + wave * 8448);
    const int gw = bid * 8 + wave, NGW = nb * 8;
    constexpr int I_GU = 16 * 176, I_DN = 44 * 32, I_IN = 16 * 88, I_OUT = 16 * 32, I_L = 2 * I_GU + 2 * I_DN + I_IN + I_OUT;
    for (int it = gw; it < 4 * I_L; it += NGW) {
        const int l = it / I_L; int r = it % I_L;
        bf16_t* wl = (bf16_t*)(p->ws + WS_W) + (size_t)l * WL_ELEMS;
        const float* colp; int ld, K, k0; bf16_t* dst;
        if (r < 2 * I_GU) {
            const int f = r >= I_GU; r -= f * I_GU; const int kb = r / 176, nb32 = r % 176;
            const float* gsrc = p->in[f ? 20 : 7] + (size_t)l * DM * FF; const float* usrc = p->in[f ? 21 : 8] + (size_t)l * DM * FF;
            colp = (((nb32 >> 2) & 1) ? usrc : gsrc) + 128 * (nb32 >> 3) + 32 * (nb32 & 3) + (lane & 31); ld = FF; K = DM; k0 = 64 * kb;
            dst = wl + (f ? O_GU2 : O_GU1) + (size_t)(32 * nb32) * DM + k0;
        } else if (r < 2 * I_GU + 2 * I_DN) {
            r -= 2 * I_GU; const int f = r >= I_DN; r -= f * I_DN; const int kb = r / 32, nb32 = r % 32;
            colp = p->in[f ? 22 : 9] + (size_t)l * FF * DM + 32 * nb32 + (lane & 31); ld = DM; K = FF; k0 = 64 * kb;
            dst = wl + (f ? O_DN2 : O_DN1) + (size_t)(32 * nb32) * FF + k0;
        } else if (r < 2 * I_GU + 2 * I_DN + I_IN) {
            r -= 2 * I_GU + 2 * I_DN; const int kb = r / 88, nb32 = r % 88; const int n = 32 * nb32 + (lane & 31);
            colp = p->in[11] + (size_t)l * DM * INC + (n < 2048 ? n : n + 8); ld = INC; K = DM; k0 = 64 * kb;
            dst = wl + O_IN + (size_t)(32 * nb32) * DM + k0;
        } else {
            r -= 2 * I_GU + 2 * I_DN + I_IN; const int kb = r / 32, nb32 = r % 32;
            colp = p->in[18] + (size_t)l * DM * DM + 32 * nb32 + (lane & 31); ld = DM; K = DM; k0 = 64 * kb;
            dst = wl + O_OUT + (size_t)(32 * nb32) * DM + k0;
        }
        transpose_item(colp, ld, k0, dst, K, scr, lane);
    }
    {
        f32x4 wv[4];
#pragma unroll
        for (int j = 0; j < 4; ++j) wv[j] = ((const f32x4*)p->in[6])[lane + 64 * j];
        for (int row = gw; row < TT; row += NGW) {
            const f32x4* xr = (const f32x4*)(row < TP ? p->in[0] + (size_t)row * DM : p->in[1] + (size_t)(row - TP) * DM) + lane;
            f32x4* xo = (f32x4*)((float*)(p->ws + WS_X) + (size_t)row * DM) + lane;
            f32x4 v[4]; float s = 0.f;
#pragma unroll
            for (int j = 0; j < 4; ++j) { v[j] = xr[64 * j]; xo[64 * j] = v[j]; s += (v[j].x * v[j].x + v[j].y * v[j].y) + (v[j].z * v[j].z + v[j].w * v[j].w); }
            const float rs = rsqrtf(wave_sum(s) * (1.f / DM) + 1e-6f);
            u32x2* o = (u32x2*)((bf16_t*)(p->ws + WS_XN) + (size_t)row * DM) + lane;
#pragma unroll
            for (int j = 0; j < 4; ++j) { const f32x4 t = v[j] * rs * wv[j]; u32x2 q; q.x = pk2(t.x, t.y); q.y = pk2(t.z, t.w); o[64 * j] = q; }
        }
    }
}

__device__ __forceinline__ int row_of(int k, int bid, int wave, int nb) {
    if (nb == 256) {
        if (k < 8) return (bid & 7) * 2048 + ((bid >> 3) * 8 + wave) + 256 * k;
        const int gw = bid * 8 + wave;
        return (k == 8 && gw < TSM) ? TP + gw : -1;
    }
    const int r = bid * 8 + wave + k * nb * 8;
    return r < TT ? r : -1;
}
template <int MODE>
__device__ __forceinline__ void rms_phase(float* x, const float* w, bf16_t* ob, float* of, float* ba, const float* win, const float* part, int nsplit, float pscale, int bid, int nb) {
    const int tid = get_tid(), lane = tid & 63, wave = tid >> 6;
    f32x4 wv[4];
#pragma unroll
    for (int j = 0; j < 4; ++j) wv[j] = ((const f32x4*)w)[lane + 64 * j];
    f32x4 wc0[4][4], wc1[4][4];
    if (MODE == 1) {
#pragma unroll
        for (int j = 0; j < 4; ++j)
#pragma unroll
            for (int e = 0; e < 4; ++e) { const float* wp = win + (size_t)(4 * lane + 256 * j + e) * INC + 2048; wc0[j][e] = *(const f32x4*)wp; wc1[j][e] = *(const f32x4*)(wp + 4); }
    }
    f32x4 nv[4];
    {
        const int r0 = row_of(0, bid, wave, nb);
        if (r0 >= 0) { const f32x4* q = (const f32x4*)(x + (size_t)r0 * DM) + lane;
#pragma unroll
            for (int j = 0; j < 4; ++j) nv[j] = q[64 * j]; }
    }
    for (int kk = 0;; ++kk) {
        const int row = row_of(kk, bid, wave, nb); if (row < 0) break;
        f32x4* xr = (f32x4*)(x + (size_t)row * DM) + lane;
        f32x4 v[4]; float s = 0.f;
#pragma unroll
        for (int j = 0; j < 4; ++j) v[j] = nv[j];
        const int rnext = row_of(kk + 1, bid, wave, nb);
        if (rnext >= 0) { const f32x4* q = (const f32x4*)(x + (size_t)rnext * DM) + lane;
#pragma unroll
            for (int j = 0; j < 4; ++j) nv[j] = q[64 * j]; }
        if (row >= TP && nsplit > 0) {
            f32x4 a[4] = {(f32x4){0.f, 0.f, 0.f, 0.f}, (f32x4){0.f, 0.f, 0.f, 0.f}, (f32x4){0.f, 0.f, 0.f, 0.f}, (f32x4){0.f, 0.f, 0.f, 0.f}};
            for (int ks = 0; ks < nsplit; ++ks) { const f32x4* pr = (const f32x4*)(part + ((size_t)ks * TSM + (row - TP)) * DM) + lane;
#pragma unroll
                for (int j = 0; j < 4; ++j) a[j] += pr[64 * j]; }
#pragma unroll
            for (int j = 0; j < 4; ++j) { v[j] += a[j] * pscale; xr[64 * j] = v[j]; }
        }
#pragma unroll
        for (int j = 0; j < 4; ++j) s += (v[j].x * v[j].x + v[j].y * v[j].y) + (v[j].z * v[j].z + v[j].w * v[j].w);
        const float rs = rsqrtf(wave_sum(s) * (1.f / DM) + 1e-6f);
#pragma unroll
        for (int j = 0; j < 4; ++j) v[j] = v[j] * rs * wv[j];
        if (MODE == 2) {
            f32x4* o = (f32x4*)(of + (size_t)row * DM) + lane;
#pragma unroll
            for (int j = 0; j < 4; ++j) o[64 * j] = v[j];
        } else {
            u32x2* o = (u32x2*)(ob + (size_t)row * DM) + lane;
#pragma unroll
            for (int j = 0; j < 4; ++j) { u32x2 q; q.x = pk2(v[j].x, v[j].y); q.y = pk2(v[j].z, v[j].w); o[64 * j] = q; }
        }
        if (MODE == 1) {
            float a8[8];
#pragma unroll
            for (int c = 0; c < 8; ++c) a8[c] = 0.f;
#pragma unroll
            for (int j = 0; j < 4; ++j)
#pragma unroll
                for (int e = 0; e < 4; ++e) {
                    const f32x4 w0 = wc0[j][e], w1 = wc1[j][e]; const float xv = v[j][e];
                    a8[0] += xv * w0.x; a8[1] += xv * w0.y; a8[2] += xv * w0.z; a8[3] += xv * w0.w; a8[4] += xv * w1.x; a8[5] += xv * w1.y; a8[6] += xv * w1.z; a8[7] += xv * w1.w;
                }
#pragma unroll
            for (int c = 0; c < 8; ++c) a8[c] = wave_sum(a8[c]);
            if (lane == 0) { *(f32x4*)(ba + (size_t)row * 8) = (f32x4){a8[0], a8[1], a8[2], a8[3]}; *(f32x4*)(ba + (size_t)row * 8 + 4) = (f32x4){a8[4], a8[5], a8[6], a8[7]}; }
        }
    }
}

__device__ __forceinline__ void gdn_stage_a(PP p, int l, int it, LAS unsigned char* lds) {
    const int tid = get_tid(), lane = tid & 63, wave = tid >> 6;
    const int hh = it & 3, n = (it >> 2) & 31, b = it >> 7;
    const int t0 = b * 2048 + n * 64;
    const bf16_t* hb = (const bf16_t*)(p->ws + WS_H);
    const float* ba = (const float*)(p->ws + WS_BA);
    bf16_t* gi_base = (bf16_t*)(p->ws + WS_G) + (size_t)it * G_ITEM;
    bf16_t* wg = gi_base; bf16_t* kcg = gi_base + 8192; bf16_t* qdg = gi_base + 16384; bf16_t* kdtg = gi_base + 24576; bf16_t* qkg = gi_base + 32768;
    LAS float* gcs = (LAS float*)lds;
    LAS float* bet = gcs + 64;
    LAS float* AT = (LAS float*)(lds + 1024);
    LAS float* vr = AT + 64 * 68;
    LAS float* kr = vr + 64 * 128;
    LAS bf16_t* qb = (LAS bf16_t*)(kr + 64 * 128);
    LAS bf16_t* kb = qb + 64 * 136;
    if (wave == 7) {
        const float av = ba[(size_t)(t0 + lane) * 8 + 4 + hh] + p->in[14][l * 4 + hh];
        const float bv = ba[(size_t)(t0 + lane) * 8 + hh];
        const float sp = av > 20.f ? av : log1pf(expf(av));
        float g = -expf(p->in[13][l * 4 + hh]) * sp;
#pragma unroll
        for (int o = 1; o < 64; o <<= 1) { const float t = __shfl_up(g, o); if (lane >= o) g += t; }
        gcs[lane] = g; bet[lane] = 1.f / (1.f + expf(-bv));
    }
    const int gi = tid & 15, cgrp = (tid - 256) >> 4, partA = cgrp >> 3, tbA = cgrp & 7;
    auto conv_task = [&](const int part, const int tok0, float (&o)[8][8], float (&ss)[8], auto ntc) {
        constexpr int NT = decltype(ntc)::value;
        const int cb = part * 512 + hh * 128 + gi * 8;
        float cw[4][8];
        const float* cwp = p->in[12] + (size_t)l * 4 * 1536 + cb;
#pragma unroll
        for (int i = 0; i < 4; ++i) { const f32x4 a = *(const f32x4*)(cwp + i * 1536), c = *(const f32x4*)(cwp + i * 1536 + 4);
            cw[i][0] = a.x; cw[i][1] = a.y; cw[i][2] = a.z; cw[i][3] = a.w; cw[i][4] = c.x; cw[i][5] = c.y; cw[i][6] = c.z; cw[i][7] = c.w; }
        float win[3][8];
#pragma unroll
        for (int i = 0; i < 3; ++i) {
            const int tl = tok0 - 3 + i;
            if (n > 0 || tl >= 0) { const u32x4 raw = *(const u32x4*)(hb + (size_t)(t0 + tl) * HC + cb); unpack8(raw, win[i]); }
            else {
#pragma unroll
                for (int c = 0; c < 8; ++c) win[i][c] = 0.f; }
        }
#pragma unroll
        for (int tt = 0; tt < NT; ++tt) {
            float cur[8];
            const u32x4 raw = *(const u32x4*)(hb + (size_t)(t0 + tok0 + tt) * HC + cb); unpack8(raw, cur);
            float s2 = 0.f;
#pragma unroll
            for (int c = 0; c < 8; ++c) { float v = cw[0][c] * win[0][c] + cw[1][c] * win[1][c] + cw[2][c] * win[2][c] + cw[3][c] * cur[c]; v = silu_f(v); o[tt][c] = v; s2 += v * v; }
            ss[tt] = s2;
            if (n == 31 && tok0 + tt >= 61) {
                float* cp = p->out + OUT_CONV_P + ((size_t)(l * 8 + b) * 3 + (tok0 + tt - 61)) * 1536 + cb;
                *(f32x4*)cp = (f32x4){cur[0], cur[1], cur[2], cur[3]}; *(f32x4*)(cp + 4) = (f32x4){cur[4], cur[5], cur[6], cur[7]};
            }
#pragma unroll
            for (int c = 0; c < 8; ++c) { win[0][c] = win[1][c]; win[1][c] = win[2][c]; win[2][c] = cur[c]; }
        }
#pragma unroll
        for (int tt = 0; tt < NT; ++tt) {
            float s2 = ss[tt];
            s2 += __shfl_xor(s2, 1); s2 += __shfl_xor(s2, 2); s2 += __shfl_xor(s2, 4); s2 += __shfl_xor(s2, 8);
            ss[tt] = rsqrtf(s2 + 1e-6f);
        }
    };
    const int tokB = tbA * 8 + (cgrp >> 3) * 4;
    float oA[8][8], ssA[8], oB[8][8], ssB[8];
    if (tid >= 256) { conv_task(partA, tbA * 8, oA, ssA, std::integral_constant<int, 8>{}); conv_task(2, tokB, oB, ssB, std::integral_constant<int, 4>{}); }
    __syncthreads();
    const float gc_last = gcs[63];
    auto write_task = [&](const int part, const int tok0, float (&o)[8][8], float (&ss)[8], auto ntc) {
        constexpr int NT = decltype(ntc)::value;
        if (part == 0) {
#pragma unroll
            for (int tt = 0; tt < 8; ++tt) {
                const int tok = tok0 + tt; const float sc = ss[tt] * 0.08838834764831845f; const float eg = __expf(gcs[tok]);
                float q[8];
#pragma unroll
                for (int c = 0; c < 8; ++c) q[c] = o[tt][c] * sc;
                u32x4 w; w.x = pk2(q[0], q[1]); w.y = pk2(q[2], q[3]); w.z = pk2(q[4], q[5]); w.w = pk2(q[6], q[7]);
                *(LAS u32x4*)(qb + tok * 136 + gi * 8) = w;
                u32x4 d; d.x = pk2(q[0] * eg, q[1] * eg); d.y = pk2(q[2] * eg, q[3] * eg); d.z = pk2(q[4] * eg, q[5] * eg); d.w = pk2(q[6] * eg, q[7] * eg);
                *(u32x4*)(qdg + tok * 128 + gi * 8) = d;
            }
        } else if (part == 1) {
            float ed[8];
#pragma unroll
            for (int tt = 0; tt < 8; ++tt) {
                const int tok = tok0 + tt; const float sc = ss[tt]; const float gct = gcs[tok]; const float be = bet[tok] * __expf(gct);
                ed[tt] = __expf(gc_last - gct);
#pragma unroll
                for (int c = 0; c < 8; ++c) o[tt][c] *= sc;
                u32x4 w; w.x = pk2(o[tt][0], o[tt][1]); w.y = pk2(o[tt][2], o[tt][3]); w.z = pk2(o[tt][4], o[tt][5]); w.w = pk2(o[tt][6], o[tt][7]);
                *(LAS u32x4*)(kb + tok * 136 + gi * 8) = w;
                *(LAS f32x4*)(kr + tok * 128 + gi * 8) = (f32x4){o[tt][0] * be, o[tt][1] * be, o[tt][2] * be, o[tt][3] * be};
                *(LAS f32x4*)(kr + tok * 128 + gi * 8 + 4) = (f32x4){o[tt][4] * be, o[tt][5] * be, o[tt][6] * be, o[tt][7] * be};
            }
#pragma unroll
            for (int c = 0; c < 8; ++c) {
                u32x4 w; w.x = pk2(o[0][c] * ed[0], o[1][c] * ed[1]); w.y = pk2(o[2][c] * ed[2], o[3][c] * ed[3]); w.z = pk2(o[4][c] * ed[4], o[5][c] * ed[5]); w.w = pk2(o[6][c] * ed[6], o[7][c] * ed[7]);
                *(u32x4*)(kdtg + (gi * 8 + c) * 64 + tok0) = w;
            }
        } else {
#pragma unroll
            for (int tt = 0; tt < NT; ++tt) {
                const int tok = tok0 + tt; const float be = bet[tok];
                *(LAS f32x4*)(vr + tok * 128 + gi * 8) = (f32x4){o[tt][0] * be, o[tt][1] * be, o[tt][2] * be, o[tt][3] * be};
                *(LAS f32x4*)(vr + tok * 128 + gi * 8 + 4) = (f32x4){o[tt][4] * be, o[tt][5] * be, o[tt][6] * be, o[tt][7] * be};
            }
        }
    };
    if (tid >= 256) { write_task(partA, tbA * 8, oA, ssA, std::integral_constant<int, 8>{}); write_task(2, tokB, oB, ssB, std::integral_constant<int, 4>{}); }
    if (tid == 0) ((float*)(p->ws + WS_CD))[it * 32] = __expf(gc_last);
    __syncthreads();
    {
        const int prod = wave >> 2, I = wave & 3, fr = lane & 15, fq = lane >> 4;
        const LAS bf16_t* X = prod ? qb : kb;
        bf16x8 af[4];
#pragma unroll
        for (int ks = 0; ks < 4; ++ks) af[ks] = *(const LAS bf16x8*)(X + (16 * I + fr) * 136 + ks * 32 + fq * 8);
        const int i0 = 16 * I + 4 * fq;
        float gci[4];
#pragma unroll
        for (int r = 0; r < 4; ++r) gci[r] = gcs[i0 + r];
#pragma unroll
        for (int J = 0; J < 4; ++J) {
            f32x4 acc = (f32x4){0.f, 0.f, 0.f, 0.f};
            if (J <= I) {
#pragma unroll
                for (int ks = 0; ks < 4; ++ks) { const bf16x8 bfr = *(const LAS bf16x8*)(kb + (16 * J + fr) * 136 + ks * 32 + fq * 8); acc = __builtin_amdgcn_mfma_f32_16x16x32_bf16(af[ks], bfr, acc, 0, 0, 0); }
            }
            const int j = 16 * J + fr; const float gcj = gcs[j];
            if (prod == 0) {
                if (J <= I) {
                    f32x4 o4;
#pragma unroll
                    for (int r = 0; r < 4; ++r) { const int i = i0 + r; o4[r] = (i > j) ? bet[i] * acc[r] * __expf(gci[r] - gcj) : 0.f; }
                    *(LAS f32x4*)(AT + j * 68 + i0) = o4;
                }
            } else {
#pragma unroll
                for (int r = 0; r < 4; ++r) { const int i = i0 + r; const float v = (i >= j) ? acc[r] * __expf(gci[r] - gcj) : 0.f; qkg[i * 64 + j] = (bf16_t)(pk2(v, 0.f) & 0xffffu); }
            }
        }
    }
    __syncthreads();
    if (tid < 256) {
        const LAS float* src = tid < 128 ? vr + tid : kr + (tid - 128);
        f32x2 ap[32];
#pragma unroll
        for (int k = 0; k < 32; ++k) ap[k] = (f32x2){src[(2 * k) * 128], src[(2 * k + 1) * 128]};
        f32x4 cur[16], nxt[16];
#pragma unroll
        for (int c = 0; c < 16; ++c) cur[c] = *(const LAS f32x4*)(AT + 4 * c);
#pragma unroll
        for (int j = 0; j < 63; ++j) {
#pragma unroll
            for (int c = 0; c < 16; ++c) if (j < 62 && 4 * c + 3 > j + 1) nxt[c] = *(const LAS f32x4*)(AT + (j + 1) * 68 + 4 * c);
            __builtin_amdgcn_sched_barrier(0);
            const float xj = (j & 1) ? ap[j >> 1].y : ap[j >> 1].x;
            if (!(j & 1)) ap[j >> 1].y -= cur[j >> 2][(j & 3) + 1] * xj;
#pragma unroll
            for (int k = (j >> 1) + 1; k < 32; ++k) { const int c = k >> 1, lo = (k & 1) * 2; ap[k] -= (f32x2){cur[c][lo], cur[c][lo + 1]} * xj; }
            __builtin_amdgcn_sched_barrier(0);
#pragma unroll
            for (int c = 0; c < 16; ++c) cur[c] = nxt[c];
        }
        bf16_t* dst = tid < 128 ? wg + tid : kcg + (tid - 128);
#pragma unroll
        for (int k = 0; k < 32; ++k) { const unsigned w2 = pk2(ap[k].x, ap[k].y); dst[(2 * k) * 128] = (bf16_t)(w2 & 0xffffu); dst[(2 * k + 1) * 128] = (bf16_t)(w2 >> 16); }
    }
}

__device__ __forceinline__ void gdn_sample(PP p, int l, int it, LAS unsigned char* lds) {
    const int tid = get_tid(), lane = tid & 63, wave = tid >> 6;
    const int hh = it & 3, b = it >> 2;
    const bf16_t* hb = (const bf16_t*)(p->ws + WS_H);
    const float* ba = (const float*)(p->ws + WS_BA);
    float* oraw = (float*)(p->ws + WS_O);
    LAS float* val = (LAS float*)lds;
    LAS float* valn = val + 4 * 384;
    LAS float* red = valn + 4 * 256;
    LAS float* kqs = red + 4 * 2 * 512;
    const int trow = TP + b * 4;
    const int dv = tid & 127, kq = tid >> 7;
    const size_t sbase = ((size_t)(l * 128 + b) * 4 + hh) * 16384 + (size_t)(32 * kq) * 128 + dv;
    if (tid < 384) {
        const int part = tid >> 7, d = tid & 127, col = part * 512 + hh * 128 + d;
        float full[7];
#pragma unroll
        for (int r = 0; r < 3; ++r) full[r] = p->in[2][((size_t)(l * 128 + b) * 3 + r) * 1536 + col];
#pragma unroll
        for (int i = 0; i < 4; ++i) full[3 + i] = bf2f(hb[(size_t)(trow + i) * HC + col]);
        float cw[4];
#pragma unroll
        for (int i = 0; i < 4; ++i) cw[i] = p->in[12][((size_t)l * 4 + i) * 1536 + col];
#pragma unroll
        for (int t = 0; t < 4; ++t) val[t * 384 + tid] = silu_f(cw[0] * full[t] + cw[1] * full[t + 1] + cw[2] * full[t + 2] + cw[3] * full[t + 3]);
#pragma unroll
        for (int r = 0; r < 3; ++r) p->out[OUT_CONV_S + ((size_t)(l * 128 + b) * 3 + r) * 1536 + col] = full[4 + r];
    }
    __syncthreads();
    {
        const int t = wave & 3, part = wave >> 2;
        const float q0 = val[t * 384 + lane], q1 = val[t * 384 + 64 + lane], k0 = val[t * 384 + 128 + lane], k1 = val[t * 384 + 192 + lane];
        const float scq = rsqrtf(wave_sum(q0 * q0 + q1 * q1) + 1e-6f) * 0.08838834764831845f, sck = rsqrtf(wave_sum(k0 * k0 + k1 * k1) + 1e-6f);
        const float dqk = wave_sum(q0 * k0 + q1 * k1);
        if (part == 0) { valn[t * 256 + lane] = q0 * scq; valn[t * 256 + 64 + lane] = q1 * scq; if (lane == 0) kqs[t] = dqk * scq * sck; }
        else { valn[t * 256 + 128 + lane] = k0 * sck; valn[t * 256 + 192 + lane] = k1 * sck; }
    }
    float dec[4], beta[4];
    {
        const float alog = -expf(p->in[13][l * 4 + hh]), dtb = p->in[14][l * 4 + hh];
#pragma unroll
        for (int t = 0; t < 4; ++t) {
            const float av = ba[(size_t)(trow + t) * 8 + 4 + hh] + dtb, bv = ba[(size_t)(trow + t) * 8 + hh];
            const float sp = av > 20.f ? av : log1pf(expf(av));
            dec[t] = expf(alog * sp); beta[t] = 1.f / (1.f + expf(-bv));
        }
    }
    __syncthreads();
    float S[32];
#pragma unroll
    for (int i = 0; i < 32; ++i) S[i] = p->in[3][sbase + (size_t)i * 128];
#pragma unroll
    for (int t = 0; t < 4; ++t) {
        const LAS float* qv = valn + t * 256 + 32 * kq; const LAS float* kv = qv + 128;
        float pk = 0.f, pq = 0.f;
#pragma unroll
        for (int i = 0; i < 32; ++i) { S[i] *= dec[t]; pk += S[i] * kv[i]; pq += S[i] * qv[i]; }
        LAS float* r0 = red + (t * 2 + 0) * 512; LAS float* r1 = red + (t * 2 + 1) * 512;
        r0[kq * 128 + dv] = pk; r1[kq * 128 + dv] = pq;
        __syncthreads();
        const float sk = (r0[dv] + r0[128 + dv]) + (r0[256 + dv] + r0[384 + dv]);
        const float u = beta[t] * (val[t * 384 + 256 + dv] - sk);
#pragma unroll
        for (int i = 0; i < 32; ++i) S[i] += kv[i] * u;
        if (kq == 0) oraw[(size_t)(trow + t) * DM + hh * 128 + dv] = ((r1[dv] + r1[128 + dv]) + (r1[256 + dv] + r1[384 + dv])) + u * kqs[t];
    }
    float* so = p->out + OUT_GDN_S + sbase;
#pragma unroll
    for (int i = 0; i < 32; ++i) so[(size_t)i * 128] = S[i];
    __syncthreads();
}

__device__ __forceinline__ void swa_prompt(PP p, int l, int it, LAS unsigned char* lds) {
    const int tid = get_tid(), lane = tid & 63, wave = tid >> 6, fr = lane & 15, fq = lane >> 4;
    const int rr = it >> 3, pr = (rr >> 5) * 8 + (it & 7), qt = rr & 31, b = pr >> 1, kvh = pr & 1;
    const int q0 = qt * 64, kbase = q0 - 128;
    const bf16_t* hb = (const bf16_t*)(p->ws + WS_H) + (size_t)(b * 2048) * HC;
    float* oraw = (float*)(p->ws + WS_O) + (size_t)(b * 2048) * DM;
    LAS bf16_t* Ks = (LAS bf16_t*)lds;
    LAS bf16_t* VT = Ks + 192 * 72;
#pragma unroll
    for (int i = 0; i < 3; ++i) {
        const int id = tid + 512 * i, row = id >> 3, c8 = id & 7, kp = kbase + row;
        u32x4 kr4 = (u32x4){0u, 0u, 0u, 0u}, vr4 = kr4;
        if (kp >= 0) { kr4 = *(const u32x4*)(hb + (size_t)kp * HC + C_SK + kvh * 64 + c8 * 8); vr4 = *(const u32x4*)(hb + (size_t)kp * HC + C_SV + kvh * 64 + c8 * 8); }
        *(LAS u32x4*)(Ks + row * 72 + c8 * 8) = kr4;
        LAS bf16_t* vt = VT + (c8 * 8) * 200 + row;
        vt[0 * 200] = (bf16_t)(vr4.x & 0xffffu); vt[1 * 200] = (bf16_t)(vr4.x >> 16); vt[2 * 200] = (bf16_t)(vr4.y & 0xffffu); vt[3 * 200] = (bf16_t)(vr4.y >> 16);
        vt[4 * 200] = (bf16_t)(vr4.z & 0xffffu); vt[5 * 200] = (bf16_t)(vr4.z >> 16); vt[6 * 200] = (bf16_t)(vr4.w & 0xffffu); vt[7 * 200] = (bf16_t)(vr4.w >> 16);
        if (qt >= 30 && row >= 128) {
            float kf[8], vf[8]; unpack8(kr4, kf); unpack8(vr4, vf);
            const size_t o = ((size_t)(l * 8 + b) * 128 + (kp - 1920)) * 128 + kvh * 64 + c8 * 8;
            *(f32x4*)(p->out + OUT_K_P + o) = (f32x4){kf[0], kf[1], kf[2], kf[3]}; *(f32x4*)(p->out + OUT_K_P + o + 4) = (f32x4){kf[4], kf[5], kf[6], kf[7]};
            *(f32x4*)(p->out + OUT_V_P + o) = (f32x4){vf[0], vf[1], vf[2], vf[3]}; *(f32x4*)(p->out + OUT_V_P + o + 4) = (f32x4){vf[4], vf[5], vf[6], vf[7]};
        }
    }
    const int g = wave >> 1, half = wave & 1, hq = kvh * 4 + g;
    const int qrow0 = q0 + 32 * half, kl0 = 32 * half;
    bf16x8 qf[2][2];
#pragma unroll
    for (int qt2 = 0; qt2 < 2; ++qt2)
#pragma unroll
        for (int ks = 0; ks < 2; ++ks) qf[qt2][ks] = *(const bf16x8*)(hb + (size_t)(qrow0 + 16 * qt2 + fr) * HC + C_SQ + hq * 64 + ks * 32 + fq * 8);
    __syncthreads();
    f32x4 sacc[2][10];
#pragma unroll
    for (int kt = 0; kt < 10; ++kt) {
        bf16x8 kf[2];
#pragma unroll
        for (int ks = 0; ks < 2; ++ks) kf[ks] = *(const LAS bf16x8*)(Ks + (kl0 + 16 * kt + fr) * 72 + ks * 32 + fq * 8);
#pragma unroll
        for (int qt2 = 0; qt2 < 2; ++qt2) {
            f32x4 a = (f32x4){0.f, 0.f, 0.f, 0.f};
            a = __builtin_amdgcn_mfma_f32_16x16x32_bf16(kf[0], qf[qt2][0], a, 0, 0, 0);
            a = __builtin_amdgcn_mfma_f32_16x16x32_bf16(kf[1], qf[qt2][1], a, 0, 0, 0);
            sacc[qt2][kt] = a;
        }
    }
    const float sink = p->in[16][l * 8 + hq];
    float inv[2];
    bf16x8 pf[2][5];
#pragma unroll
    for (int qt2 = 0; qt2 < 2; ++qt2) {
        float m = sink;
#pragma unroll
        for (int kt = 0; kt < 10; ++kt)
#pragma unroll
            for (int r = 0; r < 4; ++r) {
                const int diff = 128 + 16 * qt2 + fr - 16 * kt - 4 * fq - r;
                const int kp = kbase + kl0 + 16 * kt + 4 * fq + r;
                const bool ok = (diff >= 0) && (diff < 128) && (kp >= 0);
                const float s = ok ? sacc[qt2][kt][r] * 0.125f : -__builtin_inff();
                sacc[qt2][kt][r] = s; m = fmaxf(m, s);
            }
        m = fmaxf(m, __shfl_xor(m, 16)); m = fmaxf(m, __shfl_xor(m, 32));
        float sum = 0.f;
#pragma unroll
        for (int kt = 0; kt < 10; ++kt)
#pragma unroll
            for (int r = 0; r < 4; ++r) { const float e = __expf(sacc[qt2][kt][r] - m); sacc[qt2][kt][r] = e; sum += e; }
        sum += __shfl_xor(sum, 16); sum += __shfl_xor(sum, 32);
        sum += __expf(sink - m);
        inv[qt2] = 1.f / sum;
#pragma unroll
        for (int s5 = 0; s5 < 5; ++s5) {
            const f32x4 a = sacc[qt2][2 * s5], c = sacc[qt2][2 * s5 + 1];
            u32x4 w; w.x = pk2(a[0], a[1]); w.y = pk2(a[2], a[3]); w.z = pk2(c[0], c[1]); w.w = pk2(c[2], c[3]);
            pf[qt2][s5] = __builtin_bit_cast(bf16x8, w);
        }
    }
#pragma unroll
    for (int dt = 0; dt < 4; ++dt) {
        f32x4 oa[2] = {(f32x4){0.f, 0.f, 0.f, 0.f}, (f32x4){0.f, 0.f, 0.f, 0.f}};
#pragma unroll
        for (int s5 = 0; s5 < 5; ++s5) {
            const LAS bf16_t* vp = VT + (16 * dt + fr) * 200 + kl0 + 32 * s5 + 4 * fq;
            const u32x2 lo = *(const LAS u32x2*)vp, hi = *(const LAS u32x2*)(vp + 16);
            const bf16x8 vf = __builtin_bit_cast(bf16x8, (u32x4){lo.x, lo.y, hi.x, hi.y});
            oa[0] = __builtin_amdgcn_mfma_f32_16x16x32_bf16(vf, pf[0][s5], oa[0], 0, 0, 0);
            oa[1] = __builtin_amdgcn_mfma_f32_16x16x32_bf16(vf, pf[1][s5], oa[1], 0, 0, 0);
        }
#pragma unroll
        for (int qt2 = 0; qt2 < 2; ++qt2)
            *(f32x4*)(oraw + (size_t)(qrow0 + 16 * qt2 + fr) * DM + 512 + hq * 64 + 16 * dt + 4 * fq) = oa[qt2] * inv[qt2];
    }
    __syncthreads();
}

__device__ __forceinline__ void swa_sample(PP p, int l, int it, LAS unsigned char* lds) {
    const int tid = get_tid(), lane = tid & 63, wave = tid >> 6;
    const int kvh = it & 1, b = it >> 1;
    const bf16_t* hb = (const bf16_t*)(p->ws + WS_H) + (size_t)(TP + b * 4) * HC;
    float* oraw = (float*)(p->ws + WS_O) + (size_t)(TP + b * 4) * DM;
    LAS float* Kc = (LAS float*)lds;
    LAS float* Vc = Kc + 132 * 68;
    LAS float* Qs = Vc + 132 * 68;
    LAS float* sc = Qs + 16 * 64;
    for (int id = tid; id < 132 * 16; id += NTHR) {
        const int row = id >> 4, c4 = (id & 15) * 4;
        f32x4 kv, vv;
        if (row < 128) {
            const size_t o = ((size_t)(l * 128 + b) * 128 + row) * 128 + kvh * 64 + c4;
            kv = *(const f32x4*)(p->in[4] + o); vv = *(const f32x4*)(p->in[5] + o);
        } else {
            const bf16_t* hp = hb + (size_t)(row - 128) * HC + kvh * 64 + c4;
            const u32x2 kr = *(const u32x2*)(hp + C_SK), vr = *(const u32x2*)(hp + C_SV);
            kv = (f32x4){bflo(kr.x), bfhi(kr.x), bflo(kr.y), bfhi(kr.y)}; vv = (f32x4){bflo(vr.x), bfhi(vr.x), bflo(vr.y), bfhi(vr.y)};
        }
        *(LAS f32x4*)(Kc + row * 68 + c4) = kv; *(LAS f32x4*)(Vc + row * 68 + c4) = vv;
        if (row >= 4) {
            const size_t o = ((size_t)(l * 128 + b) * 128 + (row - 4)) * 128 + kvh * 64 + c4;
            *(f32x4*)(p->out + OUT_K_S + o) = kv; *(f32x4*)(p->out + OUT_V_S + o) = vv;
        }
    }
    for (int id = tid; id < 16 * 64; id += NTHR) {
        const int row = id >> 6, d = id & 63, g = row >> 2, i = row & 3;
        Qs[id] = bf2f(hb[(size_t)i * HC + C_SQ + (kvh * 4 + g) * 64 + d]);
    }
    __syncthreads();
    for (int id = tid; id < 16 * 132; id += NTHR) {
        const int row = id / 132, key = id % 132, i = row & 3;
        const LAS float* kp = Kc + key * 68; const LAS float* qp = Qs + row * 64;
        float s = 0.f;
#pragma unroll
        for (int d = 0; d < 64; d += 4) { const f32x4 a = *(const LAS f32x4*)(kp + d), c = *(const LAS f32x4*)(qp + d); s += (a.x * c.x + a.y * c.y) + (a.z * c.z + a.w * c.w); }
        const bool ok = (key >= i + 1) && (key <= i + 128);
        sc[row * 136 + key] = ok ? s * 0.125f : -__builtin_inff();
    }
    __syncthreads();
#pragma unroll
    for (int rr = 0; rr < 2; ++rr) {
        const int row = wave * 2 + rr, g = row >> 2;
        const float sink = p->in[16][l * 8 + kvh * 4 + g];
        const float s0 = sc[row * 136 + lane], s1 = sc[row * 136 + 64 + lane], s2 = lane < 4 ? sc[row * 136 + 128 + lane] : -__builtin_inff();
        float m = fmaxf(fmaxf(s0, s1), fmaxf(s2, sink));
#pragma unroll
        for (int o = 1; o < 64; o <<= 1) m = fmaxf(m, __shfl_xor(m, o));
        const float e0 = __expf(s0 - m), e1 = __expf(s1 - m), e2 = __expf(s2 - m);
        const float inv = 1.f / (wave_sum(e0 + e1 + e2) + __expf(sink - m));
        sc[row * 136 + lane] = e0 * inv; sc[row * 136 + 64 + lane] = e1 * inv; if (lane < 4) sc[row * 136 + 128 + lane] = e2 * inv;
    }
    __syncthreads();
    {
        const int row = tid >> 5, d2 = (tid & 31) * 2, g = row >> 2, i = row & 3;
        float o0 = 0.f, o1 = 0.f;
#pragma unroll 6
        for (int key = 0; key < 132; ++key) { const float pr = sc[row * 136 + key]; const f32x2 v = *(const LAS f32x2*)(Vc + key * 68 + d2); o0 += pr * v.x; o1 += pr * v.y; }
        *(f32x2*)(oraw + (size_t)i * DM + 512 + (kvh * 4 + g) * 64 + d2) = (f32x2){o0, o1};
    }
    __syncthreads();
}

__device__ __forceinline__ void gdn_chain(PP p, int l, int c, LAS unsigned char* lds) {
    const int tid = get_tid(), lane = tid & 63, wave = tid >> 6, fr = lane & 15, fq = lane >> 4;
    const int xg = c & 7, jg = c >> 3, vs = jg & 3, grp = (jg >> 2) * 8 + xg, hh = grp & 3, b = grp >> 2;
    float* oraw = (float*)(p->ws + WS_O);
    const float* cdg = (const float*)(p->ws + WS_CD);
    LAS bf16_t* STb = (LAS bf16_t*)lds;
    LAS bf16_t* kcs = STb + 32 * 136;
    LAS bf16_t* qds = kcs + 64 * 136;
    LAS bf16_t* kdts = qds + 64 * 136;
    LAS bf16_t* qks = kdts + 128 * 72;
    LAS bf16_t* wsl = qks + 64 * 72;
    LAS bf16_t* uT = wsl + 64 * 40;
    u32x4 rk[2], rq[2], rd[2], rqk, rw;
    auto prefetch = [&](int n) {
        const bf16_t* gb = (const bf16_t*)(p->ws + WS_G) + (size_t)(((b * 32 + n) << 2) + hh) * G_ITEM;
#pragma unroll
        for (int i = 0; i < 2; ++i) { const int id = tid + 512 * i;
            rk[i] = *(const u32x4*)(gb + 8192 + (id >> 4) * 128 + (id & 15) * 8);
            rq[i] = *(const u32x4*)(gb + 16384 + (id >> 4) * 128 + (id & 15) * 8);
            rd[i] = *(const u32x4*)(gb + 24576 + (id >> 3) * 64 + (id & 7) * 8); }
        rqk = *(const u32x4*)(gb + 32768 + (tid >> 3) * 64 + (tid & 7) * 8);
        if (tid < 256) rw = *(const u32x4*)(gb + (tid >> 2) * 128 + 32 * vs + (tid & 3) * 8);
    };
    auto commit = [&]() {
#pragma unroll
        for (int i = 0; i < 2; ++i) { const int id = tid + 512 * i;
            *(LAS u32x4*)(kcs + (id >> 4) * 136 + (id & 15) * 8) = rk[i];
            *(LAS u32x4*)(qds + (id >> 4) * 136 + (id & 15) * 8) = rq[i];
            *(LAS u32x4*)(kdts + (id >> 3) * 72 + (id & 7) * 8) = rd[i]; }
        *(LAS u32x4*)(qks + (tid >> 3) * 72 + (tid & 7) * 8) = rqk;
        if (tid < 256) *(LAS u32x4*)(wsl + (tid >> 2) * 40 + (tid & 3) * 8) = rw;
    };
    LAS float* cds = (LAS float*)(uT + 32 * 72);
    if (tid < 32) cds[tid] = cdg[(((b * 32 + tid) << 2) + hh) * 32];
    prefetch(0);
    for (int i = tid; i < 32 * 136 / 2; i += NTHR) ((LAS unsigned*)STb)[i] = 0u;
    commit();
    f32x4 sa[2] = {(f32x4){0.f, 0.f, 0.f, 0.f}, (f32x4){0.f, 0.f, 0.f, 0.f}};
    const int I = wave >> 1, Jt = wave & 1;
    __syncthreads();
    for (int n = 0; n < 32; ++n) {
        const float cd = cds[n];
        if (n + 1 < 32) prefetch(n + 1);
        bf16x8 sfr[4];
        {
            f32x4 a = (f32x4){0.f, 0.f, 0.f, 0.f};
            bf16x8 af[4];
#pragma unroll
            for (int ks = 0; ks < 4; ++ks) { af[ks] = *(const LAS bf16x8*)(kcs + (16 * I + fr) * 136 + ks * 32 + fq * 8); sfr[ks] = *(const LAS bf16x8*)(STb + (16 * Jt + fr) * 136 + ks * 32 + fq * 8); }
            float w4[4];
#pragma unroll
            for (int r = 0; r < 4; ++r) w4[r] = bf2f(wsl[(16 * I + 4 * fq + r) * 40 + 16 * Jt + fr]);
            __builtin_amdgcn_sched_barrier(0);
#pragma unroll
            for (int ks = 0; ks < 4; ++ks) a = __builtin_amdgcn_mfma_f32_16x16x32_bf16(af[ks], sfr[ks], a, 0, 0, 0);
            float u4[4];
#pragma unroll
            for (int r = 0; r < 4; ++r) u4[r] = w4[r] - a[r];
            u32x2 w; w.x = pk2(u4[0], u4[1]); w.y = pk2(u4[2], u4[3]);
            *(LAS u32x2*)(uT + (16 * Jt + fr) * 72 + 16 * I + 4 * fq) = w;
        }
        __syncthreads();
        {
            f32x4 a = (f32x4){0.f, 0.f, 0.f, 0.f};
            bf16x8 af[6], ufo[2], kf[2], ufx[2];
#pragma unroll
            for (int ks = 0; ks < 4; ++ks) af[ks] = *(const LAS bf16x8*)(qds + (16 * I + fr) * 136 + ks * 32 + fq * 8);
#pragma unroll
            for (int ks = 0; ks < 2; ++ks) { af[4 + ks] = *(const LAS bf16x8*)(qks + (16 * I + fr) * 72 + ks * 32 + fq * 8); ufo[ks] = *(const LAS bf16x8*)(uT + (16 * Jt + fr) * 72 + ks * 32 + fq * 8); }
#pragma unroll
            for (int ks = 0; ks < 2; ++ks) { kf[ks] = *(const LAS bf16x8*)(kdts + (16 * wave + fr) * 72 + ks * 32 + fq * 8); ufx[ks] = *(const LAS bf16x8*)(uT + (16 * (Jt ^ 1) + fr) * 72 + ks * 32 + fq * 8); }
            __builtin_amdgcn_sched_barrier(0);
#pragma unroll
            for (int ks = 0; ks < 4; ++ks) a = __builtin_amdgcn_mfma_f32_16x16x32_bf16(sfr[ks], af[ks], a, 0, 0, 0);
#pragma unroll
            for (int ks = 0; ks < 2; ++ks) a = __builtin_amdgcn_mfma_f32_16x16x32_bf16(ufo[ks], af[4 + ks], a, 0, 0, 0);
            {
                f32x4 s0 = sa[0] * cd, s1 = sa[1] * cd;
#pragma unroll
                for (int ks = 0; ks < 2; ++ks) { s0 = __builtin_amdgcn_mfma_f32_16x16x32_bf16(kf[ks], ufo[ks], s0, 0, 0, 0); s1 = __builtin_amdgcn_mfma_f32_16x16x32_bf16(kf[ks], ufx[ks], s1, 0, 0, 0); }
                sa[0] = s0; sa[1] = s1;
            }
            *(f32x4*)(oraw + (size_t)(b * 2048 + n * 64 + 16 * I + fr) * DM + hh * 128 + 32 * vs + 16 * Jt + 4 * fq) = a;
        }
        __syncthreads();
#pragma unroll
        for (int j2 = 0; j2 < 2; ++j2) { u32x2 w; w.x = pk2(sa[j2][0], sa[j2][1]); w.y = pk2(sa[j2][2], sa[j2][3]);
            *(LAS u32x2*)(STb + (16 * (Jt ^ j2) + fr) * 136 + 16 * wave + 4 * fq) = w; }
        if (n + 1 < 32) commit();
        __syncthreads();
    }
    float* so = p->out + OUT_GDN_P + ((size_t)(l * 8 + b) * 4 + hh) * 16384;
#pragma unroll
    for (int j2 = 0; j2 < 2; ++j2)
#pragma unroll
        for (int r = 0; r < 4; ++r) so[(size_t)(16 * wave + 4 * fq + r) * 128 + 32 * vs + 16 * (Jt ^ j2) + fr] = sa[j2][r];
}

__device__ __forceinline__ void finalize_phase(PP p, int l, int bid, int nb) {
    const int tid = get_tid(), lane = tid & 63, wave = tid >> 6;
    const float* oraw = (const float*)(p->ws + WS_O);
    const bf16_t* hb = (const bf16_t*)(p->ws + WS_H);
    bf16_t* mix = (bf16_t*)(p->ws + WS_XN);
    float wv[16];
    {
        const float* wp = lane < 32 ? p->in[15] + l * 128 + (lane & 7) * 16 : p->in[17] + l * 512 + (lane - 32) * 16;
#pragma unroll
        for (int e = 0; e < 16; ++e) wv[e] = wp[e];
    }
    for (int kk = 0;; ++kk) {
        const int row = row_of(kk, bid, wave, nb); if (row < 0) break;
        const f32x4* op = (const f32x4*)(oraw + (size_t)row * DM + 16 * lane);
        float v[16]; float s = 0.f;
#pragma unroll
        for (int j = 0; j < 4; ++j) { const f32x4 a = op[j]; v[4 * j] = a.x; v[4 * j + 1] = a.y; v[4 * j + 2] = a.z; v[4 * j + 3] = a.w; s += (a.x * a.x + a.y * a.y) + (a.z * a.z + a.w * a.w); }
        s += __shfl_xor(s, 1); s += __shfl_xor(s, 2); s += __shfl_xor(s, 4);
        float s5 = s; s5 += __shfl_xor(s5, 8); s5 += __shfl_xor(s5, 16);
        const float rs = lane < 32 ? rsqrtf(s * (1.f / 128.f) + 1e-6f) : rsqrtf(s5 * (1.f / 512.f) + 1e-6f);
        if (lane < 32) {
            const u32x4* zp = (const u32x4*)(hb + (size_t)row * HC + C_Z + 16 * lane);
            float z[16]; { float t8[8]; unpack8(zp[0], t8);
#pragma unroll
                for (int e = 0; e < 8; ++e) z[e] = t8[e];
                unpack8(zp[1], t8);
#pragma unroll
                for (int e = 0; e < 8; ++e) z[8 + e] = t8[e]; }
#pragma unroll
            for (int e = 0; e < 16; ++e) v[e] = v[e] * rs * wv[e] * silu_f(z[e]);
        } else {
#pragma unroll
            for (int e = 0; e < 16; ++e) v[e] = v[e] * rs * wv[e];
        }
        u32x4 o0, o1;
        o0.x = pk2(v[0], v[1]); o0.y = pk2(v[2], v[3]); o0.z = pk2(v[4], v[5]); o0.w = pk2(v[6], v[7]);
        o1.x = pk2(v[8], v[9]); o1.y = pk2(v[10], v[11]); o1.z = pk2(v[12], v[13]); o1.w = pk2(v[14], v[15]);
        u32x4* mp = (u32x4*)(mix + (size_t)row * DM + 16 * lane); mp[0] = o0; mp[1] = o1;
    }
}

#define XB_TMO      128
#define XB_XCNT(j)  (256  + 64 * (j))
#define XB_XSUB(j)  (1280 + 64 * (j))
#define XB_XGEN(j)  (2304 + 64 * (j))
#define XB_TOP      3328
#define XB_TOPGEN   3392
#define XCD_BAR_WORDS 3456
#define XB_SPIN_CAP (1u << 20)
__device__ __forceinline__ unsigned xb_ld(unsigned* p)              { return __hip_atomic_load(p, __ATOMIC_RELAXED, __HIP_MEMORY_SCOPE_AGENT); }
__device__ __forceinline__ unsigned xb_add(unsigned* p, unsigned v) { return __hip_atomic_fetch_add(p, v, __ATOMIC_RELAXED, __HIP_MEMORY_SCOPE_AGENT); }
__device__ __forceinline__ unsigned xb_xcc_id() { return (unsigned)__builtin_amdgcn_s_getreg((3 << 11) | 20) & 0xFu; }
#define XB_SPIN(cond, bar) do { unsigned _sp = 0; while (cond) { __builtin_amdgcn_s_sleep(1); \
    if ((++_sp & 255u) == 0u) { if (xb_ld(&(bar)[XB_TMO])) break; if (_sp > XB_SPIN_CAP) { atomicAdd(&(bar)[XB_TMO], 1u); break; } } } } while (0)
__device__ __forceinline__ void xcd_barrier_complete(unsigned* bar, unsigned x, unsigned& nloc, unsigned& nx) {
    const unsigned G = gridDim.x * gridDim.y * gridDim.z;
    unsigned sum, cnt, mine, sp = 0u;
    for (;;) {
        sum = 0u; cnt = 0u; mine = 0u;
#pragma unroll
        for (unsigned j = 0; j < 16; ++j) { const unsigned c = xb_ld(&bar[XB_XCNT(j)]); sum += c; cnt += (c > 0u) ? 1u : 0u; mine = (j == x) ? c : mine; }
        if (sum == G) break;
        __builtin_amdgcn_s_sleep(1);
        if ((++sp & 255u) == 0u) { if (xb_ld(&bar[XB_TMO])) break; if (sp > XB_SPIN_CAP) { atomicAdd(&bar[XB_TMO], 1u); break; } }
    }
    nloc = mine > 0u ? mine : 1u; nx = cnt > 0u ? cnt : 1u;
}
__device__ __forceinline__ void xcd_barrier(unsigned* bar, volatile LAS unsigned* st) {
    asm volatile("s_waitcnt vmcnt(0)" ::: "memory");
    __syncthreads();
    if (threadIdx.x == 0) {
        const unsigned x = xb_xcc_id();
        __builtin_amdgcn_s_waitcnt(0);
        unsigned nloc = st[0], nx = st[1];
        if (nloc == 0u) { xcd_barrier_complete(bar, x, nloc, nx); st[0] = nloc; st[1] = nx; }
        const unsigned old = xb_add(&bar[XB_XSUB(x)], 1u);
        const unsigned gen = old / nloc;
        if (old + 1u == (gen + 1u) * nloc) {
            __builtin_amdgcn_fence(__ATOMIC_RELEASE, "agent");
            asm volatile("s_waitcnt vmcnt(0)" ::: "memory");
            const unsigned og = xb_add(&bar[XB_TOP], 1u);
            const unsigned tg = og / nx;
            if (og + 1u == (tg + 1u) * nx) xb_add(&bar[XB_TOPGEN], 1u);
            else XB_SPIN(xb_ld(&bar[XB_TOPGEN]) == tg, bar);
            __builtin_amdgcn_fence(__ATOMIC_ACQUIRE, "agent");
            xb_add(&bar[XB_XGEN(x)], 1u);
            asm volatile("s_waitcnt vmcnt(0)" ::: "memory");
        } else {
            XB_SPIN(xb_ld(&bar[XB_XGEN(x)]) == gen, bar);
            __builtin_amdgcn_fence(__ATOMIC_ACQUIRE, "agent");
            asm volatile("s_waitcnt vmcnt(0)" ::: "memory");
        }
    }
    __syncthreads();
}

#ifndef PROBE_A
#define PROBE_A 1
#endif
#ifndef PROBE_C
#define PROBE_C 1
#endif
__global__ void __launch_bounds__(NTHR, 2) hymba_fwd(Params pv) {
    extern __shared__ __attribute__((aligned(16))) unsigned char smem[];
    LAS unsigned char* lds = (LAS unsigned char*)smem;
    cg::grid_group grid = cg::this_grid();
    const int bid = blockIdx.x, nb = gridDim.x;
    volatile LAS unsigned* xst = (volatile LAS unsigned*)(lds + LDS_MAIN);
    if (threadIdx.x == 0) { xst[0] = 0u; xst[1] = 0u; (void)xb_add((unsigned*)(pv.ws + WS_BAR) + XB_XCNT(xb_xcc_id()), 1u); }
    __syncthreads();
    const int ph_lo = pv.ph_lo, ph_hi = pv.ph_hi;
    int ph = 0;
#define RUN (ph >= ph_lo && ph < ph_hi)
#if defined(USE_CG_SYNC)
#define SEAM() do { ++ph; if (ph > ph_lo && ph < ph_hi) grid.sync(); } while (0)
#else
#define SEAM() do { ++ph; if (ph > ph_lo && ph < ph_hi) xcd_barrier((unsigned*)(get_params()->ws + WS_BAR), xst); } while (0)
#endif
    if (RUN) { PP p = get_params(); prep_phase(p, lds, bid, nb); }
    if (ph_hi == -12345) grid.sync();
    SEAM();
#pragma unroll 1
    for (int step = 0; step < 12; ++step) {
        const int l = step / 3, ty = step % 3;
        if (step > 0) {
            if (RUN) {
                PP p = get_params();
                float* xres = (float*)(p->ws + WS_X); bf16_t* xn = (bf16_t*)(p->ws + WS_XN);
                const float* part = (const float*)(p->ws + WS_O);
                const int nsp = ty == 2 ? DM / 256 : FF / 256; const float psc = ty == 2 ? 1.f : 0.5f;
                if (ty == 1) rms_phase<1>(xres, p->in[10] + l * DM, xn, nullptr, (float*)(p->ws + WS_BA), p->in[11] + (size_t)l * DM * INC, part, nsp, psc, bid, nb);
                else rms_phase<0>(xres, p->in[ty == 0 ? 6 : 19] + l * DM, xn, nullptr, nullptr, nullptr, part, nsp, psc, bid, nb);
            }
            SEAM();
        }
        if (RUN) {
            PP p = get_params();
            const bf16_t* wl = (const bf16_t*)(p->ws + WS_W) + (size_t)l * WL_ELEMS;
            const bf16_t* xn = (const bf16_t*)(p->ws + WS_XN); bf16_t* hbuf = (bf16_t*)(p->ws + WS_H);
            if (ty == 1) {
                pg8::Gemm g{xn, wl + O_IN, DM, DM / 64}; pg8::StaticOrder S; S.init(TT, HC, nb, bid); pg8::EpiH E{hbuf, HC};
                pg8::gemm_phase(lds, g, S, E);
            } else {
                pg8::Gemm g{xn, wl + (ty == 0 ? O_GU1 : O_GU2), DM, DM / 64}; pg8::StaticOrder S; S.init(TT, 2 * FF, nb, bid); pg8::EpiGU E{hbuf};
                pg8::gemm_phase(lds, g, S, E);
            }
        }
        SEAM();
        if (ty == 1) {
            if (RUN) {
                for (int rep = 0; rep < PROBE_A; ++rep)
                for (int it = bid; it < 1024 + 512; it += nb) {
                    PP p = get_params();
                    if (it < 1024) gdn_stage_a(p, l, it, lds);
                    else { __syncthreads(); gdn_sample(p, l, it - 1024, lds); }
                }
            }
            SEAM();
            if (RUN) {
                if (bid < 128 || nb < 256) { for (int rep = 0; rep < PROBE_C; ++rep) for (int c = bid; c < 128; c += nb) { PP p = get_params(); gdn_chain(p, l, c, lds); __syncthreads(); } }
                const int sb = nb >= 256 ? bid - 128 : bid, sn = nb >= 256 ? nb - 128 : nb;
                if (sb >= 0) for (int it = sb; it < 512 + 256; it += sn) {
                    PP p = get_params();
                    if (it < 512) swa_prompt(p, l, it, lds);
                    else swa_sample(p, l, it - 512, lds);
                }
            }
            SEAM();
            if (RUN) { PP p = get_params(); finalize_phase(p, l, bid, nb); }
            SEAM();
        }
        if (RUN) {
            PP p = get_params();
            const bf16_t* wl = (const bf16_t*)(p->ws + WS_W) + (size_t)l * WL_ELEMS;
            float* xres = (float*)(p->ws + WS_X);
            const bf16_t* A = ty == 1 ? (const bf16_t*)(p->ws + WS_XN) : (const bf16_t*)(p->ws + WS_H); const bf16_t* Bt = wl + (ty == 0 ? O_DN1 : ty == 1 ? O_OUT : O_DN2);
            const int K = ty == 1 ? DM : FF; const float scale = ty == 1 ? 1.f : 0.5f;
            {
                pg8::Gemm g{A, Bt, K, K / 64}; pg8::StaticOrder S; S.init(TP, DM, nb, bid); pg8::EpiRes E{xres, scale};
                pg8::gemm_phase(lds, g, S, E);
            }
            {
                pg8::Gemm g{A, Bt, K, 4}; pg8::SplitOrder S{TP / 256, TSM / 256, DM / 256, K / 256, 512, nb, bid}; pg8::EpiPart E{(float*)(p->ws + WS_O)};
                pg8::gemm_phase(lds, g, S, E);
            }
        }
        SEAM();
    }
    if (RUN) { PP p = get_params(); rms_phase<2>((float*)(p->ws + WS_X), p->in[23], nullptr, p->out + OUT_Y, nullptr, nullptr, (const float*)(p->ws + WS_O), FF / 256, 0.5f, bid, nb); }
#undef RUN
#undef SEAM
}

extern "C" void kernel_launch(void* const* d_in, const int* in_sizes, int n_in, void* d_out, int out_size, void* d_ws, size_t ws_size, hipStream_t stream) {
    static int grid = 0;
    if (grid == 0) {
        if (n_in != 24 || (size_t)out_size != OUT_END || ws_size < WS_END) { fprintf(stderr, "kernel_launch: unexpected shapes (n_in %d out %d ws %zu need %zu)\n", n_in, out_size, ws_size, (size_t)WS_END); grid = -1; return; }
        int dev = 0, cus = 0, per_cu = 0;
        (void)hipGetDevice(&dev); (void)hipDeviceGetAttribute(&cus, hipDeviceAttributeMultiprocessorCount, dev);
        (void)hipFuncSetAttribute((const void*)hymba_fwd, hipFuncAttributeMaxDynamicSharedMemorySize, LDS_BYTES);
        (void)hipOccupancyMaxActiveBlocksPerMultiprocessor(&per_cu, (const void*)hymba_fwd, NTHR, LDS_BYTES);
        (void)hipGetLastError();
        if (per_cu < 1) fprintf(stderr, "kernel_launch: occupancy query says %d blocks per CU\n", per_cu);
        grid = cus;
    }
    if (grid < 0) return;
    Params p{};
    for (int i = 0; i < 24; ++i) p.in[i] = (const float*)d_in[i];
    p.out = (float*)d_out; p.ws = (unsigned char*)d_ws; p.ph_lo = 0; p.ph_hi = 1 << 20;
    void* args[] = {&p};
    (void)hipMemsetAsync((char*)d_ws + WS_BAR, 0, 16384, stream);
    hipError_t e = hipLaunchCooperativeKernel((const void*)hymba_fwd, dim3(grid), dim3(NTHR), args, LDS_BYTES, stream);
    if (e != hipSuccess) fprintf(stderr, "cooperative launch failed: %s (grid %d)\n", hipGetErrorString(e), grid);
}
```
